# Optimizing an MI355X kernel written in HIP

```python
import math
import jax, jax.numpy as jnp
from jax import lax
import numpy as np

D_MODEL = 1024
BATCH = 4
SEQ = 8192
DEPTH = 1

D_RNN = D_MODEL
N_RNN_BLOCKS = 16
RNN_BLOCK = D_RNN // N_RNN_BLOCKS
CONV_WIDTH = 4
LRU_C = 8.0
N_DIFF_HEADS = 8
DIFF_HEAD_DIM = 64
D_QK = N_DIFF_HEADS * 2 * DIFF_HEAD_DIM
D_ATTN = N_DIFF_HEADS * 2 * DIFF_HEAD_DIM
Q_BLOCK = 128
N_BUCKETS = 32
MAX_DISTANCE = 128
LN_EPS = 1e-5
DEEPNORM_ALPHA = (2.0 * DEPTH) ** 0.25
DEEPNORM_BETA = (8.0 * DEPTH) ** -0.25
IN_WIDTHS = (D_RNN, D_RNN, D_QK, D_QK, D_ATTN, D_ATTN, 2 * D_MODEL)
IN_WIDTH = sum(IN_WIDTHS)
SPLIT_POINTS = tuple(int(v) for v in np.cumsum(IN_WIDTHS)[:-1])

kernel_name = "hybrid_rglru_diffattn_gated_merge"


def layer_norm(z, g, b):
    z32 = z.astype(jnp.float32)
    mu = jnp.mean(z32, axis=-1, keepdims=True)
    var = jnp.mean(jnp.square(z32 - mu), axis=-1, keepdims=True)
    return ((z32 - mu) * lax.rsqrt(var + LN_EPS) * g.astype(jnp.float32) + b.astype(jnp.float32)).astype(z.dtype)


def rms_norm(z, g):
    z32 = z.astype(jnp.float32)
    return z32 * lax.rsqrt(jnp.mean(jnp.square(z32), axis=-1, keepdims=True) + LN_EPS) * g.astype(jnp.float32)


def causal_depthwise_conv(x, w, b):
    y = lax.conv_general_dilated(
        x, w[:, None, :].astype(x.dtype), window_strides=(1,),
        padding=[(CONV_WIDTH - 1, 0)],
        dimension_numbers=("NWC", "WIO", "NWC"),
        feature_group_count=x.shape[-1])
    return y + b.astype(x.dtype)


def rg_lru(xr, w_a, b_a, w_x, b_x, lam_param):
    B, S, _ = xr.shape
    x32 = xr.astype(jnp.float32)
    xb = x32.reshape(B, S, N_RNN_BLOCKS, RNN_BLOCK)
    r = jax.nn.sigmoid(jnp.einsum("bshi,hij->bshj", xb, w_a.astype(jnp.float32)).reshape(B, S, D_RNN) + b_a.astype(jnp.float32))
    i = jax.nn.sigmoid(jnp.einsum("bshi,hij->bshj", xb, w_x.astype(jnp.float32)).reshape(B, S, D_RNN) + b_x.astype(jnp.float32))
    log_a = -LRU_C * r * jax.nn.softplus(-lam_param.astype(jnp.float32))
    a = jnp.exp(log_a)
    b_in = jnp.sqrt(-jnp.expm1(2.0 * log_a)) * (i * x32)

    def combine(left, right):
        a1, b1 = left
        a2, b2 = right
        return a1 * a2, a2 * b1 + b2

    _, h = lax.associative_scan(combine, (a, b_in), axis=1)
    return h


def t5_causal_bucket(q_pos, k_pos):
    n = jnp.maximum(q_pos[:, None] - k_pos[None, :], 0)
    max_exact = N_BUCKETS // 2
    nf = jnp.maximum(n, 1).astype(jnp.float32)
    large = max_exact + (jnp.log(nf / max_exact) / math.log(MAX_DISTANCE / max_exact)
                         * (N_BUCKETS - max_exact)).astype(jnp.int32)
    large = jnp.minimum(large, N_BUCKETS - 1)
    return jnp.where(n < max_exact, n, large)


def diff_attention(q, k, v, rel_bias, lam):
    B, S = q.shape[0], q.shape[1]
    nb = S // Q_BLOCK
    scale = DIFF_HEAD_DIM ** -0.5
    qb = (q.astype(jnp.float32) * scale).reshape(
        B, nb, Q_BLOCK, N_DIFF_HEADS, 2, DIFF_HEAD_DIM).transpose(1, 0, 2, 3, 4, 5)
    k32 = k.astype(jnp.float32)
    v32 = v.astype(jnp.float32)
    bias_table = rel_bias.astype(jnp.float32)
    k_pos = jnp.arange(S)

    def block(args):
        qi, bi = args
        q_pos = bi * Q_BLOCK + jnp.arange(Q_BLOCK)
        bias = bias_table[t5_causal_bucket(q_pos, k_pos)].transpose(2, 0, 1)
        logits = jnp.einsum("bqhcd,bkhcd->cbhqk", qi, k32) + bias[None, None]
        causal = q_pos[:, None] >= k_pos[None, :]
        logits = jnp.where(causal, logits, -jnp.inf)
        p = jax.nn.softmax(logits, axis=-1)
        w = p[0] - lam * p[1]
        return jnp.einsum("bhqk,bkhe->bqhe", w, v32)

    out = lax.map(block, (qb, jnp.arange(nb)))
    return out.transpose(1, 0, 2, 3, 4).reshape(B, S, N_DIFF_HEADS, 2 * DIFF_HEAD_DIM)


def setup_inputs(seed: int = 0) -> dict:
    key = jax.random.key(seed)
    ks = jax.random.split(key, 24)
    f32 = jnp.float32
    nrm = lambda k, shape, s: jax.random.normal(k, shape, f32) * s
    u = jax.random.uniform(ks[10], (DEPTH, D_RNN), f32, minval=0.9, maxval=0.999)
    a0 = u ** (1.0 / LRU_C)
    return {
        "x": nrm(ks[0], (BATCH, SEQ, D_MODEL), 1.0),
        "c": nrm(ks[1], (BATCH, D_MODEL), 1.0),
        "w_ada": nrm(ks[2], (DEPTH, D_MODEL, 3 * D_MODEL), 0.5 * D_MODEL ** -0.5),
        "b_ada": nrm(ks[3], (DEPTH, 3 * D_MODEL), 0.01),
        "w_in": nrm(ks[4], (DEPTH, D_MODEL, IN_WIDTH), D_MODEL ** -0.5),
        "conv_w": nrm(ks[5], (DEPTH, CONV_WIDTH, D_RNN), CONV_WIDTH ** -0.5),
        "conv_b": nrm(ks[6], (DEPTH, D_RNN), 0.01),
        "w_rg_a": nrm(ks[7], (DEPTH, N_RNN_BLOCKS, RNN_BLOCK, RNN_BLOCK), RNN_BLOCK ** -0.5),
        "b_rg_a": nrm(ks[8], (DEPTH, D_RNN), 0.01),
        "w_rg_x": nrm(ks[9], (DEPTH, N_RNN_BLOCKS, RNN_BLOCK, RNN_BLOCK), RNN_BLOCK ** -0.5),
        "b_rg_x": nrm(ks[11], (DEPTH, D_RNN), 0.01),
        "lru_lambda": jnp.log(a0) - jnp.log1p(-a0),
        "lambda_q1": nrm(ks[12], (DEPTH, DIFF_HEAD_DIM), 0.1),
        "lambda_k1": nrm(ks[13], (DEPTH, DIFF_HEAD_DIM), 0.1),
        "lambda_q2": nrm(ks[14], (DEPTH, DIFF_HEAD_DIM), 0.1),
        "lambda_k2": nrm(ks[15], (DEPTH, DIFF_HEAD_DIM), 0.1),
        "subln_w": 1.0 + nrm(ks[16], (DEPTH, 2 * DIFF_HEAD_DIM), 0.02),
        "rel_bias": nrm(ks[17], (N_BUCKETS, N_DIFF_HEADS), 0.2),
        "w_rnn_out": nrm(ks[18], (DEPTH, D_RNN, D_MODEL), DEEPNORM_BETA * D_RNN ** -0.5),
        "w_attn_out": nrm(ks[19], (DEPTH, D_ATTN, D_MODEL), DEEPNORM_BETA * D_ATTN ** -0.5),
        "w_out": nrm(ks[20], (DEPTH, D_MODEL, D_MODEL), DEEPNORM_BETA * D_MODEL ** -0.5),
        "ln_g": 1.0 + nrm(ks[21], (DEPTH, D_MODEL), 0.02),
        "ln_b": nrm(ks[22], (DEPTH, D_MODEL), 0.02),
    }


def reference(x, c, w_ada, b_ada, w_in, conv_w, conv_b, w_rg_a, b_rg_a, w_rg_x, b_rg_x,
              lru_lambda, lambda_q1, lambda_k1, lambda_q2, lambda_k2, subln_w, rel_bias,
              w_rnn_out, w_attn_out, w_out, ln_g, ln_b):
    B, S, _ = x.shape
    dtype = x.dtype
    h = x
    for layer in range(DEPTH):
        lambda_init = 0.8 - 0.6 * math.exp(-0.3 * layer)
        mod = jnp.einsum("bd,de->be", jax.nn.silu(c), w_ada[layer]) + b_ada[layer]
        shift, scale, gate = jnp.split(mod, 3, axis=-1)
        u = h * (1.0 + scale[:, None, :]) + shift[:, None, :]
        proj = jnp.einsum("bsd,de->bse", u, w_in[layer])
        rx, rg, q, k, v, ag, mg = jnp.split(proj, SPLIT_POINTS, axis=-1)

        rx = causal_depthwise_conv(rx, conv_w[layer], conv_b[layer])
        hr = rg_lru(rx, w_rg_a[layer], b_rg_a[layer], w_rg_x[layer], b_rg_x[layer], lru_lambda[layer])
        y_rnn = (hr * jax.nn.silu(rg.astype(jnp.float32))).astype(dtype)
        y_rnn = jnp.einsum("bse,ed->bsd", y_rnn, w_rnn_out[layer])

        q = q.reshape(B, S, N_DIFF_HEADS, 2, DIFF_HEAD_DIM)
        k = k.reshape(B, S, N_DIFF_HEADS, 2, DIFF_HEAD_DIM)
        v = v.reshape(B, S, N_DIFF_HEADS, 2 * DIFF_HEAD_DIM)
        lam = (jnp.exp(jnp.sum(lambda_q1[layer].astype(jnp.float32) * lambda_k1[layer].astype(jnp.float32)))
               - jnp.exp(jnp.sum(lambda_q2[layer].astype(jnp.float32) * lambda_k2[layer].astype(jnp.float32)))
               + lambda_init)
        o = diff_attention(q, k, v, rel_bias, lam)
        o = rms_norm(o, subln_w[layer]) * (1.0 - lambda_init)
        y_attn = (o.reshape(B, S, D_ATTN) * jax.nn.silu(ag.astype(jnp.float32))).astype(dtype)
        y_attn = jnp.einsum("bse,ed->bsd", y_attn, w_attn_out[layer])

        g_rnn, g_attn = jnp.split(jax.nn.sigmoid(mg), 2, axis=-1)
        merged = g_rnn * y_rnn + g_attn * y_attn
        out = jnp.einsum("bsd,de->bse", merged, w_out[layer]) * gate[:, None, :]

        h = layer_norm(DEEPNORM_ALPHA * h + out, ln_g[layer], ln_b[layer])
    return h.astype(dtype)
```

```cpp
#include <hip/hip_runtime.h>
#include <cstdio>
#include <cstdint>
#include <cmath>

typedef unsigned short bf16_t;
#ifndef MK_ROT
#define MK_ROT 8
#endif
constexpr int NB = 4, SEQ = 8192, DM = 1024, MTOK = NB * SEQ, NIN = 8192;
constexpr float LN_EPS = 1e-5f;
constexpr float ALPHA = 1.189207115002721f;
constexpr float LOG2E = 1.4426950408889634f;
constexpr float C2 = 0.125f * LOG2E;

__device__ __forceinline__ float bf2f_(bf16_t v) { return __uint_as_float(((unsigned)v) << 16); }
__device__ __forceinline__ bf16_t f2bf_(float f) { unsigned u = __float_as_uint(f); return (bf16_t)((u + 0x7fffu + ((u >> 16) & 1u)) >> 16); }
__device__ __forceinline__ float sigmoidf_(float x) { return 1.f / (1.f + __expf(-x)); }
__device__ __forceinline__ float siluf_(float x) { return x / (1.f + __expf(-x)); }

constexpr size_t MiB = 1u << 20;
constexpr size_t WS_CTL = 0;
constexpr size_t WS_MODF = 1 * MiB + 512 * 1024;
constexpr size_t CTL_ZERO_BYTES = 512 * 1024;
constexpr size_t WS_WIN = 2 * MiB;
constexpr size_t WS_WCAT = 18 * MiB;
constexpr size_t WS_WOUT = 22 * MiB;
constexpr size_t WS_YA = 24 * MiB;
constexpr size_t WS_Q = 152 * MiB;
constexpr size_t WS_K = 216 * MiB;
constexpr size_t WS_V = 280 * MiB;
constexpr size_t WS_MG = 344 * MiB;
constexpr size_t WS_END = 472 * MiB;
constexpr size_t DO_U = 0, DO_RX = 64 * MiB, DO_O0 = 0, DO_O1 = 64 * MiB;

__global__ void k_mod(const float* __restrict__ c, const float* __restrict__ w_ada, const float* __restrict__ b_ada, float* __restrict__ modf) {
    const int idx = blockIdx.x * blockDim.x + threadIdx.x; if (idx >= NB * 3072) return;
    const int b = idx / 3072, e = idx % 3072; float acc = 0.f;
    for (int k = 0; k < DM; ++k) acc += siluf_(c[b * DM + k]) * w_ada[(size_t)k * 3072 + e];
    modf[idx] = acc + b_ada[e];
}
__global__ void k_u(const float* __restrict__ x, const float* __restrict__ modf, bf16_t* __restrict__ u) {
    const size_t idx = (size_t)blockIdx.x * blockDim.x + threadIdx.x; if (idx >= (size_t)MTOK * DM) return;
    const int d = (int)(idx % DM); const int b = (int)(idx / ((size_t)SEQ * DM));
    u[idx] = f2bf_(x[idx] * (1.f + modf[b * 3072 + 1024 + d]) + modf[b * 3072 + d]);
}
__global__ void k_transpose(const float* __restrict__ W, int K, int N, bf16_t* __restrict__ WT, int ldt, int koff) {
    const size_t idx = (size_t)blockIdx.x * blockDim.x + threadIdx.x; if (idx >= (size_t)K * N) return;
    const int k = (int)(idx / N), n = (int)(idx % N);
    WT[(size_t)n * ldt + koff + k] = f2bf_(W[idx]);
}

struct EpiProj {
    bf16_t *rx, *ya, *q, *k, *v, *mg;
    __device__ __forceinline__ void mid(int, int, float&) const {}
    __device__ __forceinline__ void operator()(int m, int n, float a) const {
        const int g = n >> 10, c = n & 1023;
        if (g == 0) rx[(size_t)m * 1024 + c] = f2bf_(a);
        else if (g == 1) ya[(size_t)m * 2048 + c] = f2bf_(siluf_(a));
        else if (g == 2) q[(size_t)m * 1024 + c] = f2bf_(a * C2);
        else if (g == 3) k[(size_t)m * 1024 + c] = f2bf_(a);
        else if (g == 4) v[(size_t)m * 1024 + c] = f2bf_(a);
        else if (g == 5) ya[(size_t)m * 2048 + 1024 + c] = f2bf_(siluf_(a));
        else mg[(size_t)m * 2048 + (n - 6144)] = f2bf_(sigmoidf_(a));
    }
};
struct EpiMerge {
    const bf16_t* mg; bf16_t* merged;
    __device__ __forceinline__ void mid(int m, int n, float& a) const { a *= bf2f_(mg[(size_t)m * 2048 + n]) / bf2f_(mg[(size_t)m * 2048 + 1024 + n]); }
    __device__ __forceinline__ void operator()(int m, int n, float a) const { merged[(size_t)m * 1024 + n] = f2bf_(a * bf2f_(mg[(size_t)m * 2048 + 1024 + n])); }
};
struct EpiOut {
    const float* x; const float* modf; float* z;
    __device__ __forceinline__ void mid(int, int, float&) const {}
    __device__ __forceinline__ void operator()(int m, int n, float a) const { const int b = m / SEQ; z[(size_t)m * 1024 + n] = ALPHA * x[(size_t)m * 1024 + n] + modf[b * 3072 + 2048 + n] * a; }
};

template <class Epi, bool MID>
__global__ void __launch_bounds__(256) k_gemm_simple(const bf16_t* __restrict__ A, const bf16_t* __restrict__ Bt, int M, int N, int K, Epi epi, int nblk0 = 0) {
    __shared__ float As[16][68], Bs[16][68];
    const int tid = threadIdx.x, tx = tid & 15, ty = tid >> 4;
    const int m0 = blockIdx.y * 64, n0 = (blockIdx.x + nblk0) * 64;
    float acc[4][4];
#pragma unroll
    for (int i = 0; i < 4; ++i)
#pragma unroll
        for (int j = 0; j < 4; ++j) acc[i][j] = 0.f;
    for (int k0 = 0; k0 < K; k0 += 16) {
        if (MID && k0 == K / 2) {
#pragma unroll
            for (int i = 0; i < 4; ++i)
#pragma unroll
                for (int j = 0; j < 4; ++j) epi.mid(m0 + ty * 4 + i, n0 + tx * 4 + j, acc[i][j]);
        }
#pragma unroll
        for (int e = 0; e < 4; ++e) {
            const int idx = tid + e * 256, r = idx >> 4, kk = idx & 15;
            As[kk][r] = bf2f_(A[(size_t)(m0 + r) * K + k0 + kk]);
            Bs[kk][r] = bf2f_(Bt[(size_t)(n0 + r) * K + k0 + kk]);
        }
        __syncthreads();
#pragma unroll
        for (int kk = 0; kk < 16; ++kk) {
            float a[4], b[4];
#pragma unroll
            for (int i = 0; i < 4; ++i) { a[i] = As[kk][ty * 4 + i]; b[i] = Bs[kk][tx * 4 + i]; }
#pragma unroll
            for (int i = 0; i < 4; ++i)
#pragma unroll
                for (int j = 0; j < 4; ++j) acc[i][j] += a[i] * b[j];
        }
        __syncthreads();
    }
#pragma unroll
    for (int i = 0; i < 4; ++i)
#pragma unroll
        for (int j = 0; j < 4; ++j) epi(m0 + ty * 4 + i, n0 + tx * 4 + j, acc[i][j]);
}

__global__ void __launch_bounds__(64) k_rnn_simple(const bf16_t* __restrict__ rx, bf16_t* __restrict__ ya, const float* __restrict__ conv_w, const float* __restrict__ conv_b,
                                                   const float* __restrict__ w_a, const float* __restrict__ b_a, const float* __restrict__ w_x, const float* __restrict__ b_x, const float* __restrict__ lam) {
    __shared__ float xs[64];
    const int b = blockIdx.x / 16, hb = blockIdx.x % 16, j = threadIdx.x, ch = hb * 64 + j;
    float wa[64], wx[64];
#pragma unroll
    for (int i = 0; i < 64; ++i) { wa[i] = w_a[(size_t)hb * 4096 + i * 64 + j]; wx[i] = w_x[(size_t)hb * 4096 + i * 64 + j]; }
    const float cw0 = conv_w[ch], cw1 = conv_w[1024 + ch], cw2 = conv_w[2048 + ch], cw3 = conv_w[3072 + ch], cb = conv_b[ch];
    const float ba = b_a[ch], bx = b_x[ch];
    const float L = lam[ch]; const float sp = log1pf(expf(-L));
    const float logu = -8.0f * sp;
    float x1 = 0.f, x2 = 0.f, x3 = 0.f, h = 0.f;
    for (int t = 0; t < SEQ; ++t) {
        const size_t row = (size_t)b * SEQ + t;
        const float x0 = bf2f_(rx[row * 1024 + ch]);
        const float xc = cw0 * x3 + cw1 * x2 + cw2 * x1 + cw3 * x0 + cb;
        x3 = x2; x2 = x1; x1 = x0;
        __syncthreads(); xs[j] = xc; __syncthreads();
        float ra = ba, ri = bx;
#pragma unroll
        for (int i = 0; i < 64; ++i) { const float xv = xs[i]; ra += xv * wa[i]; ri += xv * wx[i]; }
        const float r = sigmoidf_(ra), ig = sigmoidf_(ri);
        const float la = r * logu; const float a = expf(la); const float bin = sqrtf(-expm1f(2.f * la)) * (ig * xc);
        h = a * h + bin;
        const size_t o = row * 2048 + ch;
        ya[o] = f2bf_(h * bf2f_(ya[o]));
    }
}

__device__ __forceinline__ int t5_bucket(int n) {
    if (n < 16) return n;
    int l = 16 + (int)(logf((float)n / 16.0f) / 2.0794415416798357f * 16.0f);
    return l < 31 ? l : 31;
}
__global__ void __launch_bounds__(256) k_attn_simple(const bf16_t* __restrict__ Q, const bf16_t* __restrict__ K, const bf16_t* __restrict__ V, bf16_t* __restrict__ O0, bf16_t* __restrict__ O1, const float* __restrict__ rel_bias) {
    __shared__ float tab[128];
    const int qb = blockIdx.x % 32, c = (blockIdx.x / 32) % 2, h = (blockIdx.x / 64) % 8, b = blockIdx.x / 512;
    if (threadIdx.x < 128) tab[threadIdx.x] = rel_bias[t5_bucket(threadIdx.x) * 8 + h] * LOG2E;
    __syncthreads();
    const float far = rel_bias[31 * 8 + h] * LOG2E;
    const int qi = qb * 256 + threadIdx.x; const size_t rowq = (size_t)b * SEQ + qi;
    float q[64], o[128];
#pragma unroll
    for (int d = 0; d < 64; ++d) q[d] = bf2f_(Q[rowq * 1024 + h * 128 + c * 64 + d]);
#pragma unroll
    for (int e = 0; e < 128; ++e) o[e] = 0.f;
    float m = -INFINITY, l = 0.f;
    const int kend = qb * 256 + 255;
    for (int kk = 0; kk <= kend; ++kk) {
        const size_t rowk = (size_t)b * SEQ + kk;
        const bf16_t* kp = K + rowk * 1024 + h * 128 + c * 64;
        float s = 0.f;
#pragma unroll
        for (int d = 0; d < 64; ++d) s += q[d] * bf2f_(kp[d]);
        const int n = qi - kk;
        if (n >= 0) {
            s += (n < 128) ? tab[n] : far;
            if (s > m) { const float f = exp2f(m - s); l *= f;
#pragma unroll
                for (int e = 0; e < 128; ++e) o[e] *= f;
                m = s; }
            const float p = exp2f(s - m); l += p;
            const bf16_t* vp = V + rowk * 1024 + h * 128;
#pragma unroll
            for (int e = 0; e < 128; ++e) o[e] += p * bf2f_(vp[e]);
        }
    }
    bf16_t* Op = (c == 0 ? O0 : O1) + rowq * 1024 + h * 128; const float il = 1.f / l;
#pragma unroll
    for (int e = 0; e < 128; ++e) Op[e] = f2bf_(o[e] * il);
}

__global__ void __launch_bounds__(256) k_combine(const bf16_t* __restrict__ O0, const bf16_t* __restrict__ O1, bf16_t* __restrict__ ya, const float* __restrict__ lq1, const float* __restrict__ lk1,
                                                 const float* __restrict__ lq2, const float* __restrict__ lk2, const float* __restrict__ subw) {
    const int lane = threadIdx.x & 63, row = blockIdx.x * 4 + (threadIdx.x >> 6);
    float s1 = lq1[lane] * lk1[lane], s2 = lq2[lane] * lk2[lane];
#pragma unroll
    for (int o = 1; o < 64; o <<= 1) { s1 += __shfl_xor(s1, o); s2 += __shfl_xor(s2, o); }
    const float lam = expf(s1) - expf(s2) + 0.2f;
    const int col = lane * 16;
    float v[16]; float ss = 0.f;
#pragma unroll
    for (int i = 0; i < 16; ++i) { v[i] = bf2f_(O0[(size_t)row * 1024 + col + i]) - lam * bf2f_(O1[(size_t)row * 1024 + col + i]); ss += v[i] * v[i]; }
    ss += __shfl_xor(ss, 1); ss += __shfl_xor(ss, 2); ss += __shfl_xor(ss, 4);
    const float rs = rsqrtf(ss * (1.f / 128.f) + LN_EPS) * 0.8f;
#pragma unroll
    for (int i = 0; i < 16; ++i) { const size_t o = (size_t)row * 2048 + 1024 + col + i; ya[o] = f2bf_(v[i] * rs * subw[(col + i) & 127] * bf2f_(ya[o])); }
}

__global__ void __launch_bounds__(256) k_ln(float* __restrict__ z, const float* __restrict__ g, const float* __restrict__ bta) {
    const int lane = threadIdx.x & 63, row = blockIdx.x * 4 + (threadIdx.x >> 6);
    float4* p = (float4*)(z + (size_t)row * 1024) + lane; float4 v[4]; float s = 0.f;
#pragma unroll
    for (int j = 0; j < 4; ++j) { v[j] = p[64 * j]; s += (v[j].x + v[j].y) + (v[j].z + v[j].w); }
#pragma unroll
    for (int o = 1; o < 64; o <<= 1) s += __shfl_xor(s, o);
    const float mean = s * (1.f / 1024.f); float q = 0.f;
#pragma unroll
    for (int j = 0; j < 4; ++j) { v[j].x -= mean; v[j].y -= mean; v[j].z -= mean; v[j].w -= mean; q += (v[j].x * v[j].x + v[j].y * v[j].y) + (v[j].z * v[j].z + v[j].w * v[j].w); }
#pragma unroll
    for (int o = 1; o < 64; o <<= 1) q += __shfl_xor(q, o);
    const float rstd = rsqrtf(q * (1.f / 1024.f) + LN_EPS);
#pragma unroll
    for (int j = 0; j < 4; ++j) { const float4 gg = ((const float4*)g)[lane + 64 * j], bb = ((const float4*)bta)[lane + 64 * j];
        float4 o; o.x = v[j].x * rstd * gg.x + bb.x; o.y = v[j].y * rstd * gg.y + bb.y; o.z = v[j].z * rstd * gg.z + bb.z; o.w = v[j].w * rstd * gg.w + bb.w; p[64 * j] = o; }
}

namespace pg8 {
#define PG8_LAS __attribute__((address_space(3)))
typedef unsigned short bf16_t;
typedef short bf16x8 __attribute__((ext_vector_type(8)));
typedef float f32x4 __attribute__((ext_vector_type(4)));
typedef unsigned u32x4 __attribute__((ext_vector_type(4)));
constexpr int BM = 256, BK = 64, HALF = 128, HTB = HALF * BK * 2  , STAGE_BYTES = 8 * HTB, NXCD = 8, WGM = 8;

__host__ __device__ __forceinline__ int lds_byte(int r, int c) { const int st = (r >> 4) * 2 + (c >> 5), rr = r & 15, cc = c & 31, ob = rr * 64 + cc * 2; return st * 1024 + (ob ^ (((ob >> 9) & 1) << 5)); }
__host__ __device__ __forceinline__ void stage_rc(int b, int& R, int& C) { const int st = b / 1024, sb = b % 1024, swz = sb ^ (((sb >> 9) & 1) << 5); R = (st >> 1) * 16 + swz / 64; C = (st & 1) * 32 + (swz % 64) / 2; }
__host__ __device__ __forceinline__ int perm32(int rho) { const int n = rho >> 4, i = rho & 15; return 8 * (i >> 2) + 4 * n + (i & 3); }

struct Unit { int pm, pn; };
struct Gemm { const bf16_t* A; const bf16_t* Bt; int M, N, K; };

struct StaticOrder {
    int nM, nN, nwg, G, c;
    __host__ __device__ void init(int M, int N, int G_, int c_) { nM = M / BM; nN = N / BM; nwg = nM * nN; G = G_; c = c_; }
    __host__ __device__ bool next(int i, Unit& u) const {
        const long L = (long)i * G + c; if (L >= nwg) return false;
        int wgid = (int)L; { const int q = nwg / NXCD, r = nwg % NXCD, xcd = wgid % NXCD, off = wgid / NXCD; wgid = (xcd < r ? xcd * (q + 1) : r * (q + 1) + (xcd - r) * q) + off; }
        const int nig = WGM * nN, gid = wgid / nig, fm = gid * WGM, gsz = (nM - fm) < WGM ? (nM - fm) : WGM;
        u.pm = fm + ((wgid % nig) % gsz); u.pn = (wgid % nig) / gsz; return true;
    }
    __device__ __forceinline__ void a_ready(const Unit&) const {}
    __device__ __forceinline__ void done(const Unit&) const {}
};


typedef float f32x2_cv __attribute__((ext_vector_type(2))); typedef __bf16 bf16x2_cv __attribute__((ext_vector_type(2)));
__device__ __forceinline__ unsigned cvt_pk_bf16(float lo, float hi) { f32x2_cv v = {lo, hi}; bf16x2_cv b = __builtin_convertvector(v, bf16x2_cv); return __builtin_bit_cast(unsigned, b); }
__device__ __forceinline__ float fast_sigmoid(float x) { return __builtin_amdgcn_rcpf(1.0f + __builtin_amdgcn_exp2f(-1.4426950408889634f * x)); }
__device__ __forceinline__ float bflo(unsigned w) { return __uint_as_float(w << 16); }
__device__ __forceinline__ float bfhi(unsigned w) { return __uint_as_float(w & 0xffff0000u); }

struct EpiProjV {
    static constexpr bool PERM = true, AFTER_DRAIN = false, HAS_MID = false;
    unsigned char* ws; unsigned char* dob;
    template <int ACT> __device__ __forceinline__ void run(const f32x4 (&acc)[2][2][4][2], bf16_t* base, int ldc, int row0, float sc) const {
#pragma unroll
        for (int ai = 0; ai < 2; ++ai)
#pragma unroll
            for (int m = 0; m < 4; ++m) { bf16_t* rowp = base + (size_t)(row0 + ai * HALF + m * 16) * ldc;
#pragma unroll
                for (int bj = 0; bj < 2; ++bj) { f32x4 v0 = acc[ai][bj][m][0], v1 = acc[ai][bj][m][1];
                    if (ACT == 0) { v0 = v0 * sc; v1 = v1 * sc; }
                    if (ACT == 1) {
#pragma unroll
                        for (int e = 0; e < 4; ++e) { v0[e] = v0[e] * fast_sigmoid(v0[e]); v1[e] = v1[e] * fast_sigmoid(v1[e]); } }
                    if (ACT == 2) {
#pragma unroll
                        for (int e = 0; e < 4; ++e) { v0[e] = fast_sigmoid(v0[e]); v1[e] = fast_sigmoid(v1[e]); } }
                    u32x4 w; w.x = cvt_pk_bf16(v0[0], v0[1]); w.y = cvt_pk_bf16(v0[2], v0[3]); w.z = cvt_pk_bf16(v1[0], v1[1]); w.w = cvt_pk_bf16(v1[2], v1[3]);
                    *(u32x4*)(rowp + bj * HALF) = w; } }
    }
    __device__ __forceinline__ void operator()(const f32x4 (&acc)[2][2][4][2], const Unit& u, int wr, int wc, int fr, int fq) const {
        const int g = u.pn >> 2, colt = (u.pn & 3) * BM + wc * 32 + 8 * fq; int row0 = u.pm * BM + wr * 64 + fr; asm volatile("" : "+v"(row0));
        const size_t goff = (g == 0) ? DO_RX : (g == 1) ? WS_YA : (g == 2) ? WS_Q : (g == 3) ? WS_K : (g == 4) ? WS_V : (g == 5) ? WS_YA + 2048 : (g == 6) ? WS_MG : WS_MG + 2048;
        bf16_t* base = (bf16_t*)((g == 0 ? dob : ws) + goff) + colt;
        const int ldc = (g == 1 || g >= 5) ? 2048 : 1024;
        if (g == 1 || g == 5) run<1>(acc, base, ldc, row0, 1.0f);
        else if (g >= 6) run<2>(acc, base, ldc, row0, 1.0f);
        else run<0>(acc, base, ldc, row0, g == 2 ? C2 : 1.0f);
    }
};

struct EpiMergeV {
    static constexpr bool PERM = true, AFTER_DRAIN = false, HAS_MID = true;
    const bf16_t* mg; bf16_t* merged;
    __device__ __forceinline__ void mid(f32x4 (&acc)[2][2][4][2], const Unit& u, int wr, int wc, int fr, int fq) const {
        const int col0 = u.pn * BM + wc * 32 + 8 * fq; int row0 = u.pm * BM + wr * 64 + fr; asm volatile("" : "+v"(row0));
#pragma unroll
        for (int ai = 0; ai < 2; ++ai)
#pragma unroll
            for (int m = 0; m < 4; ++m) { const bf16_t* rowp = mg + (size_t)(row0 + ai * HALF + m * 16) * 2048 + col0;
#pragma unroll
                for (int bj = 0; bj < 2; ++bj) { const u32x4 a = *(const u32x4*)(rowp + bj * HALF), b = *(const u32x4*)(rowp + 1024 + bj * HALF);
                    f32x4 r0, r1;
                    r0[0] = bflo(a.x) * __builtin_amdgcn_rcpf(bflo(b.x)); r0[1] = bfhi(a.x) * __builtin_amdgcn_rcpf(bfhi(b.x)); r0[2] = bflo(a.y) * __builtin_amdgcn_rcpf(bflo(b.y)); r0[3] = bfhi(a.y) * __builtin_amdgcn_rcpf(bfhi(b.y));
                    r1[0] = bflo(a.z) * __builtin_amdgcn_rcpf(bflo(b.z)); r1[1] = bfhi(a.z) * __builtin_amdgcn_rcpf(bfhi(b.z)); r1[2] = bflo(a.w) * __builtin_amdgcn_rcpf(bflo(b.w)); r1[3] = bfhi(a.w) * __builtin_amdgcn_rcpf(bfhi(b.w));
                    acc[ai][bj][m][0] = acc[ai][bj][m][0] * r0; acc[ai][bj][m][1] = acc[ai][bj][m][1] * r1; } }
    }
    __device__ __forceinline__ void operator()(const f32x4 (&acc)[2][2][4][2], const Unit& u, int wr, int wc, int fr, int fq) const {
        const int col0 = u.pn * BM + wc * 32 + 8 * fq; int row0 = u.pm * BM + wr * 64 + fr; asm volatile("" : "+v"(row0));
#pragma unroll
        for (int ai = 0; ai < 2; ++ai)
#pragma unroll
            for (int m = 0; m < 4; ++m) { const size_t r = (size_t)(row0 + ai * HALF + m * 16);
#pragma unroll
                for (int bj = 0; bj < 2; ++bj) { const u32x4 b = *(const u32x4*)(mg + r * 2048 + 1024 + col0 + bj * HALF);
                    f32x4 v0 = acc[ai][bj][m][0], v1 = acc[ai][bj][m][1];
                    v0[0] *= bflo(b.x); v0[1] *= bfhi(b.x); v0[2] *= bflo(b.y); v0[3] *= bfhi(b.y); v1[0] *= bflo(b.z); v1[1] *= bfhi(b.z); v1[2] *= bflo(b.w); v1[3] *= bfhi(b.w);
                    u32x4 w; w.x = cvt_pk_bf16(v0[0], v0[1]); w.y = cvt_pk_bf16(v0[2], v0[3]); w.z = cvt_pk_bf16(v1[0], v1[1]); w.w = cvt_pk_bf16(v1[2], v1[3]);
                    *(u32x4*)(merged + r * 1024 + col0 + bj * HALF) = w; } }
    }
};

struct EpiOutV {
    static constexpr bool PERM = false, AFTER_DRAIN = false, HAS_MID = false;
    const float* x; const float* modf; float* z;
    __device__ __forceinline__ void operator()(const f32x4 (&acc)[2][2][4][2], const Unit& u, int wr, int wc, int fr, int fq) const {
        const int col0 = u.pn * BM + wc * 32 + 4 * fq, b = (u.pm * BM) / SEQ; int row0 = u.pm * BM + wr * 64 + fr; asm volatile("" : "+v"(row0));
        f32x4 gv[2][2];
#pragma unroll
        for (int bj = 0; bj < 2; ++bj)
#pragma unroll
            for (int n = 0; n < 2; ++n) gv[bj][n] = *(const f32x4*)(modf + b * 3072 + 2048 + col0 + bj * HALF + n * 16);
#pragma unroll
        for (int ai = 0; ai < 2; ++ai)
#pragma unroll
            for (int m = 0; m < 4; ++m) { const size_t off = (size_t)(row0 + ai * HALF + m * 16) * 1024 + col0;
#pragma unroll
                for (int bj = 0; bj < 2; ++bj)
#pragma unroll
                    for (int n = 0; n < 2; ++n) { const f32x4 xv = *(const f32x4*)(x + off + bj * HALF + n * 16);
                        *(f32x4*)(z + off + bj * HALF + n * 16) = xv * ALPHA + gv[bj][n] * acc[ai][bj][m][n]; } }
    }
};

template <class Epi, class Sched, bool ALIGN_EPI = false, bool SP2 = false>
__device__ __forceinline__ void gemm_phase(PG8_LAS unsigned char* lds, const Gemm g, const Sched& S, const Epi& E, const int tid_in) {
    const int tid = tid_in, wid = __builtin_amdgcn_readfirstlane(tid >> 6), lane = tid & 63, wr = wid >> 2, wc = wid & 3, fr = lane & 15, fq = lane >> 4;
    const int K = g.K, nt = K / BK;
    unsigned voffA[2], voffB[2];
#pragma unroll
    for (int i = 0; i < 2; ++i) { int R, C; stage_rc(tid * 16 + i * 8192, R, C); const int Rb = Epi::PERM ? ((R & ~31) + perm32(R & 31)) : R;
        voffA[i] = (unsigned)(R * K + C) * 2u; voffB[i] = (unsigned)(Rb * K + C) * 2u; }
    const size_t kstep = (size_t)(BK * 2);
    const size_t hstep = (size_t)HALF * K * 2;
    const size_t tstep = 2 * hstep;
    const unsigned ldsw = (unsigned)wid * 1024u;
    const int aoff = lds_byte(wr * 64 + fr, fq * 8), boff = lds_byte(wc * 32 + fr, fq * 8);
#define PG8_SA(b, h) (((b) * 2 + (h)) * HTB)
#define PG8_SB(b, h) ((4 + (b) * 2 + (h)) * HTB)
#define PG8_STAGE(bufoff, gbase, voff) do { _Pragma("unroll") for (int _i = 0; _i < 2; ++_i) \
        __builtin_amdgcn_global_load_lds((const unsigned*)((const char*)(gbase) + (voff)[_i]), (PG8_LAS unsigned*)(lds + (bufoff) + ldsw + _i * 8192), 16, 0, 0); } while (0)
#define PG8_LDA(dst, b, h) do { _Pragma("unroll") for (int m = 0; m < 4; ++m) _Pragma("unroll") for (int k = 0; k < 2; ++k) dst[m][k] = *(const PG8_LAS bf16x8*)(lds + PG8_SA(b, h) + aoff + m * 2048 + k * 1024); } while (0)
#define PG8_LDB(dst, b, h) do { _Pragma("unroll") for (int n = 0; n < 2; ++n) _Pragma("unroll") for (int k = 0; k < 2; ++k) dst[n][k] = *(const PG8_LAS bf16x8*)(lds + PG8_SB(b, h) + boff + n * 2048 + k * 1024); } while (0)
#define PG8_MMA(ai, bj, At, Bt) do { __builtin_amdgcn_s_setprio(1); _Pragma("unroll") for (int m = 0; m < 4; ++m) _Pragma("unroll") for (int n = 0; n < 2; ++n) _Pragma("unroll") for (int k = 0; k < 2; ++k) \
        acc[ai][bj][m][n] = __builtin_amdgcn_mfma_f32_16x16x32_bf16(Bt[n][k], At[m][k], acc[ai][bj][m][n], 0, 0, 0); __builtin_amdgcn_s_setprio(0); } while (0)
#define PG8_WAIT_V(n) asm volatile("s_waitcnt vmcnt(" #n ")" ::: "memory")
#define PG8_WAIT_L(n) asm volatile("s_waitcnt lgkmcnt(" #n ")" ::: "memory")
#define PG8_BAR __builtin_amdgcn_s_barrier()
#define PG8_SCHED __builtin_amdgcn_sched_barrier(0)
    Unit cur, nxt; int ui = 0;
    if (!S.next(0, cur)) return;
    f32x4 acc[2][2][4][2];
#pragma unroll
    for (int a = 0; a < 2; ++a)
#pragma unroll
        for (int b = 0; b < 2; ++b)
#pragma unroll
            for (int m = 0; m < 4; ++m)
#pragma unroll
                for (int n = 0; n < 2; ++n) acc[a][b][m][n] = (f32x4){0.f, 0.f, 0.f, 0.f};
    bf16x8 At[4][2], B0[2][2], B1[2][2];
    const char* cA = (const char*)g.A + (size_t)cur.pm * tstep; const char* cB = (const char*)g.Bt + (size_t)cur.pn * tstep;
    S.a_ready(cur);
    if constexpr (SP2) {
        PG8_STAGE(PG8_SB(0, 0), cB, voffB); PG8_STAGE(PG8_SB(0, 1), cB + hstep, voffB); PG8_STAGE(PG8_SA(0, 0), cA, voffA); PG8_STAGE(PG8_SA(0, 1), cA + hstep, voffA);
        if (wr == 1) PG8_BAR;
        PG8_WAIT_V(2); PG8_BAR;
        PG8_STAGE(PG8_SB(1, 0), cB + kstep, voffB); PG8_STAGE(PG8_SA(1, 0), cA + kstep, voffA); PG8_STAGE(PG8_SB(1, 1), cB + hstep + kstep, voffB);
        PG8_WAIT_V(6); PG8_BAR;
    } else {
        PG8_STAGE(PG8_SB(0, 0), cB, voffB); PG8_STAGE(PG8_SA(0, 0), cA, voffA); PG8_STAGE(PG8_SB(0, 1), cB + hstep, voffB); PG8_STAGE(PG8_SA(0, 1), cA + hstep, voffA);
        if (wr == 1) PG8_BAR;
        PG8_WAIT_V(4); PG8_BAR;
        PG8_STAGE(PG8_SB(1, 0), cB + kstep, voffB); PG8_STAGE(PG8_SA(1, 0), cA + kstep, voffA); PG8_STAGE(PG8_SB(1, 1), cB + hstep + kstep, voffB);
        PG8_WAIT_V(6); PG8_BAR;
    }
    for (;;) {
        const bool has_next = S.next(ui + 1, nxt);
        const char* nA = has_next ? (const char*)g.A + (size_t)nxt.pm * tstep : cA; const char* nB = has_next ? (const char*)g.Bt + (size_t)nxt.pn * tstep : cB;
        for (int t = 0; t < nt; t += 2) {
            if constexpr (Epi::HAS_MID) { if (t == (nt >> 1)) { PG8_SCHED; E.mid(acc, cur, wr, wc, fr, fq); PG8_SCHED; } }
            const bool last = (t == nt - 2);
            const char* a1 = cA + (size_t)(t + 1) * kstep;
            const char* a2 = last ? nA : cA + (size_t)(t + 2) * kstep; const char* b2 = last ? nB : cB + (size_t)(t + 2) * kstep;
            const char* a3 = a2 + kstep; const char* b3 = b2 + kstep;
            if (last && has_next) S.a_ready(nxt);
            if constexpr (SP2) {
            PG8_LDB(B0, 0, 0); PG8_LDB(B1, 0, 1); PG8_SCHED; PG8_LDA(At, 0, 0); PG8_STAGE(PG8_SA(1, 1), a1 + hstep, voffA);
            PG8_WAIT_V(8); PG8_WAIT_L(0); PG8_BAR; PG8_MMA(0, 0, At, B0); PG8_MMA(0, 1, At, B1); PG8_BAR; PG8_SCHED;
            PG8_LDA(At, 0, 1); PG8_STAGE(PG8_SB(0, 0), b2, voffB); PG8_STAGE(PG8_SB(0, 1), b2 + hstep, voffB); PG8_STAGE(PG8_SA(0, 0), a2, voffA);
            PG8_WAIT_V(8); PG8_WAIT_L(0); PG8_BAR; PG8_MMA(1, 0, At, B0); PG8_MMA(1, 1, At, B1); PG8_BAR; PG8_SCHED;
            PG8_LDB(B0, 1, 0); PG8_LDB(B1, 1, 1); PG8_SCHED; PG8_LDA(At, 1, 0); PG8_STAGE(PG8_SA(0, 1), a2 + hstep, voffA);
            PG8_WAIT_V(8); PG8_WAIT_L(0); PG8_BAR; PG8_MMA(0, 0, At, B0); PG8_MMA(0, 1, At, B1); PG8_BAR; PG8_SCHED;
            PG8_LDA(At, 1, 1); PG8_STAGE(PG8_SB(1, 0), b3, voffB); PG8_STAGE(PG8_SB(1, 1), b3 + hstep, voffB); PG8_STAGE(PG8_SA(1, 0), a3, voffA);
            PG8_WAIT_V(8); PG8_WAIT_L(0); PG8_BAR; PG8_MMA(1, 0, At, B0); PG8_MMA(1, 1, At, B1); PG8_BAR; PG8_SCHED;
            } else {
            PG8_LDB(B0, 0, 0); PG8_SCHED; PG8_LDA(At, 0, 0); PG8_STAGE(PG8_SA(1, 1), a1 + hstep, voffA);
            PG8_WAIT_L(8); PG8_BAR; PG8_WAIT_L(0); PG8_MMA(0, 0, At, B0); PG8_BAR; PG8_SCHED;
            PG8_LDB(B1, 0, 1); PG8_STAGE(PG8_SB(0, 0), b2, voffB);
            PG8_BAR; PG8_WAIT_L(0); PG8_MMA(0, 1, At, B1); PG8_BAR;
            PG8_LDA(At, 0, 1); PG8_STAGE(PG8_SA(0, 0), a2, voffA);
            PG8_BAR; PG8_WAIT_L(0); PG8_MMA(1, 0, At, B0); PG8_BAR; PG8_SCHED;
            PG8_STAGE(PG8_SB(0, 1), b2 + hstep, voffB);
            PG8_WAIT_V(6); PG8_BAR; PG8_MMA(1, 1, At, B1); PG8_BAR;
            PG8_LDB(B0, 1, 0); PG8_SCHED; PG8_LDA(At, 1, 0); PG8_STAGE(PG8_SA(0, 1), a2 + hstep, voffA);
            PG8_WAIT_L(8); PG8_BAR; PG8_WAIT_L(0); PG8_MMA(0, 0, At, B0); PG8_BAR; PG8_SCHED;
            PG8_LDB(B1, 1, 1); PG8_STAGE(PG8_SB(1, 0), b3, voffB);
            PG8_BAR; PG8_WAIT_L(0); PG8_MMA(0, 1, At, B1); PG8_BAR;
            PG8_LDA(At, 1, 1); PG8_STAGE(PG8_SA(1, 0), a3, voffA);
            PG8_BAR; PG8_WAIT_L(0); PG8_MMA(1, 0, At, B0); PG8_BAR; PG8_SCHED;
            PG8_STAGE(PG8_SB(1, 1), b3 + hstep, voffB);
            PG8_WAIT_V(6); PG8_BAR; PG8_MMA(1, 1, At, B1); PG8_BAR;
            }
        }
        if constexpr (ALIGN_EPI) { if (wr == 0) PG8_BAR; }
        if constexpr (!Epi::AFTER_DRAIN) { E(acc, cur, wr, wc, fr, fq); S.done(cur); }
        if (!has_next) break;
#pragma unroll
        for (int a = 0; a < 2; ++a)
#pragma unroll
            for (int b = 0; b < 2; ++b)
#pragma unroll
                for (int m = 0; m < 4; ++m)
#pragma unroll
                    for (int n = 0; n < 2; ++n) acc[a][b][m][n] = (f32x4){0.f, 0.f, 0.f, 0.f};
        cur = nxt; cA = nA; cB = nB; ++ui;
        if constexpr (ALIGN_EPI) { if (wr == 1) PG8_BAR; }
    }
    PG8_WAIT_V(0);
    if constexpr (!ALIGN_EPI) { if (wr == 0) PG8_BAR; }
    PG8_BAR;
    if constexpr (Epi::AFTER_DRAIN) { E.fused(acc, cur, wr, wc, fr, fq, lds, wid, lane); S.done(cur); }
#undef PG8_SA
#undef PG8_SB
#undef PG8_STAGE
#undef PG8_LDA
#undef PG8_LDB
#undef PG8_MMA
#undef PG8_WAIT_V
#undef PG8_WAIT_L
#undef PG8_BAR
#undef PG8_SCHED
}
}

#include <hip/hip_bf16.h>
#include <cmath>
namespace attn_body {
using bf16=__hip_bfloat16;
using bf16x8=__attribute__((ext_vector_type(8)))short;
using s16x4=__attribute__((ext_vector_type(4)))short;
using f32x16=__attribute__((ext_vector_type(16)))float;
using u32x4=__attribute__((ext_vector_type(4)))unsigned;
constexpr int BATCH=4,NHEAD=16,SEQ=8192,D=64,DM=NHEAD*D;
constexpr int NW=8,QBLK=32,QB=QBLK*NW,KVBLK=64,NQB=SEQ/QB;
constexpr int ATTN_PITCH=DM, ATTN_UNIT_ROWS=QB;
__device__ __forceinline__ int crow(int r,int hi){return (r&3)+8*(r>>2)+4*hi;}
#define SBAR() __builtin_amdgcn_sched_barrier(0)
typedef __attribute__((address_space(3))) const float* lds_fptr;
__device__ __forceinline__ void bmask(f32x16&p0,f32x16&p1,int jb,int qrel,int hi,lds_fptr tab){
  const float NEG=-INFINITY; const int nb=qrel-64*jb-4*hi;
  #pragma unroll
  for(int r=0;r<16;++r){ const int n0=nb-((r&3)+8*(r>>2)), n1=n0-32;
    const int i0=n0<0?0:(n0>127?127:n0), i1=n1<0?0:(n1>127?127:n1);
    const float t0=tab[i0], t1=tab[i1];
    p0[r]=n0<0?NEG:p0[r]+t0; p1[r]=n1<0?NEG:p1[r]+t1; }
}
constexpr int NSLOT=3, SLOTB=8192;
constexpr int LDS_K=0, LDS_V=NSLOT*SLOTB, LDS_WS=2*NSLOT*SLOTB, LDS_OST=LDS_WS+NW*64*4, LDS_BYTES=LDS_OST+NW*4096;
constexpr float C2=0.125f*1.4426950408889634f;
__device__ __forceinline__ void glds16(const void*gsrc,unsigned lds_dst){unsigned keep;
  asm volatile("s_mov_b32 %0, m0\n\ts_mov_b32 m0, %2\n\ts_nop 0\n\tglobal_load_lds_dwordx4 %1, off\n\ts_mov_b32 m0, %0":"=&s"(keep):"v"(gsrc),"s"(lds_dst):"memory");}
__device__ __forceinline__ float max3f(float a,float b,float c){float r;asm("v_max3_f32 %0, %1, %2, %3":"=v"(r):"v"(a),"v"(b),"v"(c));return r;}
__device__ __forceinline__ float max2f(float a,float b){float r;asm("v_max_f32_e32 %0, %1, %2":"=v"(r):"v"(a),"v"(b));return r;}
__device__ __forceinline__ float fadd_s(float a,float b){float r;asm("v_add_f32_e32 %0, %1, %2":"=v"(r):"v"(a),"v"(b));return r;}
__device__ __forceinline__ float fsub_s(float a,float b){float r;asm("v_sub_f32_e32 %0, %1, %2":"=v"(r):"v"(a),"v"(b));return r;}
typedef float f32x2_t __attribute__((ext_vector_type(2))); typedef __bf16 bf16x2_t __attribute__((ext_vector_type(2)));
__device__ __forceinline__ unsigned cvtpk_s(float lo,float hi){f32x2_t v={lo,hi};bf16x2_t b=__builtin_convertvector(v,bf16x2_t);return __builtin_bit_cast(unsigned,b);}
#define WAIT_BAR(N) asm volatile("s_waitcnt vmcnt(" #N ") lgkmcnt(0)\n\ts_barrier":::"memory")

__device__ __forceinline__ void qkt(f32x16&p0,f32x16&p1,const char*Kslot,const bf16x8*qr,const f32x16&negm,int r32,int hi){
  const char*kb=Kslot+hi*1024+r32*16;
  #pragma unroll
  for(int d0=0;d0<4;++d0){
    const bf16x8 b0=*reinterpret_cast<const bf16x8*>(kb+d0*2048);
    const bf16x8 b1=*reinterpret_cast<const bf16x8*>(kb+d0*2048+512);
    if(d0==0){p0=__builtin_amdgcn_mfma_f32_32x32x16_bf16(b0,qr[0],negm,0,0,0);p1=__builtin_amdgcn_mfma_f32_32x32x16_bf16(b1,qr[0],negm,0,0,0);}
    else{p0=__builtin_amdgcn_mfma_f32_32x32x16_bf16(b0,qr[d0],p0,0,0,0);p1=__builtin_amdgcn_mfma_f32_32x32x16_bf16(b1,qr[d0],p1,0,0,0);}}
}
typedef __attribute__((address_space(3))) const char* lds_cptr;
typedef short v4i16_t __attribute__((ext_vector_type(4)));
__device__ __forceinline__ void kload8(bf16x8*kf,lds_cptr kp){
  kf[0]=*(const __attribute__((address_space(3))) bf16x8*)(kp);      kf[1]=*(const __attribute__((address_space(3))) bf16x8*)(kp+512);
  kf[2]=*(const __attribute__((address_space(3))) bf16x8*)(kp+2048); kf[3]=*(const __attribute__((address_space(3))) bf16x8*)(kp+2560);
  kf[4]=*(const __attribute__((address_space(3))) bf16x8*)(kp+4096); kf[5]=*(const __attribute__((address_space(3))) bf16x8*)(kp+4608);
  kf[6]=*(const __attribute__((address_space(3))) bf16x8*)(kp+6144); kf[7]=*(const __attribute__((address_space(3))) bf16x8*)(kp+6656);
}
__device__ __forceinline__ void kload2(bf16x8*kf,lds_cptr kp,int j){ kf[2*j]=*(const __attribute__((address_space(3))) bf16x8*)(kp+j*2048); kf[2*j+1]=*(const __attribute__((address_space(3))) bf16x8*)(kp+j*2048+512); }
__device__ __forceinline__ s16x4 vtr(lds_cptr p){ return __builtin_bit_cast(s16x4,__builtin_amdgcn_ds_read_tr16_b64_v4i16((__attribute__((address_space(3))) v4i16_t*)p)); }
__device__ __forceinline__ float rowmax(const f32x16&p0,const f32x16&p1){
  float a=max3f(p0[0],p0[1],p1[0]),b=max3f(p0[2],p0[3],p1[1]);a=max3f(a,p1[2],p1[3]);
  #pragma unroll
  for(int r=4;r<16;r+=4){a=max3f(a,p0[r],p0[r+1]);b=max3f(b,p0[r+2],p0[r+3]);a=max3f(a,p1[r],p1[r+1]);b=max3f(b,p1[r+2],p1[r+3]);}
  const float m=max2f(a,b);
  auto rr=__builtin_amdgcn_permlane32_swap(__float_as_uint(m),__float_as_uint(m),false,false);
  return max2f(__uint_as_float(rr[0]),__uint_as_float(rr[1]));
}
__device__ __forceinline__ void pv(f32x16*o,int vb,bf16x8 pa0,bf16x8 pa1,bf16x8 pa2,bf16x8 pa3){
  #pragma unroll
  for(int d0=0;d0<2;++d0){s16x4 lo[4],hi[4];
    #pragma unroll
    for(int ks=0;ks<4;++ks){
      asm volatile("ds_read_b64_tr_b16 %0,%1 offset:%c2":"=&v"(lo[ks]):"v"(vb),"i"(d0*4096+ks*1024):"memory");
      asm volatile("ds_read_b64_tr_b16 %0,%1 offset:%c2":"=&v"(hi[ks]):"v"(vb),"i"(d0*4096+ks*1024+512):"memory");}
    asm volatile("s_waitcnt lgkmcnt(0)":::"memory");SBAR();
    #define PK(k) (bf16x8){lo[k][0],lo[k][1],lo[k][2],lo[k][3],hi[k][0],hi[k][1],hi[k][2],hi[k][3]}
    o[d0]=__builtin_amdgcn_mfma_f32_32x32x16_bf16(pa0,PK(0),o[d0],0,0,0);
    o[d0]=__builtin_amdgcn_mfma_f32_32x32x16_bf16(pa1,PK(1),o[d0],0,0,0);
    o[d0]=__builtin_amdgcn_mfma_f32_32x32x16_bf16(pa2,PK(2),o[d0],0,0,0);
    o[d0]=__builtin_amdgcn_mfma_f32_32x32x16_bf16(pa3,PK(3),o[d0],0,0,0);
    #undef PK
  }
}

#ifndef ATTN_STORE16
#define ATTN_STORE16(p,v) (*(u32x4*)(p)=(v))
#endif
template<int THRL> __device__ __forceinline__ void attn_unit(int b,int hq,int hv,int qb,const bf16*Q,const bf16*__restrict__ K,const bf16*__restrict__ V,bf16*O,char*shm,lds_fptr tab,int wid_in){
  int lane; asm volatile("v_mbcnt_lo_u32_b32 %0, -1, 0\n\tv_mbcnt_hi_u32_b32 %0, -1, %0" : "=v"(lane)); const int r32=lane&31,hi=lane>>5; const int wid=wid_in;
  const long rowbase=(long)b*SEQ; const int q0=qb*QB;
  const bf16*Qw=Q+(rowbase+q0+wid*QBLK)*DM+hq*D;
  const bf16*Kh=K+rowbase*DM+hq*D,*Vh=V+rowbase*DM+hv*D;
  const unsigned lds0=(unsigned)(uintptr_t)shm;
  float*wsf=(float*)(shm+LDS_WS)+wid*64;
  const bf16*ksrc=Kh+(long)lane*DM+wid*8;
  const bf16*vsrc=Vh+(long)(16*(wid&3)+(lane>>2))*DM+(wid>>2)*32+(lane&3)*8;
  const unsigned kdst=lds0+LDS_K+wid*1024, vdst=lds0+LDS_V+wid*1024;
  #define DMA_K(t,slot) glds16(ksrc+(long)(t)*KVBLK*DM,(unsigned)__builtin_amdgcn_readfirstlane(kdst+(slot)))
  #define DMA_V(t,slot) glds16(vsrc+(long)(t)*KVBLK*DM,(unsigned)__builtin_amdgcn_readfirstlane(vdst+(slot)))
  const int vb0=(int)(lds0+LDS_V)+((lane>>4)&1)*32+(lane&3)*8+(4*hi+((lane&15)>>2))*64;
  const char*Kbase=shm+LDS_K; bf16x8 kf[8];
  const lds_cptr shm3=(lds_cptr)shm; const lds_cptr kp0=shm3+LDS_K+hi*1024+r32*16; const lds_cptr vp0=shm3+LDS_V+((lane>>4)&1)*32+(lane&3)*8+(4*hi+((lane&15)>>2))*64;
  const int NT=(q0+QB)/KVBLK;
  DMA_K(0,0);DMA_V(0,0);DMA_K(1,SLOTB);
  bf16x8 qr[4];
  #pragma unroll
  for(int d0=0;d0<4;++d0)qr[d0]=*reinterpret_cast<const bf16x8*>(&Qw[(long)r32*DM+d0*16+hi*8]);
  float mhat=0.f,l_reg=0.f;f32x16 o[2],negm; { float z_; asm volatile("v_mov_b32 %0, 0":"=v"(z_)); _Pragma("unroll") for(int r=0;r<16;++r){o[0][r]=z_;o[1][r]=z_;negm[r]=z_;} } asm volatile("":"+v"(negm));
  const int qrel=wid*QBLK+r32;
  #define CMASK(P0,P1,t) do{int jb_=(t)-(NT-4); if(jb_>=-2)bmask(P0,P1,jb_,qrel,hi,tab);}while(0)
  bool resc=false;
  #define START(P0,P1) do{ const float rm=rowmax(P0,P1); resc=false; \
    { const float dl=rm; mhat=fadd_s(mhat,dl); \
      _Pragma("unroll") for(int r=0;r<16;++r){P0[r]=fsub_s(P0[r],dl);P1[r]=fsub_s(P1[r],dl);} \
      _Pragma("unroll") for(int r=0;r<16;++r)negm[r]=-mhat; asm volatile("":"+v"(negm)); } \
    _Pragma("unroll") for(int r=0;r<16;++r)P0[r]=__builtin_amdgcn_exp2f(P0[r]); }while(0)
  #define RESC() do{ if(resc){ asm volatile("s_waitcnt lgkmcnt(0)":::"memory"); \
      _Pragma("unroll") for(int d_=0;d_<2;++d_) _Pragma("unroll") for(int r=0;r<16;++r)o[d_][r]*=wsf[crow(r,hi)]; } }while(0)
  f32x16 pA0,pA1,pB0,pB1;
  int sl_prev=0,sl_cur=0,sl_next=SLOTB;
  #define ROT() do{sl_prev=sl_cur;sl_cur=sl_next;sl_next=(sl_next==(NSLOT-1)*SLOTB)?0:sl_next+SLOTB;}while(0)
  DMA_K(2,2*SLOTB);
  WAIT_BAR(3);
  qkt(pA0,pA1,Kbase,qr,negm,r32,hi);asm volatile("s_nop 15\n\ts_nop 7":"+v"(pA0),"+v"(pA1));CMASK(pA0,pA1,0);
  START(pA0,pA1);
  _Pragma("unroll") for(int r=0;r<16;++r)pA1[r]=__builtin_amdgcn_exp2f(pA1[r]);
  WAIT_BAR(0);
  DMA_K(3,0);DMA_V(1,SLOTB);
  ROT();
  kload8(kf,kp0+sl_cur);
  WAIT_BAR(2);
  s16x4 vlo[8],vhi[8]; u32x4 pw0,pw1,pw2,pw3;
  #define PKW(P,B) cvtpk_s(P[B],P[B+1])
  #define PAF(k) __builtin_bit_cast(bf16x8,pw##k)
  #define VFR(i) (bf16x8){vlo[i][0],vlo[i][1],vlo[i][2],vlo[i][3],vhi[i][0],vhi[i][1],vhi[i][2],vhi[i][3]}
  #define PIN(x) asm volatile("":"+v"(x))
  #define MX3(a,b,c) __builtin_fmaxf(__builtin_fmaxf((a),(b)),(c))
  #define GAPA(MF,A0,A1,A2,A3,W0,W1,PW) do{ MF; sacc+=A0; sacc+=A1; sacc+=A2; sacc+=A3; PIN(sacc); W0; W1; PIN(PW); SBAR(); }while(0)
  #define EX(v) __builtin_amdgcn_exp2f(v)
  #define GAPB(MF,X,B) do{ MF; X[B]=EX(X[B]); X[B+1]=EX(X[B+1]); X[B+2]=EX(X[B+2]); X[B+3]=EX(X[B+3]); PIN(X); SBAR(); }while(0)
  #define VRD(i) do{ vlo[i]=vtr(vp_+(((i)>>2)*4096+((i)&3)*1024)); vhi[i]=vtr(vp_+(((i)>>2)*4096+((i)&3)*1024+512)); }while(0)
  #define KRD(G,j) do{ if(G){ kload2(kf,kp0+sl_next,j); SBAR(); } }while(0)
  #define STEP(C0,C1,P0,P1,t,GK,GV,GL) do{ SBAR(); \
    const lds_cptr vp_=vp0+sl_prev; \
    VRD(0); SBAR(); float sacc=(P0[0]+P0[1]); \
    GAPA(C0=__builtin_amdgcn_mfma_f32_32x32x16_bf16(kf[0],qr[0],negm,0,0,0), P0[2],P0[3],P0[4],P0[5],     pw0[0]=PKW(P0,0), pw0[1]=PKW(P0,2), pw0); \
    VRD(4); SBAR(); GAPA(C1=__builtin_amdgcn_mfma_f32_32x32x16_bf16(kf[1],qr[0],negm,0,0,0), P0[6],P0[7],P0[8],P0[9],     pw0[2]=PKW(P0,4), pw0[3]=PKW(P0,6), pw0); \
    VRD(1); SBAR(); GAPA(C0=__builtin_amdgcn_mfma_f32_32x32x16_bf16(kf[2],qr[1],C0,0,0,0),   P0[10],P0[11],P0[12],P0[13], pw1[0]=PKW(P0,8), pw1[1]=PKW(P0,10), pw1); \
    VRD(5); SBAR(); GAPA(C1=__builtin_amdgcn_mfma_f32_32x32x16_bf16(kf[3],qr[1],C1,0,0,0),   P0[14],P0[15],P1[0],P1[1],   pw1[2]=PKW(P0,12),pw1[3]=PKW(P0,14), pw1); \
    VRD(2); SBAR(); GAPA(C0=__builtin_amdgcn_mfma_f32_32x32x16_bf16(kf[4],qr[2],C0,0,0,0),   P1[2],P1[3],P1[4],P1[5],     pw2[0]=PKW(P1,0), pw2[1]=PKW(P1,2), pw2); \
    VRD(6); SBAR(); GAPA(C1=__builtin_amdgcn_mfma_f32_32x32x16_bf16(kf[5],qr[2],C1,0,0,0),   P1[6],P1[7],P1[8],P1[9],     pw2[2]=PKW(P1,4), pw2[3]=PKW(P1,6), pw2); \
    VRD(3); SBAR(); GAPA(C0=__builtin_amdgcn_mfma_f32_32x32x16_bf16(kf[6],qr[3],C0,0,0,0),   P1[10],P1[11],P1[12],P1[13], pw3[0]=PKW(P1,8), pw3[1]=PKW(P1,10), pw3); \
    VRD(7); SBAR(); GAPA(C1=__builtin_amdgcn_mfma_f32_32x32x16_bf16(kf[7],qr[3],C1,0,0,0),   P1[14],P1[15],0.f,0.f,       pw3[2]=PKW(P1,12),pw3[3]=PKW(P1,14), pw3); \
    l_reg+=sacc; \
    if(GK){DMA_K((t)+3,sl_cur);} if(GV){DMA_V((t)+1,sl_next);} \
    CMASK(C0,C1,t); \
    { float a=MX3(C0[0],C0[1],C1[0]),b=MX3(C0[2],C0[3],C1[1]); a=MX3(a,C1[2],C1[3]); \
      _Pragma("unroll") for(int r=4;r<16;r+=4){a=MX3(a,C0[r],C0[r+1]);b=MX3(b,C0[r+2],C0[r+3]);a=MX3(a,C1[r],C1[r+1]);b=MX3(b,C1[r+2],C1[r+3]);} \
      float rm=__builtin_fmaxf(a,b); { auto rr=__builtin_amdgcn_permlane32_swap(__float_as_uint(rm),__float_as_uint(rm),false,false); rm=__builtin_fmaxf(__uint_as_float(rr[0]),__uint_as_float(rr[1])); } \
      resc=false; \
      if(__builtin_expect(__any(rm>(float)THRL),0)){ const float dl=__builtin_fmaxf(rm,0.f); mhat+=dl; \
        _Pragma("unroll") for(int r=0;r<16;++r){C0[r]-=dl;C1[r]-=dl;} \
        _Pragma("unroll") for(int r=0;r<16;++r)negm[r]=-mhat; asm volatile("":"+v"(negm)); \
        const float f=__builtin_amdgcn_exp2f(-dl); l_reg*=f; if(hi==0)wsf[r32]=f; resc=true; } } \
    SBAR(); \
    GAPB(o[0]=__builtin_amdgcn_mfma_f32_32x32x16_bf16(PAF(0),VFR(0),o[0],0,0,0), C0,0); \
    GAPB(o[1]=__builtin_amdgcn_mfma_f32_32x32x16_bf16(PAF(0),VFR(4),o[1],0,0,0), C0,4); \
    KRD(GL,0); GAPB(o[0]=__builtin_amdgcn_mfma_f32_32x32x16_bf16(PAF(1),VFR(1),o[0],0,0,0), C0,8); \
    KRD(GL,1); GAPB(o[1]=__builtin_amdgcn_mfma_f32_32x32x16_bf16(PAF(1),VFR(5),o[1],0,0,0), C0,12); \
    KRD(GL,2); GAPB(o[0]=__builtin_amdgcn_mfma_f32_32x32x16_bf16(PAF(2),VFR(2),o[0],0,0,0), C1,0); \
    KRD(GL,3); GAPB(o[1]=__builtin_amdgcn_mfma_f32_32x32x16_bf16(PAF(2),VFR(6),o[1],0,0,0), C1,4); \
    GAPB(o[0]=__builtin_amdgcn_mfma_f32_32x32x16_bf16(PAF(3),VFR(3),o[0],0,0,0), C1,8); \
    GAPB(o[1]=__builtin_amdgcn_mfma_f32_32x32x16_bf16(PAF(3),VFR(7),o[1],0,0,0), C1,12); \
    }while(0)
  int t=1;
  #undef CMASK
  #define CMASK(P0,P1,t) do{}while(0)
  for(;t+7<NT;t+=2){
    STEP(pB0,pB1,pA0,pA1,t,true,true,true);     WAIT_BAR(2); RESC(); ROT();
    STEP(pA0,pA1,pB0,pB1,t+1,true,true,true);   WAIT_BAR(2); RESC(); ROT();
  }
  #undef CMASK
  #define CMASK(P0,P1,t) do{int jb_=(t)-(NT-4); if(jb_>=-2)bmask(P0,P1,jb_,qrel,hi,tab);}while(0)
  #define ENDW(tt) do{ if((tt)+3<NT){WAIT_BAR(2);} else if((tt)+2<NT){WAIT_BAR(1);} else {WAIT_BAR(0);} }while(0)
  for(;t+1<NT;t+=2){
    STEP(pB0,pB1,pA0,pA1,t,(t+3<NT),(t+1<NT),(t+1<NT));       ENDW(t);   RESC(); ROT();
    STEP(pA0,pA1,pB0,pB1,t+1,(t+4<NT),(t+2<NT),(t+2<NT));     ENDW(t+1); RESC(); ROT();
  }
  STEP(pB0,pB1,pA0,pA1,NT-1,false,false,false); RESC();
  { float sacc=pB0[0]+pB0[1]; _Pragma("unroll") for(int r=2;r<16;++r)sacc+=pB0[r]; _Pragma("unroll") for(int r=0;r<16;++r)sacc+=pB1[r]; l_reg+=sacc;
    pw0=(u32x4){PKW(pB0,0),PKW(pB0,2),PKW(pB0,4),PKW(pB0,6)};pw1=(u32x4){PKW(pB0,8),PKW(pB0,10),PKW(pB0,12),PKW(pB0,14)};pw2=(u32x4){PKW(pB1,0),PKW(pB1,2),PKW(pB1,4),PKW(pB1,6)};pw3=(u32x4){PKW(pB1,8),PKW(pB1,10),PKW(pB1,12),PKW(pB1,14)};
    SBAR(); pv(o,vb0+sl_cur,PAF(0),PAF(1),PAF(2),PAF(3)); }
  #undef PKW
  #undef PAF
  #undef VFR
  #undef PIN
  #undef MX3
  #undef GAPA
  #undef GAPB
  #undef EX
  #undef VRD
  #undef KRD
  #undef STEP
  #undef ENDW
  {auto rr=__builtin_amdgcn_permlane32_swap(__float_as_uint(l_reg),__float_as_uint(l_reg),false,false);l_reg=__uint_as_float(rr[0])+__uint_as_float(rr[1]);}
  if(hi==0)wsf[32+r32]=l_reg;asm volatile("s_waitcnt lgkmcnt(0)":::"memory");
  float rli[16];
  #pragma unroll
  for(int r=0;r<16;++r)rli[r]=__builtin_amdgcn_rcpf(wsf[32+crow(r,hi)]);
  bf16*Ow=O+(rowbase+q0+wid*QBLK)*DM+hv*D;
  { bf16*stg=(bf16*)(shm+LDS_OST)+wid*2048;
    #pragma unroll
    for(int r=0;r<16;++r){const int orow=crow(r,hi);
      #pragma unroll
      for(int d0=0;d0<2;++d0)stg[orow*64+d0*32+r32]=__float2bfloat16(o[d0][r]*rli[r]);}
    asm volatile("s_waitcnt lgkmcnt(0)":::"memory");
    #pragma unroll
    for(int i=0;i<4;++i){const int row=i*8+(lane>>3),ch=lane&7; const u32x4 v=*(const u32x4*)(stg+row*64+ch*8); ATTN_STORE16(Ow+(long)row*DM+ch*8,v);} }
  asm volatile("s_waitcnt lgkmcnt(0)\n\ts_barrier":::"memory");
  #undef DMA_K
  #undef DMA_V
  #undef CMASK
  #undef START
  #undef RESC
  #undef ROT
}
constexpr int ATTN_LDS_BYTES=LDS_BYTES;
#undef SBAR
#undef WAIT_BAR
}

#define GAS __attribute__((address_space(1)))
#define LAS __attribute__((address_space(3)))
typedef unsigned short bf16;
typedef unsigned v4u __attribute__((ext_vector_type(4)));
typedef float f32x4 __attribute__((ext_vector_type(4)));
typedef short bf16x8 __attribute__((ext_vector_type(8)));
typedef GAS unsigned gu32;
typedef GAS unsigned long long gu64;
#define RLX_AGENT __ATOMIC_RELAXED, __HIP_MEMORY_SCOPE_AGENT
#define LDS_WAIT() asm volatile("s_waitcnt lgkmcnt(0)" ::: "memory")
#define VM_WAIT() asm volatile("s_waitcnt vmcnt(0)" ::: "memory")
__device__ __forceinline__ unsigned long long rt() { return __builtin_amdgcn_s_memrealtime(); }
__device__ __forceinline__ unsigned f2bf(float f) { unsigned u = __builtin_bit_cast(unsigned, f); return (u + 0x7fffu + ((u >> 16) & 1u)) >> 16; }
__device__ __forceinline__ unsigned pk2(float lo, float hi) { return f2bf(lo) | (f2bf(hi) << 16); }

#define XB_TMO      128
#define XB_XCNT(j)  (256  + 64 * (j))
#define XB_XSUB(j)  (1280 + 64 * (j))
#define XB_XGEN(j)  (2304 + 64 * (j))
#define XB_TOP      3328
#define XB_TOPGEN   3392
#define XCD_BAR_WORDS 3456
#define XB_SPIN_CAP (1u << 18)

__device__ __forceinline__ unsigned xb_ld(unsigned* p)              { return __hip_atomic_load(p, __ATOMIC_RELAXED, __HIP_MEMORY_SCOPE_AGENT); }
__device__ __forceinline__ unsigned xb_add(unsigned* p, unsigned v) { return __hip_atomic_fetch_add(p, v, __ATOMIC_RELAXED, __HIP_MEMORY_SCOPE_AGENT); }
__device__ __forceinline__ unsigned xb_xcc_id() { return (unsigned)__builtin_amdgcn_s_getreg((3 << 11) | 20) & 0xFu; }
#define XB_SPIN(cond, bar) do { unsigned _sp = 0; while (cond) { __builtin_amdgcn_s_sleep(1); \
    if ((++_sp & 255u) == 0u) { if (xb_ld(&(bar)[XB_TMO])) break; if (_sp > XB_SPIN_CAP) { atomicAdd(&(bar)[XB_TMO], 1u); break; } } } } while (0)

struct XcdBarrier {
    unsigned* bar; unsigned x;
    volatile LAS unsigned* st;
};

__device__ __forceinline__ XcdBarrier xcd_barrier_post(unsigned* bar, volatile LAS unsigned* st) {
    XcdBarrier b; b.bar = bar; b.x = xb_xcc_id(); b.st = st;
    if (threadIdx.x == 0) (void)xb_add(&bar[XB_XCNT(b.x)], 1u);
    return b;
}
__device__ __forceinline__ void xcd_barrier_complete(unsigned* bar, unsigned x, unsigned& nloc, unsigned& nx) {
    const unsigned G = gridDim.x * gridDim.y * gridDim.z;
    unsigned sum, cnt, mine, sp = 0u;
    for (;;) {
        sum = 0u; cnt = 0u; mine = 0u;
#pragma unroll
        for (unsigned j = 0; j < 16; ++j) { const unsigned c = xb_ld(&bar[XB_XCNT(j)]); sum += c; cnt += (c > 0u) ? 1u : 0u; mine = (j == x) ? c : mine; }
        if (sum == G) break;
        __builtin_amdgcn_s_sleep(1);
        if ((++sp & 255u) == 0u) { if (xb_ld(&bar[XB_TMO])) break; if (sp > XB_SPIN_CAP) { atomicAdd(&bar[XB_TMO], 1u); break; } }
    }
    nloc = mine > 0u ? mine : 1u; nx = cnt > 0u ? cnt : 1u;
}

__device__ __forceinline__ void xcd_barrier(const XcdBarrier& b, const bool leader) {
    asm volatile("s_waitcnt vmcnt(0)" ::: "memory");
    __syncthreads();
    if (leader) {
        unsigned* bar = b.bar;
        __builtin_amdgcn_s_waitcnt(0);
        unsigned nloc = b.st[0], nx = b.st[1];
        if (nloc == 0u) { xcd_barrier_complete(bar, b.x, nloc, nx); b.st[0] = nloc; b.st[1] = nx; }
        const unsigned old = xb_add(&bar[XB_XSUB(b.x)], 1u);
        const unsigned gen = old / nloc;
        if (old + 1u == (gen + 1u) * nloc) {
            __builtin_amdgcn_fence(__ATOMIC_RELEASE, "agent");
            asm volatile("s_waitcnt vmcnt(0)" ::: "memory");
            const unsigned og = xb_add(&bar[XB_TOP], 1u);
            const unsigned tg = og / nx;
            if (og + 1u == (tg + 1u) * nx) xb_add(&bar[XB_TOPGEN], 1u);
            else XB_SPIN(xb_ld(&bar[XB_TOPGEN]) == tg, bar);
            __builtin_amdgcn_fence(__ATOMIC_ACQUIRE, "agent");
            xb_add(&bar[XB_XGEN(b.x)], 1u);
            asm volatile("s_waitcnt vmcnt(0)" ::: "memory");
        } else {
            XB_SPIN(xb_ld(&bar[XB_XGEN(b.x)]) == gen, bar);
            __builtin_amdgcn_fence(__ATOMIC_ACQUIRE, "agent");
            asm volatile("s_waitcnt vmcnt(0)" ::: "memory");
        }
    }
    __syncthreads();
}


constexpr int NWAVES = 8;
constexpr int RING_OFF = 0, RING_BYTES = 131072;
constexpr int LDSCTL_OFF = RING_BYTES, MISC_OFF = LDSCTL_OFF + 320;
constexpr int LDS_BYTES = 147456;
constexpr int ATT_TAB_OFF = 86016;
static_assert(attn_body::ATTN_LDS_BYTES <= ATT_TAB_OFF && ATT_TAB_OFF + 4096 <= RING_BYTES, "attention LDS map");
constexpr int CW_TMO = 0, CW_CODE = 1, CW_BAR = 4096;
static_assert((CW_BAR + XCD_BAR_WORDS) * 4 <= (int)CTL_ZERO_BYTES, "control words inside the memset region");
constexpr int N_PHASES = 9;
#ifndef MK_ALIGN
#define MK_ALIGN false
#endif
#ifndef MK_SP2
#define MK_SP2 false
#endif

__device__ __forceinline__ float wave_sum(float v) {
#pragma unroll
    for (int o = 1; o < 64; o <<= 1) v += __shfl_xor(v, o);
    return v;
}
__device__ __forceinline__ float sigm(float x) { return __builtin_amdgcn_rcpf(1.0f + __builtin_amdgcn_exp2f(-1.4426950408889634f * x)); }

__device__ __forceinline__ void p0_transpose_item(const float* W, int N, bf16* WT, int ldt, int koff, LAS float* scr, int item, int lane, int rot = 0) {
    const int nblk = N / 32, kb = item / nblk, nb = item % nblk, k0 = 64 * kb, n0 = 32 * nb;
#pragma unroll 8
    for (int i = 0; i < 32; ++i) { const int kk = 2 * i + (lane >> 5); scr[kk * 33 + (lane & 31)] = W[(size_t)(k0 + kk) * N + n0 + (lane & 31)]; }
    LDS_WAIT(); asm volatile("" ::: "memory");
    const int c = lane & 7;
#pragma unroll
    for (int j = 0; j < 4; ++j) { const int n = (lane >> 3) + 8 * j; const LAS float* s = scr + (8 * c) * 33 + n;
        v4u o; o.x = pk2(s[0 * 33], s[1 * 33]); o.y = pk2(s[2 * 33], s[3 * 33]); o.z = pk2(s[4 * 33], s[5 * 33]); o.w = pk2(s[6 * 33], s[7 * 33]);
        *(GAS v4u*)(WT + (size_t)((n0 + n + rot) & (N - 1)) * ldt + koff + k0 + 8 * c) = o; }
    LDS_WAIT(); asm volatile("" ::: "memory");
}

__device__ __forceinline__ void rnn_phase(LAS unsigned char* lds, int vcu, int lane, int wave, const bf16* RX, bf16* YA, const float* conv_w, const float* conv_b,
                                          const float* w_a, const float* b_a, const float* w_x, const float* b_x, const float* lam) {
    const int b = vcu >> 6, hb = (vcu >> 2) & 15, qd = vcu & 3, fr = lane & 15, fq = lane >> 4;
    const int cin0 = hb * 64, co = hb * 64 + qd * 16 + fr;
    bf16x8 Ba[2], Bx[2], Bs[2];
#pragma unroll
    for (int ks = 0; ks < 2; ++ks)
#pragma unroll
        for (int j = 0; j < 8; ++j) { const int i = 32 * ks + 8 * fq + j, jo = qd * 16 + fr;
            Ba[ks][j] = (short)f2bf(w_a[(size_t)hb * 4096 + i * 64 + jo]); Bx[ks][j] = (short)f2bf(w_x[(size_t)hb * 4096 + i * 64 + jo]); Bs[ks][j] = (i == jo) ? (short)0x3f80 : (short)0; }
    float cw[2][4][8], cb[2][8];
#pragma unroll
    for (int ks = 0; ks < 2; ++ks)
#pragma unroll
        for (int j = 0; j < 8; ++j) { const int ch = cin0 + 32 * ks + 8 * fq + j; cb[ks][j] = conv_b[ch];
#pragma unroll
            for (int tp = 0; tp < 4; ++tp) cw[ks][tp][j] = conv_w[tp * 1024 + ch]; }
    const float bav = b_a[co], bxv = b_x[co]; const float logu = -8.0f * log1pf(expf(-lam[co]));
    float hsc = 0.f;
    LAS float* tot = (LAS float*)lds;
    const bf16* RXb = RX + (size_t)b * SEQ * 1024 + cin0 + 8 * fq;
    bf16* YAb = YA + (size_t)b * SEQ * 2048 + co;
    for (int sc = 0; sc < SEQ / 512; ++sc) {
        const int t0 = sc * 512 + wave * 64;
        unsigned short rg[4][4];
#pragma unroll
        for (int m = 0; m < 4; ++m)
#pragma unroll
            for (int r = 0; r < 4; ++r) rg[m][r] = YAb[(size_t)(t0 + 16 * m + 4 * fq + r) * 2048];
        float hl[4][4], ac[4][4]; float Ach = 1.f, Hch = 0.f;
#pragma unroll
        for (int m = 0; m < 4; ++m) {
            const int tok = t0 + 16 * m + fr;
            bf16x8 Af[2];
#pragma unroll
            for (int ks = 0; ks < 2; ++ks) {
                float xc[8];
#pragma unroll
                for (int j = 0; j < 8; ++j) xc[j] = cb[ks][j];
#pragma unroll
                for (int tp = 0; tp < 4; ++tp) { const int tt = tok - 3 + tp; v4u xr = (v4u){0u, 0u, 0u, 0u};
                    if (tt >= 0) xr = *(const GAS v4u*)(RXb + (size_t)tt * 1024 + 32 * ks);
                    xc[0] += cw[ks][tp][0] * __uint_as_float(xr.x << 16); xc[1] += cw[ks][tp][1] * __uint_as_float(xr.x & 0xffff0000u);
                    xc[2] += cw[ks][tp][2] * __uint_as_float(xr.y << 16); xc[3] += cw[ks][tp][3] * __uint_as_float(xr.y & 0xffff0000u);
                    xc[4] += cw[ks][tp][4] * __uint_as_float(xr.z << 16); xc[5] += cw[ks][tp][5] * __uint_as_float(xr.z & 0xffff0000u);
                    xc[6] += cw[ks][tp][6] * __uint_as_float(xr.w << 16); xc[7] += cw[ks][tp][7] * __uint_as_float(xr.w & 0xffff0000u); }
                v4u pk; pk.x = pk2(xc[0], xc[1]); pk.y = pk2(xc[2], xc[3]); pk.z = pk2(xc[4], xc[5]); pk.w = pk2(xc[6], xc[7]);
                Af[ks] = __builtin_bit_cast(bf16x8, pk);
            }
            f32x4 Dr = (f32x4){0.f, 0.f, 0.f, 0.f}, Di = Dr, Dx = Dr;
#pragma unroll
            for (int ks = 0; ks < 2; ++ks) { Dr = __builtin_amdgcn_mfma_f32_16x16x32_bf16(Af[ks], Ba[ks], Dr, 0, 0, 0); Di = __builtin_amdgcn_mfma_f32_16x16x32_bf16(Af[ks], Bx[ks], Di, 0, 0, 0);
                Dx = __builtin_amdgcn_mfma_f32_16x16x32_bf16(Af[ks], Bs[ks], Dx, 0, 0, 0); }
            float al[4], hh[4];
#pragma unroll
            for (int r = 0; r < 4; ++r) { const float rr = sigm(Dr[r] + bav), ii = sigm(Di[r] + bxv); const float la = rr * logu; const float a = __expf(la);
                const float bin = sqrtf(-expm1f(2.0f * la)) * (ii * Dx[r]);
                if (r == 0) { al[0] = a; hh[0] = bin; } else { al[r] = a * al[r - 1]; hh[r] = a * hh[r - 1] + bin; } }
            float Ai = al[3], Hi = hh[3];
            { const float Ap = __shfl_up(Ai, 16), Hp = __shfl_up(Hi, 16); if (fq >= 1) { Hi = Ai * Hp + Hi; Ai = Ai * Ap; } }
            { const float Ap = __shfl_up(Ai, 32), Hp = __shfl_up(Hi, 32); if (fq >= 2) { Hi = Ai * Hp + Hi; Ai = Ai * Ap; } }
            float Ae = __shfl_up(Ai, 16), He = __shfl_up(Hi, 16); if (fq == 0) { Ae = 1.f; He = 0.f; }
            const float hin = Ae * Hch + He, Ain = Ae * Ach;
#pragma unroll
            for (int r = 0; r < 4; ++r) { hl[m][r] = hh[r] + al[r] * hin; ac[m][r] = al[r] * Ain; }
            const float Am = __shfl(Ai, 48 + fr), Hm = __shfl(Hi, 48 + fr);
            Hch = Am * Hch + Hm; Ach = Am * Ach;
        }
        LAS float* tw = tot + ((sc & 1) * 8 + wave) * 32;
        if (fq == 0) { tw[fr * 2] = Ach; tw[fr * 2 + 1] = Hch; }
        asm volatile("s_waitcnt lgkmcnt(0)\n\ts_barrier" ::: "memory");
        float cin = 0.f, c = hsc;
#pragma unroll
        for (int w2 = 0; w2 < 8; ++w2) { const LAS float* tr = tot + ((sc & 1) * 8 + w2) * 32 + fr * 2; const float A = tr[0], H = tr[1]; if (w2 == wave) cin = c; c = A * c + H; }
        hsc = c;
#pragma unroll
        for (int m = 0; m < 4; ++m)
#pragma unroll
            for (int r = 0; r < 4; ++r) { const float h = hl[m][r] + ac[m][r] * cin;
                YAb[(size_t)(t0 + 16 * m + 4 * fq + r) * 2048] = (bf16)f2bf(h * __uint_as_float(((unsigned)rg[m][r]) << 16)); }
    }
    asm volatile("s_waitcnt lgkmcnt(0)\n\ts_barrier" ::: "memory");
}

__device__ __forceinline__ void attn_phase_diff(unsigned char* lds_generic, LAS unsigned char* lds, int vcu, int tid, int wave, const bf16* Q, const bf16* K, const bf16* V, bf16* O0, bf16* O1, const float* rel_bias) {
    LAS float* tab = (LAS float*)(lds + ATT_TAB_OFF);
    for (int e = tid; e < 1024; e += NWAVES * 64) { const int h = e >> 7, n = e & 127;
        int bk; if (n < 16) bk = n; else { bk = 16 + (int)(logf((float)n / 16.0f) / 2.0794415416798357f * 16.0f); bk = bk < 31 ? bk : 31; }
        tab[e] = (rel_bias[bk * 8 + h] - rel_bias[31 * 8 + h]) * 1.4426950408889634f; }
    asm volatile("s_waitcnt lgkmcnt(0)\n\ts_barrier" ::: "memory");
    const int g = vcu >> 3, s = vcu & 7, b = g >> 3, h = g & 7;
    for (int i = 0; i < 16; ++i) {
        const int sub = i >> 2, c = sub >> 1, vh = sub & 1, j = i & 3;
        const int qb = (j == 0) ? s : (j == 1) ? 15 - s : (j == 2) ? 16 + s : 31 - s;
        attn_body::attn_unit<8>(b, h * 2 + c, h * 2 + vh, qb, (const attn_body::bf16*)Q, (const attn_body::bf16*)K, (const attn_body::bf16*)V, (attn_body::bf16*)(c == 0 ? O0 : O1), (char*)lds_generic,
                                (attn_body::lds_fptr)(tab + h * 128), wave);
    }
}

struct Args { const float* in[23]; float* out; unsigned char* ws; int ph_lo, ph_hi; };
typedef const __attribute__((address_space(4))) Args* KArgs;
__device__ __forceinline__ KArgs kargs() { auto p = __builtin_amdgcn_kernarg_segment_ptr(); asm volatile("" : "+s"(p)); return (KArgs)p; }
__device__ __forceinline__ int lane_id() { int l; asm volatile("v_mbcnt_lo_u32_b32 %0, -1, 0\n\tv_mbcnt_hi_u32_b32 %0, -1, %0" : "=v"(l)); return l; }
__global__ void __launch_bounds__(NWAVES * 64, 2) mk_fwd(Args args) {
    extern __shared__ __attribute__((aligned(16))) unsigned char lds_[];
    LAS unsigned char* lds = (LAS unsigned char*)lds_;
    volatile LAS unsigned* MISC = (volatile LAS unsigned*)(lds + MISC_OFF);
    const int wave = __builtin_amdgcn_readfirstlane((int)threadIdx.x >> 6);
    const int G = gridDim.x; const int vcu = (G % 8 == 0) ? ((int)blockIdx.x % 8) * (G / 8) + (int)blockIdx.x / 8 : (int)blockIdx.x;
    const int gw = vcu * NWAVES + wave, NGW = G * NWAVES;
    gu32* ctl = (gu32*)(args.ws + WS_CTL);
    for (int u = threadIdx.x; u < (LDS_BYTES - LDSCTL_OFF) / 4; u += NWAVES * 64) ((LAS unsigned*)(lds + LDSCTL_OFF))[u] = 0u;
    __syncthreads();
    const int lo = args.ph_lo, hi = args.ph_hi;
    const bool use_bar = (hi - lo) > 1;
    XcdBarrier bar; bar.bar = (unsigned*)(ctl + CW_BAR); bar.x = 0; bar.st = nullptr;
    if (use_bar) bar = xcd_barrier_post((unsigned*)(ctl + CW_BAR), MISC + 8);
#define IN(k) (lo <= (k) && (k) < hi)
#define SEAM(k) do { if (IN(k) && IN((k) + 1)) xcd_barrier(bar, wave == 0 && lane_id() == 0); } while (0)

    if (IN(0)) {
        KArgs A = kargs(); const int lane = lane_id(), tid = wave * 64 + lane; (void)tid;
        const float* cvec = A->in[1];
        const float* w_ada = A->in[2];
        const float* b_ada = A->in[3];
        const float* w_in = A->in[4];
        const float* w_rnn_out = A->in[18];
        const float* w_attn_out = A->in[19];
        const float* w_out = A->in[20];
        float* modf = (float*)(A->ws + WS_MODF);
        bf16* win_t = (bf16*)(A->ws + WS_WIN);
        bf16* wcat_t = (bf16*)(A->ws + WS_WCAT);
        bf16* wout_t = (bf16*)(A->ws + WS_WOUT);

        if (vcu < 192) {
            LAS float* scv = (LAS float*)lds;
            LAS float* red = (LAS float*)(lds + 16384);
#pragma unroll
            for (int i = 0; i < 8; ++i) { const int e = tid * 8 + i; const float cv = cvec[e]; scv[e] = cv * sigm(cv); }
            __syncthreads();
            const int e0 = vcu * 16, col = lane & 15, kg = lane >> 4;
            float a0 = 0.f, a1 = 0.f, a2 = 0.f, a3 = 0.f;
#pragma unroll 8
            for (int i = 0; i < 32; ++i) { const int k = wave * 128 + kg * 32 + i; const float w = w_ada[(size_t)k * 3072 + e0 + col];
                a0 += scv[k] * w; a1 += scv[1024 + k] * w; a2 += scv[2048 + k] * w; a3 += scv[3072 + k] * w; }
            a0 += __shfl_xor(a0, 16); a0 += __shfl_xor(a0, 32); a1 += __shfl_xor(a1, 16); a1 += __shfl_xor(a1, 32);
            a2 += __shfl_xor(a2, 16); a2 += __shfl_xor(a2, 32); a3 += __shfl_xor(a3, 16); a3 += __shfl_xor(a3, 32);
            if (kg == 0) { red[(wave * 4 + 0) * 16 + col] = a0; red[(wave * 4 + 1) * 16 + col] = a1; red[(wave * 4 + 2) * 16 + col] = a2; red[(wave * 4 + 3) * 16 + col] = a3; }
            __syncthreads();
            if (tid < 64) { const int bb = tid >> 4, cc = tid & 15; float sacc = b_ada[e0 + cc];
#pragma unroll
                for (int w2 = 0; w2 < 8; ++w2) sacc += red[(w2 * 4 + bb) * 16 + cc];
                modf[bb * 3072 + e0 + cc] = sacc; }
            __syncthreads();
        }
        LAS float* scr = (LAS float*)(lds + RING_OFF + wave * 16384);
        constexpr int I_IN = (DM / 64) * (NIN / 32), I_SQ = (DM / 64) * (DM / 32), NITEMS = I_IN + 3 * I_SQ;
        for (int it = gw; it < NITEMS; it += NGW) {
            int r = it;
            if (r < I_IN) { p0_transpose_item(w_in, NIN, win_t, DM, 0, scr, r, lane); continue; } r -= I_IN;
            if (r < I_SQ) { p0_transpose_item(w_rnn_out, DM, wcat_t, 2048, 0, scr, r, lane); continue; } r -= I_SQ;
            if (r < I_SQ) { p0_transpose_item(w_attn_out, DM, wcat_t, 2048, 1024, scr, r, lane); continue; } r -= I_SQ;
            p0_transpose_item(w_out, DM, wout_t, DM, 0, scr, r, lane);
        }
    }
    SEAM(0);
    if (IN(1)) {
        KArgs A = kargs(); const int lane = lane_id(), tid = wave * 64 + lane; (void)tid;
        const float* x = A->in[0];
        float* modf = (float*)(A->ws + WS_MODF);
        bf16* ubuf = (bf16*)((unsigned char*)A->out + DO_U);

        for (int blk = gw; blk < MTOK / 16; blk += NGW) {
            const int bb = (blk * 16) / SEQ; f32x4 sc4[4], sh4[4];
#pragma unroll
            for (int j = 0; j < 4; ++j) { sh4[j] = *(const GAS f32x4*)(modf + bb * 3072 + 256 * j + 4 * lane); sc4[j] = *(const GAS f32x4*)(modf + bb * 3072 + 1024 + 256 * j + 4 * lane) + 1.0f; }
            for (int rr = 0; rr < 16; ++rr) { const size_t row = (size_t)blk * 16 + rr;
                const GAS f32x4* xr = (const GAS f32x4*)(x + row * DM) + lane; GAS unsigned long long* o8 = (GAS unsigned long long*)(ubuf + row * DM) + lane;
#pragma unroll
                for (int j = 0; j < 4; ++j) { const f32x4 v = xr[64 * j] * sc4[j] + sh4[j]; o8[64 * j] = (unsigned long long)pk2(v.x, v.y) | ((unsigned long long)pk2(v.z, v.w) << 32); } }
        }
    }
    SEAM(1);
    if (IN(2)) {
        KArgs A = kargs(); const int lane = lane_id(), tid = wave * 64 + lane; (void)tid;
        bf16* ubuf = (bf16*)((unsigned char*)A->out + DO_U);
        bf16* win_t = (bf16*)(A->ws + WS_WIN);
        bf16* rxb = (bf16*)((unsigned char*)A->out + DO_RX);
        bf16* ya = (bf16*)(A->ws + WS_YA);
        bf16* qbuf = (bf16*)(A->ws + WS_Q);
        bf16* kbuf = (bf16*)(A->ws + WS_K);
        bf16* vbuf = (bf16*)(A->ws + WS_V);
        bf16* mgb = (bf16*)(A->ws + WS_MG);

        pg8::Gemm g{ubuf, win_t, MTOK, NIN, DM}; pg8::StaticOrder S; S.init(MTOK, NIN, G, (int)blockIdx.x);
        pg8::EpiProjV E{A->ws, (unsigned char*)A->out};
        pg8::gemm_phase<pg8::EpiProjV, pg8::StaticOrder, MK_ALIGN, MK_SP2>(lds + RING_OFF, g, S, E, tid);
    }
    SEAM(2);
    if (IN(3)) {
        KArgs A = kargs(); const int lane = lane_id(), tid = wave * 64 + lane; (void)tid;
        bf16* rxb = (bf16*)((unsigned char*)A->out + DO_RX);
        bf16* ya = (bf16*)(A->ws + WS_YA);
        const float* conv_w = A->in[5];
        const float* conv_b = A->in[6];
        const float* w_rg_a = A->in[7];
        const float* b_rg_a = A->in[8];
        const float* w_rg_x = A->in[9];
        const float* b_rg_x = A->in[10];
        const float* lru_lambda = A->in[11];
 if (G == 256) rnn_phase(lds, vcu, lane, wave, rxb, ya, conv_w, conv_b, w_rg_a, b_rg_a, w_rg_x, b_rg_x, lru_lambda); }
    SEAM(3);
    if (IN(4)) {
        KArgs A = kargs(); const int lane = lane_id(), tid = wave * 64 + lane; (void)tid;
        bf16* qbuf = (bf16*)(A->ws + WS_Q);
        bf16* kbuf = (bf16*)(A->ws + WS_K);
        bf16* vbuf = (bf16*)(A->ws + WS_V);
        bf16* o0 = (bf16*)((unsigned char*)A->out + DO_O0);
        bf16* o1 = (bf16*)((unsigned char*)A->out + DO_O1);
        const float* rel_bias = A->in[17];
 if (G == 256) attn_phase_diff(lds_, lds, vcu, tid, wave, qbuf, kbuf, vbuf, o0, o1, rel_bias); }
    SEAM(4);
    if (IN(5)) {
        KArgs A = kargs(); const int lane = lane_id(), tid = wave * 64 + lane; (void)tid;
        const float* lq1 = A->in[12];
        const float* lk1 = A->in[13];
        const float* lq2 = A->in[14];
        const float* lk2 = A->in[15];
        const float* subln_w = A->in[16];
        bf16* o0 = (bf16*)((unsigned char*)A->out + DO_O0);
        bf16* o1 = (bf16*)((unsigned char*)A->out + DO_O1);
        bf16* ya = (bf16*)(A->ws + WS_YA);

        float s1 = lq1[lane] * lk1[lane], s2 = lq2[lane] * lk2[lane]; s1 = wave_sum(s1); s2 = wave_sum(s2);
        const float lamv = __expf(s1) - __expf(s2) + 0.2f;
        float sw[16];
#pragma unroll
        for (int i = 0; i < 16; ++i) sw[i] = subln_w[(lane * 16 + i) & 127] * 0.8f;
        for (int row = gw; row < MTOK; row += NGW) {
            const GAS v4u* p0 = (const GAS v4u*)(o0 + (size_t)row * 1024 + lane * 16); const GAS v4u* p1 = (const GAS v4u*)(o1 + (size_t)row * 1024 + lane * 16);
            GAS v4u* pa = (GAS v4u*)(ya + (size_t)row * 2048 + 1024 + lane * 16);
            float v[16]; float ss = 0.f; v4u agv[2];
#pragma unroll
            for (int hh = 0; hh < 2; ++hh) { const v4u a = p0[hh], bq = p1[hh]; agv[hh] = pa[hh];
                const unsigned aw[4] = {a.x, a.y, a.z, a.w}, bw[4] = {bq.x, bq.y, bq.z, bq.w};
#pragma unroll
                for (int e = 0; e < 4; ++e) { v[hh * 8 + 2 * e] = __uint_as_float(aw[e] << 16) - lamv * __uint_as_float(bw[e] << 16); v[hh * 8 + 2 * e + 1] = __uint_as_float(aw[e] & 0xffff0000u) - lamv * __uint_as_float(bw[e] & 0xffff0000u); } }
#pragma unroll
            for (int i = 0; i < 16; ++i) ss += v[i] * v[i];
            ss += __shfl_xor(ss, 1); ss += __shfl_xor(ss, 2); ss += __shfl_xor(ss, 4);
            const float rs = rsqrtf(ss * (1.f / 128.f) + LN_EPS);
#pragma unroll
            for (int hh = 0; hh < 2; ++hh) { const unsigned gwd[4] = {agv[hh].x, agv[hh].y, agv[hh].z, agv[hh].w}; v4u o;
                unsigned ow[4];
#pragma unroll
                for (int e = 0; e < 4; ++e) { const int i = hh * 8 + 2 * e; ow[e] = pk2(v[i] * rs * sw[i] * __uint_as_float(gwd[e] << 16), v[i + 1] * rs * sw[i + 1] * __uint_as_float(gwd[e] & 0xffff0000u)); }
                o.x = ow[0]; o.y = ow[1]; o.z = ow[2]; o.w = ow[3]; pa[hh] = o; }
        }
    }
    SEAM(5);
    if (IN(6)) {
        KArgs A = kargs(); const int lane = lane_id(), tid = wave * 64 + lane; (void)tid;
        bf16* ya = (bf16*)(A->ws + WS_YA);
        bf16* wcat_t = (bf16*)(A->ws + WS_WCAT);
        bf16* mgb = (bf16*)(A->ws + WS_MG);
        bf16* merged = (bf16*)(A->ws + WS_Q);

        pg8::Gemm g{ya, wcat_t, MTOK, DM, 2048}; pg8::StaticOrder S; S.init(MTOK, DM, G, (int)blockIdx.x);
        pg8::EpiMergeV E{mgb, merged};
        pg8::gemm_phase<pg8::EpiMergeV, pg8::StaticOrder, MK_ALIGN, MK_SP2>(lds + RING_OFF, g, S, E, tid);
    }
    SEAM(6);
    if (IN(7)) {
        KArgs A = kargs(); const int lane = lane_id(), tid = wave * 64 + lane; (void)tid;
        bf16* merged = (bf16*)(A->ws + WS_Q);
        bf16* wout_t = (bf16*)(A->ws + WS_WOUT);
        const float* x = A->in[0];
        float* modf = (float*)(A->ws + WS_MODF);
        float* outp = A->out;

        pg8::Gemm g{merged, wout_t, MTOK, DM, DM}; pg8::StaticOrder S; S.init(MTOK, DM, G, (int)blockIdx.x);
        pg8::EpiOutV E{x, modf, outp};
        pg8::gemm_phase<pg8::EpiOutV, pg8::StaticOrder, MK_ALIGN, MK_SP2>(lds + RING_OFF, g, S, E, tid);
    }
    SEAM(7);
    if (IN(8)) {
        KArgs A = kargs(); const int lane = lane_id(), tid = wave * 64 + lane; (void)tid;
        const float* ln_g = A->in[21];
        const float* ln_b = A->in[22];
        float* outp = A->out;

        f32x4 gg[4], bb[4];
#pragma unroll
        for (int j = 0; j < 4; ++j) { gg[j] = *(const GAS f32x4*)(ln_g + 256 * j + 4 * lane); bb[j] = *(const GAS f32x4*)(ln_b + 256 * j + 4 * lane); }
        for (int row = gw; row < MTOK; row += NGW) {
            GAS f32x4* p = (GAS f32x4*)(outp + (size_t)row * DM) + lane; f32x4 v[4]; float s = 0.f;
#pragma unroll
            for (int j = 0; j < 4; ++j) { v[j] = p[64 * j]; s += (v[j].x + v[j].y) + (v[j].z + v[j].w); }
            const float mean = wave_sum(s) * (1.f / DM); float s2 = 0.f;
#pragma unroll
            for (int j = 0; j < 4; ++j) { v[j] = v[j] - mean; s2 += (v[j].x * v[j].x + v[j].y * v[j].y) + (v[j].z * v[j].z + v[j].w * v[j].w); }
            const float rstd = rsqrtf(wave_sum(s2) * (1.f / DM) + LN_EPS);
#pragma unroll
            for (int j = 0; j < 4; ++j) p[64 * j] = v[j] * rstd * gg[j] + bb[j];
        }
    }
#undef IN
#undef SEAM
}

#ifndef MK_STEP
#define MK_STEP 4
#define MK_C0 6144
#define MK_C1 7168
#endif
extern "C" void kernel_launch(void* const* d_in, const int* in_sizes, int n_in, void* d_out, int out_size, void* d_ws, size_t ws_size, hipStream_t stream) {
    static int grid = 0;
    if (grid == 0) {
        if (n_in != 23 || out_size != MTOK * DM || ws_size < WS_END) { fprintf(stderr, "kernel_launch: unexpected shapes (n_in %d out %d ws %zu)\n", n_in, out_size, ws_size); grid = -1; return; }
        int dev = 0, cus = 0;
        if (hipGetDevice(&dev) != hipSuccess || hipDeviceGetAttribute(&cus, hipDeviceAttributeMultiprocessorCount, dev) != hipSuccess) { grid = -1; return; }
        if (hipFuncSetAttribute((const void*)mk_fwd, hipFuncAttributeMaxDynamicSharedMemorySize, LDS_BYTES) != hipSuccess) { fprintf(stderr, "kernel_launch: hipFuncSetAttribute failed\n"); grid = -1; return; }
        (void)hipGetLastError();
        grid = cus;
        if (grid != 256) { fprintf(stderr, "kernel_launch: built for 256 CUs, found %d\n", grid); }
    }
    if (grid < 0) return;
    (void)hipMemsetAsync((char*)d_ws + WS_CTL, 0, CTL_ZERO_BYTES, stream);
    Args a{};
    for (int i = 0; i < 23; ++i) a.in[i] = (const float*)d_in[i];
    a.out = (float*)d_out; a.ws = (unsigned char*)d_ws;
#define MK_RUN(lo_, hi_) do { a.ph_lo = (lo_); a.ph_hi = (hi_); hipLaunchKernelGGL(mk_fwd, dim3(grid), dim3(NWAVES * 64), LDS_BYTES, stream, a); } while (0)
    unsigned char* ws = (unsigned char*)d_ws; unsigned char* dob = (unsigned char*)d_out;
    bf16_t* ya = (bf16_t*)(ws + WS_YA); bf16_t* qb = (bf16_t*)(ws + WS_Q); bf16_t* kb = (bf16_t*)(ws + WS_K); bf16_t* vb = (bf16_t*)(ws + WS_V);
    bf16_t* rx = (bf16_t*)(dob + DO_RX); bf16_t* o0 = (bf16_t*)(dob + DO_O0); bf16_t* o1 = (bf16_t*)(dob + DO_O1);
    const float* conv_w = (const float*)d_in[5]; const float* conv_b = (const float*)d_in[6];
    const float* w_rg_a = (const float*)d_in[7]; const float* b_rg_a = (const float*)d_in[8]; const float* w_rg_x = (const float*)d_in[9]; const float* b_rg_x = (const float*)d_in[10];
    const float* lru_lambda = (const float*)d_in[11]; const float* lq1 = (const float*)d_in[12]; const float* lk1 = (const float*)d_in[13]; const float* lq2 = (const float*)d_in[14]; const float* lk2 = (const float*)d_in[15];
    const float* subln_w = (const float*)d_in[16]; const float* rel_bias = (const float*)d_in[17]; const float* ln_g = (const float*)d_in[21]; const float* ln_b = (const float*)d_in[22];
#if MK_STEP == 1
    MK_RUN(0, 1); MK_RUN(1, 2); MK_RUN(2, 3);
    k_rnn_simple<<<NB * 16, 64, 0, stream>>>(rx, ya, conv_w, conv_b, w_rg_a, b_rg_a, w_rg_x, b_rg_x, lru_lambda);
    k_attn_simple<<<NB * 8 * 2 * 32, 256, 0, stream>>>(qb, kb, vb, o0, o1, rel_bias);
    k_combine<<<MTOK / 4, 256, 0, stream>>>(o0, o1, ya, lq1, lk1, lq2, lk2, subln_w);
    MK_RUN(6, 7); MK_RUN(7, 8);
    k_ln<<<MTOK / 4, 256, 0, stream>>>((float*)d_out, ln_g, ln_b);
#elif MK_STEP == 11
    MK_RUN(0, 1); MK_RUN(1, 2); MK_RUN(2, 3);
    k_rnn_simple<<<NB * 16, 64, 0, stream>>>(rx, ya, conv_w, conv_b, w_rg_a, b_rg_a, w_rg_x, b_rg_x, lru_lambda);
    k_attn_simple<<<NB * 8 * 2 * 32, 256, 0, stream>>>(qb, kb, vb, o0, o1, rel_bias);
    k_combine<<<MTOK / 4, 256, 0, stream>>>(o0, o1, ya, lq1, lk1, lq2, lk2, subln_w);
    { EpiMerge e{(bf16_t*)(ws + WS_MG), qb}; k_gemm_simple<EpiMerge, true><<<dim3(DM / 64, MTOK / 64), 256, 0, stream>>>(ya, (bf16_t*)(ws + WS_WCAT), MTOK, DM, 2048, e); }
    { EpiOut e{(const float*)d_in[0], (const float*)(ws + WS_MODF), (float*)d_out}; k_gemm_simple<EpiOut, false><<<dim3(DM / 64, MTOK / 64), 256, 0, stream>>>(qb, (bf16_t*)(ws + WS_WOUT), MTOK, DM, DM, e); }
    k_ln<<<MTOK / 4, 256, 0, stream>>>((float*)d_out, ln_g, ln_b);
#elif MK_STEP == 12 || MK_STEP == 13
    MK_RUN(0, 1);
#if MK_STEP == 13
    MK_RUN(1, 2);
#else
    k_u<<<(unsigned)(((size_t)MTOK * DM + 255) / 256), 256, 0, stream>>>((const float*)d_in[0], (const float*)(ws + WS_MODF), (bf16_t*)(dob + DO_U));
#endif
    { EpiProj e{rx, ya, qb, kb, vb, (bf16_t*)(ws + WS_MG)}; k_gemm_simple<EpiProj, false><<<dim3(NIN / 64, MTOK / 64), 256, 0, stream>>>((bf16_t*)(dob + DO_U), (bf16_t*)(ws + WS_WIN), MTOK, NIN, DM, e); }
    k_rnn_simple<<<NB * 16, 64, 0, stream>>>(rx, ya, conv_w, conv_b, w_rg_a, b_rg_a, w_rg_x, b_rg_x, lru_lambda);
    k_attn_simple<<<NB * 8 * 2 * 32, 256, 0, stream>>>(qb, kb, vb, o0, o1, rel_bias);
    k_combine<<<MTOK / 4, 256, 0, stream>>>(o0, o1, ya, lq1, lk1, lq2, lk2, subln_w);
    { EpiMerge e{(bf16_t*)(ws + WS_MG), qb}; k_gemm_simple<EpiMerge, true><<<dim3(DM / 64, MTOK / 64), 256, 0, stream>>>(ya, (bf16_t*)(ws + WS_WCAT), MTOK, DM, 2048, e); }
    { EpiOut e{(const float*)d_in[0], (const float*)(ws + WS_MODF), (float*)d_out}; k_gemm_simple<EpiOut, false><<<dim3(DM / 64, MTOK / 64), 256, 0, stream>>>(qb, (bf16_t*)(ws + WS_WOUT), MTOK, DM, DM, e); }
    k_ln<<<MTOK / 4, 256, 0, stream>>>((float*)d_out, ln_g, ln_b);
#elif MK_STEP == 14
    MK_RUN(0, 1); MK_RUN(1, 2);
    { EpiProj e{rx, ya, qb, kb, vb, (bf16_t*)(ws + WS_MG)}; k_gemm_simple<EpiProj, false><<<dim3(NIN / 64, MTOK / 64), 256, 0, stream>>>((bf16_t*)(dob + DO_U), (bf16_t*)(ws + WS_WIN), MTOK, NIN, DM, e); }
    k_rnn_simple<<<NB * 16, 64, 0, stream>>>(rx, ya, conv_w, conv_b, w_rg_a, b_rg_a, w_rg_x, b_rg_x, lru_lambda);
    k_attn_simple<<<NB * 8 * 2 * 32, 256, 0, stream>>>(qb, kb, vb, o0, o1, rel_bias);
    k_combine<<<MTOK / 4, 256, 0, stream>>>(o0, o1, ya, lq1, lk1, lq2, lk2, subln_w);
    MK_RUN(6, 7); MK_RUN(7, 8);
    k_ln<<<MTOK / 4, 256, 0, stream>>>((float*)d_out, ln_g, ln_b);
#elif MK_STEP == 15
    MK_RUN(0, 1); MK_RUN(1, 2); MK_RUN(2, 3);
    { EpiProj e{rx, ya, qb, kb, vb, (bf16_t*)(ws + WS_MG)}; k_gemm_simple<EpiProj, false><<<dim3((MK_C1 - MK_C0) / 64, MTOK / 64), 256, 0, stream>>>((bf16_t*)(dob + DO_U), (bf16_t*)(ws + WS_WIN), MTOK, NIN, DM, e, MK_C0 / 64); }
    k_rnn_simple<<<NB * 16, 64, 0, stream>>>(rx, ya, conv_w, conv_b, w_rg_a, b_rg_a, w_rg_x, b_rg_x, lru_lambda);
    k_attn_simple<<<NB * 8 * 2 * 32, 256, 0, stream>>>(qb, kb, vb, o0, o1, rel_bias);
    k_combine<<<MTOK / 4, 256, 0, stream>>>(o0, o1, ya, lq1, lk1, lq2, lk2, subln_w);
    MK_RUN(6, 7); MK_RUN(7, 8);
    k_ln<<<MTOK / 4, 256, 0, stream>>>((float*)d_out, ln_g, ln_b);
#elif MK_STEP == 2
    MK_RUN(0, 1); MK_RUN(1, 2); MK_RUN(2, 3);
    k_rnn_simple<<<NB * 16, 64, 0, stream>>>(rx, ya, conv_w, conv_b, w_rg_a, b_rg_a, w_rg_x, b_rg_x, lru_lambda);
    MK_RUN(4, 5); MK_RUN(5, 6); MK_RUN(6, 7); MK_RUN(7, 8); MK_RUN(8, 9);
#elif MK_STEP == 3
    for (int p = 0; p < N_PHASES; ++p) MK_RUN(p, p + 1);
#else
    MK_RUN(0, N_PHASES);
#endif
}
```

```cpp
#include <hip/hip_runtime.h>
#include <cstdio>
#include <cstdint>
#include <cmath>

typedef unsigned short bf16_t;
#ifndef MK_ROT
#define MK_ROT 8
#endif
constexpr int NB = 4, SEQ = 8192, DM = 1024, MTOK = NB * SEQ, NIN = 8192;
constexpr float LN_EPS = 1e-5f;
constexpr float ALPHA = 1.189207115002721f;
constexpr float LOG2E = 1.4426950408889634f;
constexpr float C2 = 0.125f * LOG2E;

__device__ __forceinline__ float bf2f_(bf16_t v) { return __uint_as_float(((unsigned)v) << 16); }
__device__ __forceinline__ bf16_t f2bf_(float f) { unsigned u = __float_as_uint(f); return (bf16_t)((u + 0x7fffu + ((u >> 16) & 1u)) >> 16); }
__device__ __forceinline__ float sigmoidf_(float x) { return 1.f / (1.f + __expf(-x)); }
__device__ __forceinline__ float siluf_(float x) { return x / (1.f + __expf(-x)); }

constexpr size_t MiB = 1u << 20;
constexpr size_t WS_CTL = 0;
constexpr size_t WS_MODF = 1 * MiB + 512 * 1024;
constexpr size_t CTL_ZERO_BYTES = 512 * 1024;
constexpr size_t WS_WIN = 2 * MiB;
constexpr size_t WS_WCAT = 18 * MiB;
constexpr size_t WS_WOUT = 22 * MiB;
constexpr size_t WS_YA = 24 * MiB;
constexpr size_t WS_Q = 152 * MiB;
constexpr size_t WS_K = 216 * MiB;
constexpr size_t WS_V = 280 * MiB;
constexpr size_t WS_MG = 344 * MiB;
constexpr size_t WS_END = 472 * MiB;
constexpr size_t DO_U = 0, DO_RX = 64 * MiB, DO_O0 = 0, DO_O1 = 64 * MiB;

__global__ void k_mod(const float* __restrict__ c, const float* __restrict__ w_ada, const float* __restrict__ b_ada, float* __restrict__ modf) {
    const int idx = blockIdx.x * blockDim.x + threadIdx.x; if (idx >= NB * 3072) return;
    const int b = idx / 3072, e = idx % 3072; float acc = 0.f;
    for (int k = 0; k < DM; ++k) acc += siluf_(c[b * DM + k]) * w_ada[(size_t)k * 3072 + e];
    modf[idx] = acc + b_ada[e];
}
__global__ void k_u(const float* __restrict__ x, const float* __restrict__ modf, bf16_t* __restrict__ u) {
    const size_t idx = (size_t)blockIdx.x * blockDim.x + threadIdx.x; if (idx >= (size_t)MTOK * DM) return;
    const int d = (int)(idx % DM); const int b = (int)(idx / ((size_t)SEQ * DM));
    u[idx] = f2bf_(x[idx] * (1.f + modf[b * 3072 + 1024 + d]) + modf[b * 3072 + d]);
}
__global__ void k_transpose(const float* __restrict__ W, int K, int N, bf16_t* __restrict__ WT, int ldt, int koff) {
    const size_t idx = (size_t)blockIdx.x * blockDim.x + threadIdx.x; if (idx >= (size_t)K * N) return;
    const int k = (int)(idx / N), n = (int)(idx % N);
    WT[(size_t)n * ldt + koff + k] = f2bf_(W[idx]);
}

struct EpiProj {
    bf16_t *rx, *ya, *q, *k, *v, *mg;
    __device__ __forceinline__ void mid(int, int, float&) const {}
    __device__ __forceinline__ void operator()(int m, int n, float a) const {
        const int g = n >> 10, c = n & 1023;
        if (g == 0) rx[(size_t)m * 1024 + c] = f2bf_(a);
        else if (g == 1) ya[(size_t)m * 2048 + c] = f2bf_(siluf_(a));
        else if (g == 2) q[(size_t)m * 1024 + c] = f2bf_(a * C2);
        else if (g == 3) k[(size_t)m * 1024 + c] = f2bf_(a);
        else if (g == 4) v[(size_t)m * 1024 + c] = f2bf_(a);
        else if (g == 5) ya[(size_t)m * 2048 + 1024 + c] = f2bf_(siluf_(a));
        else mg[(size_t)m * 2048 + (n - 6144)] = f2bf_(sigmoidf_(a));
    }
};
struct EpiMerge {
    const bf16_t* mg; bf16_t* merged;
    __device__ __forceinline__ void mid(int m, int n, float& a) const { a *= bf2f_(mg[(size_t)m * 2048 + n]) / bf2f_(mg[(size_t)m * 2048 + 1024 + n]); }
    __device__ __forceinline__ void operator()(int m, int n, float a) const { merged[(size_t)m * 1024 + n] = f2bf_(a * bf2f_(mg[(size_t)m * 2048 + 1024 + n])); }
};
struct EpiOut {
    const float* x; const float* modf; float* z;
    __device__ __forceinline__ void mid(int, int, float&) const {}
    __device__ __forceinline__ void operator()(int m, int n, float a) const { const int b = m / SEQ; z[(size_t)m * 1024 + n] = ALPHA * x[(size_t)m * 1024 + n] + modf[b * 3072 + 2048 + n] * a; }
};

template <class Epi, bool MID>
__global__ void __launch_bounds__(256) k_gemm_simple(const bf16_t* __restrict__ A, const bf16_t* __restrict__ Bt, int M, int N, int K, Epi epi, int nblk0 = 0) {
    __shared__ float As[16][68], Bs[16][68];
    const int tid = threadIdx.x, tx = tid & 15, ty = tid >> 4;
    const int m0 = blockIdx.y * 64, n0 = (blockIdx.x + nblk0) * 64;
    float acc[4][4];
#pragma unroll
    for (int i = 0; i < 4; ++i)
#pragma unroll
        for (int j = 0; j < 4; ++j) acc[i][j] = 0.f;
    for (int k0 = 0; k0 < K; k0 += 16) {
        if (MID && k0 == K / 2) {
#pragma unroll
            for (int i = 0; i < 4; ++i)
#pragma unroll
                for (int j = 0; j < 4; ++j) epi.mid(m0 + ty * 4 + i, n0 + tx * 4 + j, acc[i][j]);
        }
#pragma unroll
        for (int e = 0; e < 4; ++e) {
            const int idx = tid + e * 256, r = idx >> 4, kk = idx & 15;
            As[kk][r] = bf2f_(A[(size_t)(m0 + r) * K + k0 + kk]);
            Bs[kk][r] = bf2f_(Bt[(size_t)(n0 + r) * K + k0 + kk]);
        }
        __syncthreads();
#pragma unroll
        for (int kk = 0; kk < 16; ++kk) {
            float a[4], b[4];
#pragma unroll
            for (int i = 0; i < 4; ++i) { a[i] = As[kk][ty * 4 + i]; b[i] = Bs[kk][tx * 4 + i]; }
#pragma unroll
            for (int i = 0; i < 4; ++i)
#pragma unroll
                for (int j = 0; j < 4; ++j) acc[i][j] += a[i] * b[j];
        }
        __syncthreads();
    }
#pragma unroll
    for (int i = 0; i < 4; ++i)
#pragma unroll
        for (int j = 0; j < 4; ++j) epi(m0 + ty * 4 + i, n0 + tx * 4 + j, acc[i][j]);
}

__global__ void __launch_bounds__(64) k_rnn_simple(const bf16_t* __restrict__ rx, bf16_t* __restrict__ ya, const float* __restrict__ conv_w, const float* __restrict__ conv_b,
                                                   const float* __restrict__ w_a, const float* __restrict__ b_a, const float* __restrict__ w_x, const float* __restrict__ b_x, const float* __restrict__ lam) {
    __shared__ float xs[64];
    const int b = blockIdx.x / 16, hb = blockIdx.x % 16, j = threadIdx.x, ch = hb * 64 + j;
    float wa[64], wx[64];
#pragma unroll
    for (int i = 0; i < 64; ++i) { wa[i] = w_a[(size_t)hb * 4096 + i * 64 + j]; wx[i] = w_x[(size_t)hb * 4096 + i * 64 + j]; }
    const float cw0 = conv_w[ch], cw1 = conv_w[1024 + ch], cw2 = conv_w[2048 + ch], cw3 = conv_w[3072 + ch], cb = conv_b[ch];
    const float ba = b_a[ch], bx = b_x[ch];
    const float L = lam[ch]; const float sp = log1pf(expf(-L));
    const float logu = -8.0f * sp;
    float x1 = 0.f, x2 = 0.f, x3 = 0.f, h = 0.f;
    for (int t = 0; t < SEQ; ++t) {
        const size_t row = (size_t)b * SEQ + t;
        const float x0 = bf2f_(rx[row * 1024 + ch]);
        const float xc = cw0 * x3 + cw1 * x2 + cw2 * x1 + cw3 * x0 + cb;
        x3 = x2; x2 = x1; x1 = x0;
        __syncthreads(); xs[j] = xc; __syncthreads();
        float ra = ba, ri = bx;
#pragma unroll
        for (int i = 0; i < 64; ++i) { const float xv = xs[i]; ra += xv * wa[i]; ri += xv * wx[i]; }
        const float r = sigmoidf_(ra), ig = sigmoidf_(ri);
        const float la = r * logu; const float a = expf(la); const float bin = sqrtf(-expm1f(2.f * la)) * (ig * xc);
        h = a * h + bin;
        const size_t o = row * 2048 + ch;
        ya[o] = f2bf_(h * bf2f_(ya[o]));
    }
}

__device__ __forceinline__ int t5_bucket(int n) {
    if (n < 16) return n;
    int l = 16 + (int)(logf((float)n / 16.0f) / 2.0794415416798357f * 16.0f);
    return l < 31 ? l : 31;
}
__global__ void __launch_bounds__(256) k_attn_simple(const bf16_t* __restrict__ Q, const bf16_t* __restrict__ K, const bf16_t* __restrict__ V, bf16_t* __restrict__ O0, bf16_t* __restrict__ O1, const float* __restrict__ rel_bias) {
    __shared__ float tab[128];
    const int qb = blockIdx.x % 32, c = (blockIdx.x / 32) % 2, h = (blockIdx.x / 64) % 8, b = blockIdx.x / 512;
    if (threadIdx.x < 128) tab[threadIdx.x] = rel_bias[t5_bucket(threadIdx.x) * 8 + h] * LOG2E;
    __syncthreads();
    const float far = rel_bias[31 * 8 + h] * LOG2E;
    const int qi = qb * 256 + threadIdx.x; const size_t rowq = (size_t)b * SEQ + qi;
    float q[64], o[128];
#pragma unroll
    for (int d = 0; d < 64; ++d) q[d] = bf2f_(Q[rowq * 1024 + h * 128 + c * 64 + d]);
#pragma unroll
    for (int e = 0; e < 128; ++e) o[e] = 0.f;
    float m = -INFINITY, l = 0.f;
    const int kend = qb * 256 + 255;
    for (int kk = 0; kk <= kend; ++kk) {
        const size_t rowk = (size_t)b * SEQ + kk;
        const bf16_t* kp = K + rowk * 1024 + h * 128 + c * 64;
        float s = 0.f;
#pragma unroll
        for (int d = 0; d < 64; ++d) s += q[d] * bf2f_(kp[d]);
        const int n = qi - kk;
        if (n >= 0) {
            s += (n < 128) ? tab[n] : far;
            if (s > m) { const float f = exp2f(m - s); l *= f;
#pragma unroll
                for (int e = 0; e < 128; ++e) o[e] *= f;
                m = s; }
            const float p = exp2f(s - m); l += p;
            const bf16_t* vp = V + rowk * 1024 + h * 128;
#pragma unroll
            for (int e = 0; e < 128; ++e) o[e] += p * bf2f_(vp[e]);
        }
    }
    bf16_t* Op = (c == 0 ? O0 : O1) + rowq * 1024 + h * 128; const float il = 1.f / l;
#pragma unroll
    for (int e = 0; e < 128; ++e) Op[e] = f2bf_(o[e] * il);
}

__global__ void __launch_bounds__(256) k_combine(const bf16_t* __restrict__ O0, const bf16_t* __restrict__ O1, bf16_t* __restrict__ ya, const float* __restrict__ lq1, const float* __restrict__ lk1,
                                                 const float* __restrict__ lq2, const float* __restrict__ lk2, const float* __restrict__ subw) {
    const int lane = threadIdx.x & 63, row = blockIdx.x * 4 + (threadIdx.x >> 6);
    float s1 = lq1[lane] * lk1[lane], s2 = lq2[lane] * lk2[lane];
#pragma unroll
    for (int o = 1; o < 64; o <<= 1) { s1 += __shfl_xor(s1, o); s2 += __shfl_xor(s2, o); }
    const float lam = expf(s1) - expf(s2) + 0.2f;
    const int col = lane * 16;
    float v[16]; float ss = 0.f;
#pragma unroll
    for (int i = 0; i < 16; ++i) { v[i] = bf2f_(O0[(size_t)row * 1024 + col + i]) - lam * bf2f_(O1[(size_t)row * 1024 + col + i]); ss += v[i] * v[i]; }
    ss += __shfl_xor(ss, 1); ss += __shfl_xor(ss, 2); ss += __shfl_xor(ss, 4);
    const float rs = rsqrtf(ss * (1.f / 128.f) + LN_EPS) * 0.8f;
#pragma unroll
    for (int i = 0; i < 16; ++i) { const size_t o = (size_t)row * 2048 + 1024 + col + i; ya[o] = f2bf_(v[i] * rs * subw[(col + i) & 127] * bf2f_(ya[o])); }
}

__global__ void __launch_bounds__(256) k_ln(float* __restrict__ z, const float* __restrict__ g, const float* __restrict__ bta) {
    const int lane = threadIdx.x & 63, row = blockIdx.x * 4 + (threadIdx.x >> 6);
    float4* p = (float4*)(z + (size_t)row * 1024) + lane; float4 v[4]; float s = 0.f;
#pragma unroll
    for (int j = 0; j < 4; ++j) { v[j] = p[64 * j]; s += (v[j].x + v[j].y) + (v[j].z + v[j].w); }
#pragma unroll
    for (int o = 1; o < 64; o <<= 1) s += __shfl_xor(s, o);
    const float mean = s * (1.f / 1024.f); float q = 0.f;
#pragma unroll
    for (int j = 0; j < 4; ++j) { v[j].x -= mean; v[j].y -= mean; v[j].z -= mean; v[j].w -= mean; q += (v[j].x * v[j].x + v[j].y * v[j].y) + (v[j].z * v[j].z + v[j].w * v[j].w); }
#pragma unroll
    for (int o = 1; o < 64; o <<= 1) q += __shfl_xor(q, o);
    const float rstd = rsqrtf(q * (1.f / 1024.f) + LN_EPS);
#pragma unroll
    for (int j = 0; j < 4; ++j) { const float4 gg = ((const float4*)g)[lane + 64 * j], bb = ((const float4*)bta)[lane + 64 * j];
        float4 o; o.x = v[j].x * rstd * gg.x + bb.x; o.y = v[j].y * rstd * gg.y + bb.y; o.z = v[j].z * rstd * gg.z + bb.z; o.w = v[j].w * rstd * gg.w + bb.w; p[64 * j] = o; }
}

namespace pg8 {
#define PG8_LAS __attribute__((address_space(3)))
typedef unsigned short bf16_t;
typedef short bf16x8 __attribute__((ext_vector_type(8)));
typedef float f32x4 __attribute__((ext_vector_type(4)));
typedef unsigned u32x4 __attribute__((ext_vector_type(4)));
constexpr int BM = 256, BK = 64, HALF = 128, HTB = HALF * BK * 2  , STAGE_BYTES = 8 * HTB, NXCD = 8, WGM = 8;

__host__ __device__ __forceinline__ int lds_byte(int r, int c) { const int st = (r >> 4) * 2 + (c >> 5), rr = r & 15, cc = c & 31, ob = rr * 64 + cc * 2; return st * 1024 + (ob ^ (((ob >> 9) & 1) << 5)); }
__host__ __device__ __forceinline__ void stage_rc(int b, int& R, int& C) { const int st = b / 1024, sb = b % 1024, swz = sb ^ (((sb >> 9) & 1) << 5); R = (st >> 1) * 16 + swz / 64; C = (st & 1) * 32 + (swz % 64) / 2; }
__host__ __device__ __forceinline__ int perm32(int rho) { const int n = rho >> 4, i = rho & 15; return 8 * (i >> 2) + 4 * n + (i & 3); }

struct Unit { int pm, pn; };
struct Gemm { const bf16_t* A; const bf16_t* Bt; int M, N, K; };

struct StaticOrder {
    int nM, nN, nwg, G, c;
    __host__ __device__ void init(int M, int N, int G_, int c_) { nM = M / BM; nN = N / BM; nwg = nM * nN; G = G_; c = c_; }
    __host__ __device__ bool next(int i, Unit& u) const {
        const long L = (long)i * G + c; if (L >= nwg) return false;
        int wgid = (int)L; { const int q = nwg / NXCD, r = nwg % NXCD, xcd = wgid % NXCD, off = wgid / NXCD; wgid = (xcd < r ? xcd * (q + 1) : r * (q + 1) + (xcd - r) * q) + off; }
        const int nig = WGM * nN, gid = wgid / nig, fm = gid * WGM, gsz = (nM - fm) < WGM ? (nM - fm) : WGM;
        u.pm = fm + ((wgid % nig) % gsz); u.pn = (wgid % nig) / gsz; return true;
    }
    __device__ __forceinline__ void a_ready(const Unit&) const {}
    __device__ __forceinline__ void done(const Unit&) const {}
};


typedef float f32x2_cv __attribute__((ext_vector_type(2))); typedef __bf16 bf16x2_cv __attribute__((ext_vector_type(2)));
__device__ __forceinline__ unsigned cvt_pk_bf16(float lo, float hi) { f32x2_cv v = {lo, hi}; bf16x2_cv b = __builtin_convertvector(v, bf16x2_cv); return __builtin_bit_cast(unsigned, b); }
__device__ __forceinline__ float fast_sigmoid(float x) { return __builtin_amdgcn_rcpf(1.0f + __builtin_amdgcn_exp2f(-1.4426950408889634f * x)); }
__device__ __forceinline__ float bflo(unsigned w) { return __uint_as_float(w << 16); }
__device__ __forceinline__ float bfhi(unsigned w) { return __uint_as_float(w & 0xffff0000u); }

struct EpiProjV {
    static constexpr bool PERM = true, AFTER_DRAIN = false, HAS_MID = false;
    unsigned char* ws; unsigned char* dob;
    template <int ACT> __device__ __forceinline__ void run(const f32x4 (&acc)[2][2][4][2], bf16_t* base, int ldc, int row0, float sc) const {
#pragma unroll
        for (int ai = 0; ai < 2; ++ai)
#pragma unroll
            for (int m = 0; m < 4; ++m) { bf16_t* rowp = base + (size_t)(row0 + ai * HALF + m * 16) * ldc;
#pragma unroll
                for (int bj = 0; bj < 2; ++bj) { f32x4 v0 = acc[ai][bj][m][0], v1 = acc[ai][bj][m][1];
                    if (ACT == 0) { v0 = v0 * sc; v1 = v1 * sc; }
                    if (ACT == 1) {
#pragma unroll
                        for (int e = 0; e < 4; ++e) { v0[e] = v0[e] * fast_sigmoid(v0[e]); v1[e] = v1[e] * fast_sigmoid(v1[e]); } }
                    if (ACT == 2) {
#pragma unroll
                        for (int e = 0; e < 4; ++e) { v0[e] = fast_sigmoid(v0[e]); v1[e] = fast_sigmoid(v1[e]); } }
                    u32x4 w; w.x = cvt_pk_bf16(v0[0], v0[1]); w.y = cvt_pk_bf16(v0[2], v0[3]); w.z = cvt_pk_bf16(v1[0], v1[1]); w.w = cvt_pk_bf16(v1[2], v1[3]);
                    *(u32x4*)(rowp + bj * HALF) = w; } }
    }
    __device__ __forceinline__ void operator()(const f32x4 (&acc)[2][2][4][2], const Unit& u, int wr, int wc, int fr, int fq) const {
        const int g = u.pn >> 2, colt = (u.pn & 3) * BM + wc * 32 + 8 * fq; int row0 = u.pm * BM + wr * 64 + fr; asm volatile("" : "+v"(row0));
        const size_t goff = (g == 0) ? DO_RX : (g == 1) ? WS_YA : (g == 2) ? WS_Q : (g == 3) ? WS_K : (g == 4) ? WS_V : (g == 5) ? WS_YA + 2048 : (g == 6) ? WS_MG : WS_MG + 2048;
        bf16_t* base = (bf16_t*)((g == 0 ? dob : ws) + goff) + colt;
        const int ldc = (g == 1 || g >= 5) ? 2048 : 1024;
        if (g == 1 || g == 5) run<1>(acc, base, ldc, row0, 1.0f);
        else if (g >= 6) run<2>(acc, base, ldc, row0, 1.0f);
        else run<0>(acc, base, ldc, row0, g == 2 ? C2 : 1.0f);
    }
};

struct EpiMergeV {
    static constexpr bool PERM = true, AFTER_DRAIN = false, HAS_MID = true;
    const bf16_t* mg; bf16_t* merged;
    __device__ __forceinline__ void mid(f32x4 (&acc)[2][2][4][2], const Unit& u, int wr, int wc, int fr, int fq) const {
        const int col0 = u.pn * BM + wc * 32 + 8 * fq; int row0 = u.pm * BM + wr * 64 + fr; asm volatile("" : "+v"(row0));
#pragma unroll
        for (int ai = 0; ai < 2; ++ai)
#pragma unroll
            for (int m = 0; m < 4; ++m) { const bf16_t* rowp = mg + (size_t)(row0 + ai * HALF + m * 16) * 2048 + col0;
#pragma unroll
                for (int bj = 0; bj < 2; ++bj) { const u32x4 a = *(const u32x4*)(rowp + bj * HALF), b = *(const u32x4*)(rowp + 1024 + bj * HALF);
                    f32x4 r0, r1;
                    r0[0] = bflo(a.x) * __builtin_amdgcn_rcpf(bflo(b.x)); r0[1] = bfhi(a.x) * __builtin_amdgcn_rcpf(bfhi(b.x)); r0[2] = bflo(a.y) * __builtin_amdgcn_rcpf(bflo(b.y)); r0[3] = bfhi(a.y) * __builtin_amdgcn_rcpf(bfhi(b.y));
                    r1[0] = bflo(a.z) * __builtin_amdgcn_rcpf(bflo(b.z)); r1[1] = bfhi(a.z) * __builtin_amdgcn_rcpf(bfhi(b.z)); r1[2] = bflo(a.w) * __builtin_amdgcn_rcpf(bflo(b.w)); r1[3] = bfhi(a.w) * __builtin_amdgcn_rcpf(bfhi(b.w));
                    acc[ai][bj][m][0] = acc[ai][bj][m][0] * r0; acc[ai][bj][m][1] = acc[ai][bj][m][1] * r1; } }
    }
    __device__ __forceinline__ void operator()(const f32x4 (&acc)[2][2][4][2], const Unit& u, int wr, int wc, int fr, int fq) const {
        const int col0 = u.pn * BM + wc * 32 + 8 * fq; int row0 = u.pm * BM + wr * 64 + fr; asm volatile("" : "+v"(row0));
#pragma unroll
        for (int ai = 0; ai < 2; ++ai)
#pragma unroll
            for (int m = 0; m < 4; ++m) { const size_t r = (size_t)(row0 + ai * HALF + m * 16);
#pragma unroll
                for (int bj = 0; bj < 2; ++bj) { const u32x4 b = *(const u32x4*)(mg + r * 2048 + 1024 + col0 + bj * HALF);
                    f32x4 v0 = acc[ai][bj][m][0], v1 = acc[ai][bj][m][1];
                    v0[0] *= bflo(b.x); v0[1] *= bfhi(b.x); v0[2] *= bflo(b.y); v0[3] *= bfhi(b.y); v1[0] *= bflo(b.z); v1[1] *= bfhi(b.z); v1[2] *= bflo(b.w); v1[3] *= bfhi(b.w);
                    u32x4 w; w.x = cvt_pk_bf16(v0[0], v0[1]); w.y = cvt_pk_bf16(v0[2], v0[3]); w.z = cvt_pk_bf16(v1[0], v1[1]); w.w = cvt_pk_bf16(v1[2], v1[3]);
                    *(u32x4*)(merged + r * 1024 + col0 + bj * HALF) = w; } }
    }
};

struct EpiOutV {
    static constexpr bool PERM = false, AFTER_DRAIN = false, HAS_MID = false;
    const float* x; const float* modf; float* z;
    __device__ __forceinline__ void operator()(const f32x4 (&acc)[2][2][4][2], const Unit& u, int wr, int wc, int fr, int fq) const {
        const int col0 = u.pn * BM + wc * 32 + 4 * fq, b = (u.pm * BM) / SEQ; int row0 = u.pm * BM + wr * 64 + fr; asm volatile("" : "+v"(row0));
        f32x4 gv[2][2];
#pragma unroll
        for (int bj = 0; bj < 2; ++bj)
#pragma unroll
            for (int n = 0; n < 2; ++n) gv[bj][n] = *(const f32x4*)(modf + b * 3072 + 2048 + col0 + bj * HALF + n * 16);
#pragma unroll
        for (int ai = 0; ai < 2; ++ai)
#pragma unroll
            for (int m = 0; m < 4; ++m) { const size_t off = (size_t)(row0 + ai * HALF + m * 16) * 1024 + col0;
#pragma unroll
                for (int bj = 0; bj < 2; ++bj)
#pragma unroll
                    for (int n = 0; n < 2; ++n) { const f32x4 xv = *(const f32x4*)(x + off + bj * HALF + n * 16);
                        *(f32x4*)(z + off + bj * HALF + n * 16) = xv * ALPHA + gv[bj][n] * acc[ai][bj][m][n]; } }
    }
};

template <class Epi, class Sched, bool ALIGN_EPI = false, bool SP2 = false>
__device__ __forceinline__ void gemm_phase(PG8_LAS unsigned char* lds, const Gemm g, const Sched& S, const Epi& E, const int tid_in) {
    const int tid = tid_in, wid = __builtin_amdgcn_readfirstlane(tid >> 6), lane = tid & 63, wr = wid >> 2, wc = wid & 3, fr = lane & 15, fq = lane >> 4;
    const int K = g.K, nt = K / BK;
    unsigned voffA[2], voffB[2];
#pragma unroll
    for (int i = 0; i < 2; ++i) { int R, C; stage_rc(tid * 16 + i * 8192, R, C); const int Rb = Epi::PERM ? ((R & ~31) + perm32(R & 31)) : R;
        voffA[i] = (unsigned)(R * K + C) * 2u; voffB[i] = (unsigned)(Rb * K + C) * 2u; }
    const size_t kstep = (size_t)(BK * 2);
    const size_t hstep = (size_t)HALF * K * 2;
    const size_t tstep = 2 * hstep;
    const unsigned ldsw = (unsigned)wid * 1024u;
    const int aoff = lds_byte(wr * 64 + fr, fq * 8), boff = lds_byte(wc * 32 + fr, fq * 8);
#define PG8_SA(b, h) (((b) * 2 + (h)) * HTB)
#define PG8_SB(b, h) ((4 + (b) * 2 + (h)) * HTB)
#define PG8_STAGE(bufoff, gbase, voff) do { _Pragma("unroll") for (int _i = 0; _i < 2; ++_i) \
        __builtin_amdgcn_global_load_lds((const unsigned*)((const char*)(gbase) + (voff)[_i]), (PG8_LAS unsigned*)(lds + (bufoff) + ldsw + _i * 8192), 16, 0, 0); } while (0)
#define PG8_LDA(dst, b, h) do { _Pragma("unroll") for (int m = 0; m < 4; ++m) _Pragma("unroll") for (int k = 0; k < 2; ++k) dst[m][k] = *(const PG8_LAS bf16x8*)(lds + PG8_SA(b, h) + aoff + m * 2048 + k * 1024); } while (0)
#define PG8_LDB(dst, b, h) do { _Pragma("unroll") for (int n = 0; n < 2; ++n) _Pragma("unroll") for (int k = 0; k < 2; ++k) dst[n][k] = *(const PG8_LAS bf16x8*)(lds + PG8_SB(b, h) + boff + n * 2048 + k * 1024); } while (0)
#define PG8_MMA(ai, bj, At, Bt) do { __builtin_amdgcn_s_setprio(1); _Pragma("unroll") for (int m = 0; m < 4; ++m) _Pragma("unroll") for (int n = 0; n < 2; ++n) _Pragma("unroll") for (int k = 0; k < 2; ++k) \
        acc[ai][bj][m][n] = __builtin_amdgcn_mfma_f32_16x16x32_bf16(Bt[n][k], At[m][k], acc[ai][bj][m][n], 0, 0, 0); __builtin_amdgcn_s_setprio(0); } while (0)
#define PG8_WAIT_V(n) asm volatile("s_waitcnt vmcnt(" #n ")" ::: "memory")
#define PG8_WAIT_L(n) asm volatile("s_waitcnt lgkmcnt(" #n ")" ::: "memory")
#define PG8_BAR __builtin_amdgcn_s_barrier()
#define PG8_SCHED __builtin_amdgcn_sched_barrier(0)
    Unit cur, nxt; int ui = 0;
    if (!S.next(0, cur)) return;
    f32x4 acc[2][2][4][2];
#pragma unroll
    for (int a = 0; a < 2; ++a)
#pragma unroll
        for (int b = 0; b < 2; ++b)
#pragma unroll
            for (int m = 0; m < 4; ++m)
#pragma unroll
                for (int n = 0; n < 2; ++n) acc[a][b][m][n] = (f32x4){0.f, 0.f, 0.f, 0.f};
    bf16x8 At[4][2], B0[2][2], B1[2][2];
    const char* cA = (const char*)g.A + (size_t)cur.pm * tstep; const char* cB = (const char*)g.Bt + (size_t)cur.pn * tstep;
    S.a_ready(cur);
    if constexpr (SP2) {
        PG8_STAGE(PG8_SB(0, 0), cB, voffB); PG8_STAGE(PG8_SB(0, 1), cB + hstep, voffB); PG8_STAGE(PG8_SA(0, 0), cA, voffA); PG8_STAGE(PG8_SA(0, 1), cA + hstep, voffA);
        if (wr == 1) PG8_BAR;
        PG8_WAIT_V(2); PG8_BAR;
        PG8_STAGE(PG8_SB(1, 0), cB + kstep, voffB); PG8_STAGE(PG8_SA(1, 0), cA + kstep, voffA); PG8_STAGE(PG8_SB(1, 1), cB + hstep + kstep, voffB);
        PG8_WAIT_V(6); PG8_BAR;
    } else {
        PG8_STAGE(PG8_SB(0, 0), cB, voffB); PG8_STAGE(PG8_SA(0, 0), cA, voffA); PG8_STAGE(PG8_SB(0, 1), cB + hstep, voffB); PG8_STAGE(PG8_SA(0, 1), cA + hstep, voffA);
        if (wr == 1) PG8_BAR;
        PG8_WAIT_V(4); PG8_BAR;
        PG8_STAGE(PG8_SB(1, 0), cB + kstep, voffB); PG8_STAGE(PG8_SA(1, 0), cA + kstep, voffA); PG8_STAGE(PG8_SB(1, 1), cB + hstep + kstep, voffB);
        PG8_WAIT_V(6); PG8_BAR;
    }
    for (;;) {
        const bool has_next = S.next(ui + 1, nxt);
        const char* nA = has_next ? (const char*)g.A + (size_t)nxt.pm * tstep : cA; const char* nB = has_next ? (const char*)g.Bt + (size_t)nxt.pn * tstep : cB;
        for (int t = 0; t < nt; t += 2) {
            if constexpr (Epi::HAS_MID) { if (t == (nt >> 1)) { PG8_SCHED; E.mid(acc, cur, wr, wc, fr, fq); PG8_SCHED; } }
            const bool last = (t == nt - 2);
            const char* a1 = cA + (size_t)(t + 1) * kstep;
            const char* a2 = last ? nA : cA + (size_t)(t + 2) * kstep; const char* b2 = last ? nB : cB + (size_t)(t + 2) * kstep;
            const char* a3 = a2 + kstep; const char* b3 = b2 + kstep;
            if (last && has_next) S.a_ready(nxt);
            if constexpr (SP2) {
            PG8_LDB(B0, 0, 0); PG8_LDB(B1, 0, 1); PG8_SCHED; PG8_LDA(At, 0, 0); PG8_STAGE(PG8_SA(1, 1), a1 + hstep, voffA);
            PG8_WAIT_V(8); PG8_WAIT_L(0); PG8_BAR; PG8_MMA(0, 0, At, B0); PG8_MMA(0, 1, At, B1); PG8_BAR; PG8_SCHED;
            PG8_LDA(At, 0, 1); PG8_STAGE(PG8_SB(0, 0), b2, voffB); PG8_STAGE(PG8_SB(0, 1), b2 + hstep, voffB); PG8_STAGE(PG8_SA(0, 0), a2, voffA);
            PG8_WAIT_V(8); PG8_WAIT_L(0); PG8_BAR; PG8_MMA(1, 0, At, B0); PG8_MMA(1, 1, At, B1); PG8_BAR; PG8_SCHED;
            PG8_LDB(B0, 1, 0); PG8_LDB(B1, 1, 1); PG8_SCHED; PG8_LDA(At, 1, 0); PG8_STAGE(PG8_SA(0, 1), a2 + hstep, voffA);
            PG8_WAIT_V(8); PG8_WAIT_L(0); PG8_BAR; PG8_MMA(0, 0, At, B0); PG8_MMA(0, 1, At, B1); PG8_BAR; PG8_SCHED;
            PG8_LDA(At, 1, 1); PG8_STAGE(PG8_SB(1, 0), b3, voffB); PG8_STAGE(PG8_SB(1, 1), b3 + hstep, voffB); PG8_STAGE(PG8_SA(1, 0), a3, voffA);
            PG8_WAIT_V(8); PG8_WAIT_L(0); PG8_BAR; PG8_MMA(1, 0, At, B0); PG8_MMA(1, 1, At, B1); PG8_BAR; PG8_SCHED;
            } else {
            PG8_LDB(B0, 0, 0); PG8_SCHED; PG8_LDA(At, 0, 0); PG8_STAGE(PG8_SA(1, 1), a1 + hstep, voffA);
            PG8_WAIT_L(8); PG8_BAR; PG8_WAIT_L(0); PG8_MMA(0, 0, At, B0); PG8_BAR; PG8_SCHED;
            PG8_LDB(B1, 0, 1); PG8_STAGE(PG8_SB(0, 0), b2, voffB);
            PG8_BAR; PG8_WAIT_L(0); PG8_MMA(0, 1, At, B1); PG8_BAR;
            PG8_LDA(At, 0, 1); PG8_STAGE(PG8_SA(0, 0), a2, voffA);
            PG8_BAR; PG8_WAIT_L(0); PG8_MMA(1, 0, At, B0); PG8_BAR; PG8_SCHED;
            PG8_STAGE(PG8_SB(0, 1), b2 + hstep, voffB);
            PG8_WAIT_V(6); PG8_BAR; PG8_MMA(1, 1, At, B1); PG8_BAR;
            PG8_LDB(B0, 1, 0); PG8_SCHED; PG8_LDA(At, 1, 0); PG8_STAGE(PG8_SA(0, 1), a2 + hstep, voffA);
            PG8_WAIT_L(8); PG8_BAR; PG8_WAIT_L(0); PG8_MMA(0, 0, At, B0); PG8_BAR; PG8_SCHED;
            PG8_LDB(B1, 1, 1); PG8_STAGE(PG8_SB(1, 0), b3, voffB);
            PG8_BAR; PG8_WAIT_L(0); PG8_MMA(0, 1, At, B1); PG8_BAR;
            PG8_LDA(At, 1, 1); PG8_STAGE(PG8_SA(1, 0), a3, voffA);
            PG8_BAR; PG8_WAIT_L(0); PG8_MMA(1, 0, At, B0); PG8_BAR; PG8_SCHED;
            PG8_STAGE(PG8_SB(1, 1), b3 + hstep, voffB);
            PG8_WAIT_V(6); PG8_BAR; PG8_MMA(1, 1, At, B1); PG8_BAR;
            }
        }
        if constexpr (ALIGN_EPI) { if (wr == 0) PG8_BAR; }
        if constexpr (!Epi::AFTER_DRAIN) { E(acc, cur, wr, wc, fr, fq); S.done(cur); }
        if (!has_next) break;
#pragma unroll
        for (int a = 0; a < 2; ++a)
#pragma unroll
            for (int b = 0; b < 2; ++b)
#pragma unroll
                for (int m = 0; m < 4; ++m)
#pragma unroll
                    for (int n = 0; n < 2; ++n) acc[a][b][m][n] = (f32x4){0.f, 0.f, 0.f, 0.f};
        cur = nxt; cA = nA; cB = nB; ++ui;
        if constexpr (ALIGN_EPI) { if (wr == 1) PG8_BAR; }
    }
    PG8_WAIT_V(0);
    if constexpr (!ALIGN_EPI) { if (wr == 0) PG8_BAR; }
    PG8_BAR;
    if constexpr (Epi::AFTER_DRAIN) { E.fused(acc, cur, wr, wc, fr, fq, lds, wid, lane); S.done(cur); }
#undef PG8_SA
#undef PG8_SB
#undef PG8_STAGE
#undef PG8_LDA
#undef PG8_LDB
#undef PG8_MMA
#undef PG8_WAIT_V
#undef PG8_WAIT_L
#undef PG8_BAR
#undef PG8_SCHED
}
}

#include <hip/hip_bf16.h>
#include <cmath>
namespace attn_body {
using bf16=__hip_bfloat16;
using bf16x8=__attribute__((ext_vector_type(8)))short;
using s16x4=__attribute__((ext_vector_type(4)))short;
using f32x16=__attribute__((ext_vector_type(16)))float;
using u32x4=__attribute__((ext_vector_type(4)))unsigned;
constexpr int BATCH=4,NHEAD=16,SEQ=8192,D=64,DM=NHEAD*D;
constexpr int NW=8,QBLK=32,QB=QBLK*NW,KVBLK=64,NQB=SEQ/QB;
constexpr int ATTN_PITCH=DM, ATTN_UNIT_ROWS=QB;
__device__ __forceinline__ int crow(int r,int hi){return (r&3)+8*(r>>2)+4*hi;}
#define SBAR() __builtin_amdgcn_sched_barrier(0)
typedef __attribute__((address_space(3))) const float* lds_fptr;
__device__ __forceinline__ void bmask(f32x16&p0,f32x16&p1,int jb,int qrel,int hi,lds_fptr tab){
  const float NEG=-INFINITY; const int nb=qrel-64*jb-4*hi;
  #pragma unroll
  for(int r=0;r<16;++r){ const int n0=nb-((r&3)+8*(r>>2)), n1=n0-32;
    const int i0=n0<0?0:(n0>127?127:n0), i1=n1<0?0:(n1>127?127:n1);
    const float t0=tab[i0], t1=tab[i1];
    p0[r]=n0<0?NEG:p0[r]+t0; p1[r]=n1<0?NEG:p1[r]+t1; }
}
constexpr int NSLOT=3, SLOTB=8192;
constexpr int LDS_K=0, LDS_V=NSLOT*SLOTB, LDS_WS=2*NSLOT*SLOTB, LDS_OST=LDS_WS+NW*64*4, LDS_BYTES=LDS_OST+NW*4096;
constexpr float C2=0.125f*1.4426950408889634f;
__device__ __forceinline__ void glds16(const void*gsrc,unsigned lds_dst){unsigned keep;
  asm volatile("s_mov_b32 %0, m0\n\ts_mov_b32 m0, %2\n\ts_nop 0\n\tglobal_load_lds_dwordx4 %1, off\n\ts_mov_b32 m0, %0":"=&s"(keep):"v"(gsrc),"s"(lds_dst):"memory");}
__device__ __forceinline__ float max3f(float a,float b,float c){float r;asm("v_max3_f32 %0, %1, %2, %3":"=v"(r):"v"(a),"v"(b),"v"(c));return r;}
__device__ __forceinline__ float max2f(float a,float b){float r;asm("v_max_f32_e32 %0, %1, %2":"=v"(r):"v"(a),"v"(b));return r;}
__device__ __forceinline__ float fadd_s(float a,float b){float r;asm("v_add_f32_e32 %0, %1, %2":"=v"(r):"v"(a),"v"(b));return r;}
__device__ __forceinline__ float fsub_s(float a,float b){float r;asm("v_sub_f32_e32 %0, %1, %2":"=v"(r):"v"(a),"v"(b));return r;}
typedef float f32x2_t __attribute__((ext_vector_type(2))); typedef __bf16 bf16x2_t __attribute__((ext_vector_type(2)));
__device__ __forceinline__ unsigned cvtpk_s(float lo,float hi){f32x2_t v={lo,hi};bf16x2_t b=__builtin_convertvector(v,bf16x2_t);return __builtin_bit_cast(unsigned,b);}
#define WAIT_BAR(N) asm volatile("s_waitcnt vmcnt(" #N ") lgkmcnt(0)\n\ts_barrier":::"memory")

__device__ __forceinline__ void qkt(f32x16&p0,f32x16&p1,const char*Kslot,const bf16x8*qr,const f32x16&negm,int r32,int hi){
  const char*kb=Kslot+hi*1024+r32*16;
  #pragma unroll
  for(int d0=0;d0<4;++d0){
    const bf16x8 b0=*reinterpret_cast<const bf16x8*>(kb+d0*2048);
    const bf16x8 b1=*reinterpret_cast<const bf16x8*>(kb+d0*2048+512);
    if(d0==0){p0=__builtin_amdgcn_mfma_f32_32x32x16_bf16(b0,qr[0],negm,0,0,0);p1=__builtin_amdgcn_mfma_f32_32x32x16_bf16(b1,qr[0],negm,0,0,0);}
    else{p0=__builtin_amdgcn_mfma_f32_32x32x16_bf16(b0,qr[d0],p0,0,0,0);p1=__builtin_amdgcn_mfma_f32_32x32x16_bf16(b1,qr[d0],p1,0,0,0);}}
}
typedef __attribute__((address_space(3))) const char* lds_cptr;
typedef short v4i16_t __attribute__((ext_vector_type(4)));
__device__ __forceinline__ void kload8(bf16x8*kf,lds_cptr kp){
  kf[0]=*(const __attribute__((address_space(3))) bf16x8*)(kp);      kf[1]=*(const __attribute__((address_space(3))) bf16x8*)(kp+512);
  kf[2]=*(const __attribute__((address_space(3))) bf16x8*)(kp+2048); kf[3]=*(const __attribute__((address_space(3))) bf16x8*)(kp+2560);
  kf[4]=*(const __attribute__((address_space(3))) bf16x8*)(kp+4096); kf[5]=*(const __attribute__((address_space(3))) bf16x8*)(kp+4608);
  kf[6]=*(const __attribute__((address_space(3))) bf16x8*)(kp+6144); kf[7]=*(const __attribute__((address_space(3))) bf16x8*)(kp+6656);
}
__device__ __forceinline__ void kload2(bf16x8*kf,lds_cptr kp,int j){ kf[2*j]=*(const __attribute__((address_space(3))) bf16x8*)(kp+j*2048); kf[2*j+1]=*(const __attribute__((address_space(3))) bf16x8*)(kp+j*2048+512); }
__device__ __forceinline__ s16x4 vtr(lds_cptr p){ return __builtin_bit_cast(s16x4,__builtin_amdgcn_ds_read_tr16_b64_v4i16((__attribute__((address_space(3))) v4i16_t*)p)); }
__device__ __forceinline__ float rowmax(const f32x16&p0,const f32x16&p1){
  float a=max3f(p0[0],p0[1],p1[0]),b=max3f(p0[2],p0[3],p1[1]);a=max3f(a,p1[2],p1[3]);
  #pragma unroll
  for(int r=4;r<16;r+=4){a=max3f(a,p0[r],p0[r+1]);b=max3f(b,p0[r+2],p0[r+3]);a=max3f(a,p1[r],p1[r+1]);b=max3f(b,p1[r+2],p1[r+3]);}
  const float m=max2f(a,b);
  auto rr=__builtin_amdgcn_permlane32_swap(__float_as_uint(m),__float_as_uint(m),false,false);
  return max2f(__uint_as_float(rr[0]),__uint_as_float(rr[1]));
}
__device__ __forceinline__ void pv(f32x16*o,int vb,bf16x8 pa0,bf16x8 pa1,bf16x8 pa2,bf16x8 pa3){
  #pragma unroll
  for(int d0=0;d0<2;++d0){s16x4 lo[4],hi[4];
    #pragma unroll
    for(int ks=0;ks<4;++ks){
      asm volatile("ds_read_b64_tr_b16 %0,%1 offset:%c2":"=&v"(lo[ks]):"v"(vb),"i"(d0*4096+ks*1024):"memory");
      asm volatile("ds_read_b64_tr_b16 %0,%1 offset:%c2":"=&v"(hi[ks]):"v"(vb),"i"(d0*4096+ks*1024+512):"memory");}
    asm volatile("s_waitcnt lgkmcnt(0)":::"memory");SBAR();
    #define PK(k) (bf16x8){lo[k][0],lo[k][1],lo[k][2],lo[k][3],hi[k][0],hi[k][1],hi[k][2],hi[k][3]}
    o[d0]=__builtin_amdgcn_mfma_f32_32x32x16_bf16(pa0,PK(0),o[d0],0,0,0);
    o[d0]=__builtin_amdgcn_mfma_f32_32x32x16_bf16(pa1,PK(1),o[d0],0,0,0);
    o[d0]=__builtin_amdgcn_mfma_f32_32x32x16_bf16(pa2,PK(2),o[d0],0,0,0);
    o[d0]=__builtin_amdgcn_mfma_f32_32x32x16_bf16(pa3,PK(3),o[d0],0,0,0);
    #undef PK
  }
}

#ifndef ATTN_STORE16
#define ATTN_STORE16(p,v) (*(u32x4*)(p)=(v))
#endif
template<int THRL> __device__ __forceinline__ void attn_unit(int b,int hq,int hv,int qb,const bf16*Q,const bf16*__restrict__ K,const bf16*__restrict__ V,bf16*O,char*shm,lds_fptr tab,int wid_in){
  int lane; asm volatile("v_mbcnt_lo_u32_b32 %0, -1, 0\n\tv_mbcnt_hi_u32_b32 %0, -1, %0" : "=v"(lane)); const int r32=lane&31,hi=lane>>5; const int wid=wid_in;
  const long rowbase=(long)b*SEQ; const int q0=qb*QB;
  const bf16*Qw=Q+(rowbase+q0+wid*QBLK)*DM+hq*D;
  const bf16*Kh=K+rowbase*DM+hq*D,*Vh=V+rowbase*DM+hv*D;
  const unsigned lds0=(unsigned)(uintptr_t)shm;
  float*wsf=(float*)(shm+LDS_WS)+wid*64;
  const bf16*ksrc=Kh+(long)lane*DM+wid*8;
  const bf16*vsrc=Vh+(long)(16*(wid&3)+(lane>>2))*DM+(wid>>2)*32+(lane&3)*8;
  const unsigned kdst=lds0+LDS_K+wid*1024, vdst=lds0+LDS_V+wid*1024;
  #define DMA_K(t,slot) glds16(ksrc+(long)(t)*KVBLK*DM,(unsigned)__builtin_amdgcn_readfirstlane(kdst+(slot)))
  #define DMA_V(t,slot) glds16(vsrc+(long)(t)*KVBLK*DM,(unsigned)__builtin_amdgcn_readfirstlane(vdst+(slot)))
  const int vb0=(int)(lds0+LDS_V)+((lane>>4)&1)*32+(lane&3)*8+(4*hi+((lane&15)>>2))*64;
  const char*Kbase=shm+LDS_K; bf16x8 kf[8];
  const lds_cptr shm3=(lds_cptr)shm; const lds_cptr kp0=shm3+LDS_K+hi*1024+r32*16; const lds_cptr vp0=shm3+LDS_V+((lane>>4)&1)*32+(lane&3)*8+(4*hi+((lane&15)>>2))*64;
  const int NT=(q0+QB)/KVBLK;
  DMA_K(0,0);DMA_V(0,0);DMA_K(1,SLOTB);
  bf16x8 qr[4];
  #pragma unroll
  for(int d0=0;d0<4;++d0)qr[d0]=*reinterpret_cast<const bf16x8*>(&Qw[(long)r32*DM+d0*16+hi*8]);
  float mhat=0.f,l_reg=0.f;f32x16 o[2],negm; { float z_; asm volatile("v_mov_b32 %0, 0":"=v"(z_)); _Pragma("unroll") for(int r=0;r<16;++r){o[0][r]=z_;o[1][r]=z_;negm[r]=z_;} } asm volatile("":"+v"(negm));
  const int qrel=wid*QBLK+r32;
  #define CMASK(P0,P1,t) do{int jb_=(t)-(NT-4); if(jb_>=-2)bmask(P0,P1,jb_,qrel,hi,tab);}while(0)
  bool resc=false;
  #define START(P0,P1) do{ const float rm=rowmax(P0,P1); resc=false; \
    { const float dl=rm; mhat=fadd_s(mhat,dl); \
      _Pragma("unroll") for(int r=0;r<16;++r){P0[r]=fsub_s(P0[r],dl);P1[r]=fsub_s(P1[r],dl);} \
      _Pragma("unroll") for(int r=0;r<16;++r)negm[r]=-mhat; asm volatile("":"+v"(negm)); } \
    _Pragma("unroll") for(int r=0;r<16;++r)P0[r]=__builtin_amdgcn_exp2f(P0[r]); }while(0)
  #define RESC() do{ if(resc){ asm volatile("s_waitcnt lgkmcnt(0)":::"memory"); \
      _Pragma("unroll") for(int d_=0;d_<2;++d_) _Pragma("unroll") for(int r=0;r<16;++r)o[d_][r]*=wsf[crow(r,hi)]; } }while(0)
  f32x16 pA0,pA1,pB0,pB1;
  int sl_prev=0,sl_cur=0,sl_next=SLOTB;
  #define ROT() do{sl_prev=sl_cur;sl_cur=sl_next;sl_next=(sl_next==(NSLOT-1)*SLOTB)?0:sl_next+SLOTB;}while(0)
  DMA_K(2,2*SLOTB);
  WAIT_BAR(3);
  qkt(pA0,pA1,Kbase,qr,negm,r32,hi);asm volatile("s_nop 15\n\ts_nop 7":"+v"(pA0),"+v"(pA1));CMASK(pA0,pA1,0);
  START(pA0,pA1);
  _Pragma("unroll") for(int r=0;r<16;++r)pA1[r]=__builtin_amdgcn_exp2f(pA1[r]);
  WAIT_BAR(0);
  DMA_K(3,0);DMA_V(1,SLOTB);
  ROT();
  kload8(kf,kp0+sl_cur);
  WAIT_BAR(2);
  s16x4 vlo[8],vhi[8]; u32x4 pw0,pw1,pw2,pw3;
  #define PKW(P,B) cvtpk_s(P[B],P[B+1])
  #define PAF(k) __builtin_bit_cast(bf16x8,pw##k)
  #define VFR(i) (bf16x8){vlo[i][0],vlo[i][1],vlo[i][2],vlo[i][3],vhi[i][0],vhi[i][1],vhi[i][2],vhi[i][3]}
  #define PIN(x) asm volatile("":"+v"(x))
  #define MX3(a,b,c) __builtin_fmaxf(__builtin_fmaxf((a),(b)),(c))
  #define GAPA(MF,A0,A1,A2,A3,W0,W1,PW) do{ MF; sacc+=A0; sacc+=A1; sacc+=A2; sacc+=A3; PIN(sacc); W0; W1; PIN(PW); SBAR(); }while(0)
  #define EX(v) __builtin_amdgcn_exp2f(v)
  #define GAPB(MF,X,B) do{ MF; X[B]=EX(X[B]); X[B+1]=EX(X[B+1]); X[B+2]=EX(X[B+2]); X[B+3]=EX(X[B+3]); PIN(X); SBAR(); }while(0)
  #define VRD(i) do{ vlo[i]=vtr(vp_+(((i)>>2)*4096+((i)&3)*1024)); vhi[i]=vtr(vp_+(((i)>>2)*4096+((i)&3)*1024+512)); }while(0)
  #define KRD(G,j) do{ if(G){ kload2(kf,kp0+sl_next,j); SBAR(); } }while(0)
  #define STEP(C0,C1,P0,P1,t,GK,GV,GL) do{ SBAR(); \
    const lds_cptr vp_=vp0+sl_prev; \
    VRD(0); SBAR(); float sacc=(P0[0]+P0[1]); \
    GAPA(C0=__builtin_amdgcn_mfma_f32_32x32x16_bf16(kf[0],qr[0],negm,0,0,0), P0[2],P0[3],P0[4],P0[5],     pw0[0]=PKW(P0,0), pw0[1]=PKW(P0,2), pw0); \
    VRD(4); SBAR(); GAPA(C1=__builtin_amdgcn_mfma_f32_32x32x16_bf16(kf[1],qr[0],negm,0,0,0), P0[6],P0[7],P0[8],P0[9],     pw0[2]=PKW(P0,4), pw0[3]=PKW(P0,6), pw0); \
    VRD(1); SBAR(); GAPA(C0=__builtin_amdgcn_mfma_f32_32x32x16_bf16(kf[2],qr[1],C0,0,0,0),   P0[10],P0[11],P0[12],P0[13], pw1[0]=PKW(P0,8), pw1[1]=PKW(P0,10), pw1); \
    VRD(5); SBAR(); GAPA(C1=__builtin_amdgcn_mfma_f32_32x32x16_bf16(kf[3],qr[1],C1,0,0,0),   P0[14],P0[15],P1[0],P1[1],   pw1[2]=PKW(P0,12),pw1[3]=PKW(P0,14), pw1); \
    VRD(2); SBAR(); GAPA(C0=__builtin_amdgcn_mfma_f32_32x32x16_bf16(kf[4],qr[2],C0,0,0,0),   P1[2],P1[3],P1[4],P1[5],     pw2[0]=PKW(P1,0), pw2[1]=PKW(P1,2), pw2); \
    VRD(6); SBAR(); GAPA(C1=__builtin_amdgcn_mfma_f32_32x32x16_bf16(kf[5],qr[2],C1,0,0,0),   P1[6],P1[7],P1[8],P1[9],     pw2[2]=PKW(P1,4), pw2[3]=PKW(P1,6), pw2); \
    VRD(3); SBAR(); GAPA(C0=__builtin_amdgcn_mfma_f32_32x32x16_bf16(kf[6],qr[3],C0,0,0,0),   P1[10],P1[11],P1[12],P1[13], pw3[0]=PKW(P1,8), pw3[1]=PKW(P1,10), pw3); \
    VRD(7); SBAR(); GAPA(C1=__builtin_amdgcn_mfma_f32_32x32x16_bf16(kf[7],qr[3],C1,0,0,0),   P1[14],P1[15],0.f,0.f,       pw3[2]=PKW(P1,12),pw3[3]=PKW(P1,14), pw3); \
    l_reg+=sacc; \
    if(GK){DMA_K((t)+3,sl_cur);} if(GV){DMA_V((t)+1,sl_next);} \
    CMASK(C0,C1,t); \
    { float a=MX3(C0[0],C0[1],C1[0]),b=MX3(C0[2],C0[3],C1[1]); a=MX3(a,C1[2],C1[3]); \
      _Pragma("unroll") for(int r=4;r<16;r+=4){a=MX3(a,C0[r],C0[r+1]);b=MX3(b,C0[r+2],C0[r+3]);a=MX3(a,C1[r],C1[r+1]);b=MX3(b,C1[r+2],C1[r+3]);} \
      float rm=__builtin_fmaxf(a,b); { auto rr=__builtin_amdgcn_permlane32_swap(__float_as_uint(rm),__float_as_uint(rm),false,false); rm=__builtin_fmaxf(__uint_as_float(rr[0]),__uint_as_float(rr[1])); } \
      resc=false; \
      if(__builtin_expect(__any(rm>(float)THRL),0)){ const float dl=__builtin_fmaxf(rm,0.f); mhat+=dl; \
        _Pragma("unroll") for(int r=0;r<16;++r){C0[r]-=dl;C1[r]-=dl;} \
        _Pragma("unroll") for(int r=0;r<16;++r)negm[r]=-mhat; asm volatile("":"+v"(negm)); \
        const float f=__builtin_amdgcn_exp2f(-dl); l_reg*=f; if(hi==0)wsf[r32]=f; resc=true; } } \
    SBAR(); \
    GAPB(o[0]=__builtin_amdgcn_mfma_f32_32x32x16_bf16(PAF(0),VFR(0),o[0],0,0,0), C0,0); \
    GAPB(o[1]=__builtin_amdgcn_mfma_f32_32x32x16_bf16(PAF(0),VFR(4),o[1],0,0,0), C0,4); \
    KRD(GL,0); GAPB(o[0]=__builtin_amdgcn_mfma_f32_32x32x16_bf16(PAF(1),VFR(1),o[0],0,0,0), C0,8); \
    KRD(GL,1); GAPB(o[1]=__builtin_amdgcn_mfma_f32_32x32x16_bf16(PAF(1),VFR(5),o[1],0,0,0), C0,12); \
    KRD(GL,2); GAPB(o[0]=__builtin_amdgcn_mfma_f32_32x32x16_bf16(PAF(2),VFR(2),o[0],0,0,0), C1,0); \
    KRD(GL,3); GAPB(o[1]=__builtin_amdgcn_mfma_f32_32x32x16_bf16(PAF(2),VFR(6),o[1],0,0,0), C1,4); \
    GAPB(o[0]=__builtin_amdgcn_mfma_f32_32x32x16_bf16(PAF(3),VFR(3),o[0],0,0,0), C1,8); \
    GAPB(o[1]=__builtin_amdgcn_mfma_f32_32x32x16_bf16(PAF(3),VFR(7),o[1],0,0,0), C1,12); \
    }while(0)
  int t=1;
  #undef CMASK
  #define CMASK(P0,P1,t) do{}while(0)
  for(;t+7<NT;t+=2){
    STEP(pB0,pB1,pA0,pA1,t,true,true,true);     WAIT_BAR(2); RESC(); ROT();
    STEP(pA0,pA1,pB0,pB1,t+1,true,true,true);   WAIT_BAR(2); RESC(); ROT();
  }
  #undef CMASK
  #define CMASK(P0,P1,t) do{int jb_=(t)-(NT-4); if(jb_>=-2)bmask(P0,P1,jb_,qrel,hi,tab);}while(0)
  #define ENDW(tt) do{ if((tt)+3<NT){WAIT_BAR(2);} else if((tt)+2<NT){WAIT_BAR(1);} else {WAIT_BAR(0);} }while(0)
  for(;t+1<NT;t+=2){
    STEP(pB0,pB1,pA0,pA1,t,(t+3<NT),(t+1<NT),(t+1<NT));       ENDW(t);   RESC(); ROT();
    STEP(pA0,pA1,pB0,pB1,t+1,(t+4<NT),(t+2<NT),(t+2<NT));     ENDW(t+1); RESC(); ROT();
  }
  STEP(pB0,pB1,pA0,pA1,NT-1,false,false,false); RESC();
  { float sacc=pB0[0]+pB0[1]; _Pragma("unroll") for(int r=2;r<16;++r)sacc+=pB0[r]; _Pragma("unroll") for(int r=0;r<16;++r)sacc+=pB1[r]; l_reg+=sacc;
    pw0=(u32x4){PKW(pB0,0),PKW(pB0,2),PKW(pB0,4),PKW(pB0,6)};pw1=(u32x4){PKW(pB0,8),PKW(pB0,10),PKW(pB0,12),PKW(pB0,14)};pw2=(u32x4){PKW(pB1,0),PKW(pB1,2),PKW(pB1,4),PKW(pB1,6)};pw3=(u32x4){PKW(pB1,8),PKW(pB1,10),PKW(pB1,12),PKW(pB1,14)};
    SBAR(); pv(o,vb0+sl_cur,PAF(0),PAF(1),PAF(2),PAF(3)); }
  #undef PKW
  #undef PAF
  #undef VFR
  #undef PIN
  #undef MX3
  #undef GAPA
  #undef GAPB
  #undef EX
  #undef VRD
  #undef KRD
  #undef STEP
  #undef ENDW
  {auto rr=__builtin_amdgcn_permlane32_swap(__float_as_uint(l_reg),__float_as_uint(l_reg),false,false);l_reg=__uint_as_float(rr[0])+__uint_as_float(rr[1]);}
  if(hi==0)wsf[32+r32]=l_reg;asm volatile("s_waitcnt lgkmcnt(0)":::"memory");
  float rli[16];
  #pragma unroll
  for(int r=0;r<16;++r)rli[r]=__builtin_amdgcn_rcpf(wsf[32+crow(r,hi)]);
  bf16*Ow=O+(rowbase+q0+wid*QBLK)*DM+hv*D;
  { bf16*stg=(bf16*)(shm+LDS_OST)+wid*2048;
    #pragma unroll
    for(int r=0;r<16;++r){const int orow=crow(r,hi);
      #pragma unroll
      for(int d0=0;d0<2;++d0)stg[orow*64+d0*32+r32]=__float2bfloat16(o[d0][r]*rli[r]);}
    asm volatile("s_waitcnt lgkmcnt(0)":::"memory");
    #pragma unroll
    for(int i=0;i<4;++i){const int row=i*8+(lane>>3),ch=lane&7; const u32x4 v=*(const u32x4*)(stg+row*64+ch*8); ATTN_STORE16(Ow+(long)row*DM+ch*8,v);} }
  asm volatile("s_waitcnt lgkmcnt(0)\n\ts_barrier":::"memory");
  #undef DMA_K
  #undef DMA_V
  #undef CMASK
  #undef START
  #undef RESC
  #undef ROT
}
constexpr int ATTN_LDS_BYTES=LDS_BYTES;
#undef SBAR
#undef WAIT_BAR
}

#define GAS __attribute__((address_space(1)))
#define LAS __attribute__((address_space(3)))
typedef unsigned short bf16;
typedef unsigned v4u __attribute__((ext_vector_type(4)));
typedef float f32x4 __attribute__((ext_vector_type(4)));
typedef short bf16x8 __attribute__((ext_vector_type(8)));
typedef GAS unsigned gu32;
typedef GAS unsigned long long gu64;
#define RLX_AGENT __ATOMIC_RELAXED, __HIP_MEMORY_SCOPE_AGENT
#define LDS_WAIT() asm volatile("s_waitcnt lgkmcnt(0)" ::: "memory")
#define VM_WAIT() asm volatile("s_waitcnt vmcnt(0)" ::: "memory")
__device__ __forceinline__ unsigned long long rt() { return __builtin_amdgcn_s_memrealtime(); }
__device__ __forceinline__ unsigned f2bf(float f) { unsigned u = __builtin_bit_cast(unsigned, f); return (u + 0x7fffu + ((u >> 16) & 1u)) >> 16; }
__device__ __forceinline__ unsigned pk2(float lo, float hi) { return f2bf(lo) | (f2bf(hi) << 16); }

#define XB_TMO      128
#define XB_XCNT(j)  (256  + 64 * (j))
#define XB_XSUB(j)  (1280 + 64 * (j))
#define XB_XGEN(j)  (2304 + 64 * (j))
#define XB_TOP      3328
#define XB_TOPGEN   3392
#define XCD_BAR_WORDS 3456
#define XB_SPIN_CAP (1u << 18)

__device__ __forceinline__ unsigned xb_ld(unsigned* p)              { return __hip_atomic_load(p, __ATOMIC_RELAXED, __HIP_MEMORY_SCOPE_AGENT); }
__device__ __forceinline__ unsigned xb_add(unsigned* p, unsigned v) { return __hip_atomic_fetch_add(p, v, __ATOMIC_RELAXED, __HIP_MEMORY_SCOPE_AGENT); }
__device__ __forceinline__ unsigned xb_xcc_id() { return (unsigned)__builtin_amdgcn_s_getreg((3 << 11) | 20) & 0xFu; }
#define XB_SPIN(cond, bar) do { unsigned _sp = 0; while (cond) { __builtin_amdgcn_s_sleep(1); \
    if ((++_sp & 255u) == 0u) { if (xb_ld(&(bar)[XB_TMO])) break; if (_sp > XB_SPIN_CAP) { atomicAdd(&(bar)[XB_TMO], 1u); break; } } } } while (0)

struct XcdBarrier {
    unsigned* bar; unsigned x;
    volatile LAS unsigned* st;
};

__device__ __forceinline__ XcdBarrier xcd_barrier_post(unsigned* bar, volatile LAS unsigned* st) {
    XcdBarrier b; b.bar = bar; b.x = xb_xcc_id(); b.st = st;
    if (threadIdx.x == 0) (void)xb_add(&bar[XB_XCNT(b.x)], 1u);
    return b;
}
__device__ __forceinline__ void xcd_barrier_complete(unsigned* bar, unsigned x, unsigned& nloc, unsigned& nx) {
    const unsigned G = gridDim.x * gridDim.y * gridDim.z;
    unsigned sum, cnt, mine, sp = 0u;
    for (;;) {
        sum = 0u; cnt = 0u; mine = 0u;
#pragma unroll
        for (unsigned j = 0; j < 16; ++j) { const unsigned c = xb_ld(&bar[XB_XCNT(j)]); sum += c; cnt += (c > 0u) ? 1u : 0u; mine = (j == x) ? c : mine; }
        if (sum == G) break;
        __builtin_amdgcn_s_sleep(1);
        if ((++sp & 255u) == 0u) { if (xb_ld(&bar[XB_TMO])) break; if (sp > XB_SPIN_CAP) { atomicAdd(&bar[XB_TMO], 1u); break; } }
    }
    nloc = mine > 0u ? mine : 1u; nx = cnt > 0u ? cnt : 1u;
}

__device__ __forceinline__ void xcd_barrier(const XcdBarrier& b, const bool leader) {
    asm volatile("s_waitcnt vmcnt(0)" ::: "memory");
    __syncthreads();
    if (leader) {
        unsigned* bar = b.bar;
        __builtin_amdgcn_s_waitcnt(0);
        unsigned nloc = b.st[0], nx = b.st[1];
        if (nloc == 0u) { xcd_barrier_complete(bar, b.x, nloc, nx); b.st[0] = nloc; b.st[1] = nx; }
        const unsigned old = xb_add(&bar[XB_XSUB(b.x)], 1u);
        const unsigned gen = old / nloc;
        if (old + 1u == (gen + 1u) * nloc) {
            __builtin_amdgcn_fence(__ATOMIC_RELEASE, "agent");
            asm volatile("s_waitcnt vmcnt(0)" ::: "memory");
            const unsigned og = xb_add(&bar[XB_TOP], 1u);
            const unsigned tg = og / nx;
            if (og + 1u == (tg + 1u) * nx) xb_add(&bar[XB_TOPGEN], 1u);
            else XB_SPIN(xb_ld(&bar[XB_TOPGEN]) == tg, bar);
            __builtin_amdgcn_fence(__ATOMIC_ACQUIRE, "agent");
            xb_add(&bar[XB_XGEN(b.x)], 1u);
            asm volatile("s_waitcnt vmcnt(0)" ::: "memory");
        } else {
            XB_SPIN(xb_ld(&bar[XB_XGEN(b.x)]) == gen, bar);
            __builtin_amdgcn_fence(__ATOMIC_ACQUIRE, "agent");
            asm volatile("s_waitcnt vmcnt(0)" ::: "memory");
        }
    }
    __syncthreads();
}


constexpr int NWAVES = 8;
constexpr int RING_OFF = 0, RING_BYTES = 131072;
constexpr int LDSCTL_OFF = RING_BYTES, MISC_OFF = LDSCTL_OFF + 320;
constexpr int LDS_BYTES = 147456;
constexpr int ATT_TAB_OFF = 86016;
static_assert(attn_body::ATTN_LDS_BYTES <= ATT_TAB_OFF && ATT_TAB_OFF + 4096 <= RING_BYTES, "attention LDS map");
constexpr int CW_TMO = 0, CW_CODE = 1, CW_BAR = 4096;
static_assert((CW_BAR + XCD_BAR_WORDS) * 4 <= (int)CTL_ZERO_BYTES, "control words inside the memset region");
constexpr int N_PHASES = 9;
#ifndef MK_ALIGN
#define MK_ALIGN true
#endif
#ifndef MK_SP2
#define MK_SP2 true
#endif

__device__ __forceinline__ float wave_sum(float v) {
#pragma unroll
    for (int o = 1; o < 64; o <<= 1) v += __shfl_xor(v, o);
    return v;
}
__device__ __forceinline__ float sigm(float x) { return __builtin_amdgcn_rcpf(1.0f + __builtin_amdgcn_exp2f(-1.4426950408889634f * x)); }

__device__ __forceinline__ void p0_transpose_item(const float* W, int N, bf16* WT, int ldt, int koff, LAS float* scr, int item, int lane, int rot = 0) {
    const int nblk = N / 32, kb = item / nblk, nb = item % nblk, k0 = 64 * kb, n0 = 32 * nb;
#pragma unroll 8
    for (int i = 0; i < 32; ++i) { const int kk = 2 * i + (lane >> 5); scr[kk * 33 + (lane & 31)] = W[(size_t)(k0 + kk) * N + n0 + (lane & 31)]; }
    LDS_WAIT(); asm volatile("" ::: "memory");
    const int c = lane & 7;
#pragma unroll
    for (int j = 0; j < 4; ++j) { const int n = (lane >> 3) + 8 * j; const LAS float* s = scr + (8 * c) * 33 + n;
        v4u o; o.x = pk2(s[0 * 33], s[1 * 33]); o.y = pk2(s[2 * 33], s[3 * 33]); o.z = pk2(s[4 * 33], s[5 * 33]); o.w = pk2(s[6 * 33], s[7 * 33]);
        *(GAS v4u*)(WT + (size_t)((n0 + n + rot) & (N - 1)) * ldt + koff + k0 + 8 * c) = o; }
    LDS_WAIT(); asm volatile("" ::: "memory");
}

__device__ __forceinline__ void rnn_phase(LAS unsigned char* lds, int vcu, int lane, int wave, const bf16* RX, bf16* YA, const float* conv_w, const float* conv_b,
                                          const float* w_a, const float* b_a, const float* w_x, const float* b_x, const float* lam) {
    const int b = vcu >> 6, hb = (vcu >> 2) & 15, qd = vcu & 3, fr = lane & 15, fq = lane >> 4;
    const int cin0 = hb * 64, co = hb * 64 + qd * 16 + fr;
    bf16x8 Ba[2], Bx[2], Bs[2];
#pragma unroll
    for (int ks = 0; ks < 2; ++ks)
#pragma unroll
        for (int j = 0; j < 8; ++j) { const int i = 32 * ks + 8 * fq + j, jo = qd * 16 + fr;
            Ba[ks][j] = (short)f2bf(w_a[(size_t)hb * 4096 + i * 64 + jo]); Bx[ks][j] = (short)f2bf(w_x[(size_t)hb * 4096 + i * 64 + jo]); Bs[ks][j] = (i == jo) ? (short)0x3f80 : (short)0; }
    float cw[2][4][8], cb[2][8];
#pragma unroll
    for (int ks = 0; ks < 2; ++ks)
#pragma unroll
        for (int j = 0; j < 8; ++j) { const int ch = cin0 + 32 * ks + 8 * fq + j; cb[ks][j] = conv_b[ch];
#pragma unroll
            for (int tp = 0; tp < 4; ++tp) cw[ks][tp][j] = conv_w[tp * 1024 + ch]; }
    const float bav = b_a[co], bxv = b_x[co]; const float logu = -8.0f * log1pf(expf(-lam[co]));
    float hsc = 0.f;
    LAS float* tot = (LAS float*)lds;
    const bf16* RXb = RX + (size_t)b * SEQ * 1024 + cin0 + 8 * fq;
    bf16* YAb = YA + (size_t)b * SEQ * 2048 + co;
    for (int sc = 0; sc < SEQ / 512; ++sc) {
        const int t0 = sc * 512 + wave * 64;
        unsigned short rg[4][4];
#pragma unroll
        for (int m = 0; m < 4; ++m)
#pragma unroll
            for (int r = 0; r < 4; ++r) rg[m][r] = YAb[(size_t)(t0 + 16 * m + 4 * fq + r) * 2048];
        float hl[4][4], ac[4][4]; float Ach = 1.f, Hch = 0.f;
#pragma unroll
        for (int m = 0; m < 4; ++m) {
            const int tok = t0 + 16 * m + fr;
            bf16x8 Af[2];
#pragma unroll
            for (int ks = 0; ks < 2; ++ks) {
                float xc[8];
#pragma unroll
                for (int j = 0; j < 8; ++j) xc[j] = cb[ks][j];
#pragma unroll
                for (int tp = 0; tp < 4; ++tp) { const int tt = tok - 3 + tp; v4u xr = (v4u){0u, 0u, 0u, 0u};
                    if (tt >= 0) xr = *(const GAS v4u*)(RXb + (size_t)tt * 1024 + 32 * ks);
                    xc[0] += cw[ks][tp][0] * __uint_as_float(xr.x << 16); xc[1] += cw[ks][tp][1] * __uint_as_float(xr.x & 0xffff0000u);
                    xc[2] += cw[ks][tp][2] * __uint_as_float(xr.y << 16); xc[3] += cw[ks][tp][3] * __uint_as_float(xr.y & 0xffff0000u);
                    xc[4] += cw[ks][tp][4] * __uint_as_float(xr.z << 16); xc[5] += cw[ks][tp][5] * __uint_as_float(xr.z & 0xffff0000u);
                    xc[6] += cw[ks][tp][6] * __uint_as_float(xr.w << 16); xc[7] += cw[ks][tp][7] * __uint_as_float(xr.w & 0xffff0000u); }
                v4u pk; pk.x = pk2(xc[0], xc[1]); pk.y = pk2(xc[2], xc[3]); pk.z = pk2(xc[4], xc[5]); pk.w = pk2(xc[6], xc[7]);
                Af[ks] = __builtin_bit_cast(bf16x8, pk);
            }
            f32x4 Dr = (f32x4){0.f, 0.f, 0.f, 0.f}, Di = Dr, Dx = Dr;
#pragma unroll
            for (int ks = 0; ks < 2; ++ks) { Dr = __builtin_amdgcn_mfma_f32_16x16x32_bf16(Af[ks], Ba[ks], Dr, 0, 0, 0); Di = __builtin_amdgcn_mfma_f32_16x16x32_bf16(Af[ks], Bx[ks], Di, 0, 0, 0);
                Dx = __builtin_amdgcn_mfma_f32_16x16x32_bf16(Af[ks], Bs[ks], Dx, 0, 0, 0); }
            float al[4], hh[4];
#pragma unroll
            for (int r = 0; r < 4; ++r) { const float rr = sigm(Dr[r] + bav), ii = sigm(Di[r] + bxv); const float la = rr * logu; const float a = __expf(la);
                const float bin = sqrtf(-expm1f(2.0f * la)) * (ii * Dx[r]);
                if (r == 0) { al[0] = a; hh[0] = bin; } else { al[r] = a * al[r - 1]; hh[r] = a * hh[r - 1] + bin; } }
            float Ai = al[3], Hi = hh[3];
            { const float Ap = __shfl_up(Ai, 16), Hp = __shfl_up(Hi, 16); if (fq >= 1) { Hi = Ai * Hp + Hi; Ai = Ai * Ap; } }
            { const float Ap = __shfl_up(Ai, 32), Hp = __shfl_up(Hi, 32); if (fq >= 2) { Hi = Ai * Hp + Hi; Ai = Ai * Ap; } }
            float Ae = __shfl_up(Ai, 16), He = __shfl_up(Hi, 16); if (fq == 0) { Ae = 1.f; He = 0.f; }
            const float hin = Ae * Hch + He, Ain = Ae * Ach;
#pragma unroll
            for (int r = 0; r < 4; ++r) { hl[m][r] = hh[r] + al[r] * hin; ac[m][r] = al[r] * Ain; }
            const float Am = __shfl(Ai, 48 + fr), Hm = __shfl(Hi, 48 + fr);
            Hch = Am * Hch + Hm; Ach = Am * Ach;
        }
        LAS float* tw = tot + ((sc & 1) * 8 + wave) * 32;
        if (fq == 0) { tw[fr * 2] = Ach; tw[fr * 2 + 1] = Hch; }
        asm volatile("s_waitcnt lgkmcnt(0)\n\ts_barrier" ::: "memory");
        float cin = 0.f, c = hsc;
#pragma unroll
        for (int w2 = 0; w2 < 8; ++w2) { const LAS float* tr = tot + ((sc & 1) * 8 + w2) * 32 + fr * 2; const float A = tr[0], H = tr[1]; if (w2 == wave) cin = c; c = A * c + H; }
        hsc = c;
#pragma unroll
        for (int m = 0; m < 4; ++m)
#pragma unroll
            for (int r = 0; r < 4; ++r) { const float h = hl[m][r] + ac[m][r] * cin;
                YAb[(size_t)(t0 + 16 * m + 4 * fq + r) * 2048] = (bf16)f2bf(h * __uint_as_float(((unsigned)rg[m][r]) << 16)); }
    }
    asm volatile("s_waitcnt lgkmcnt(0)\n\ts_barrier" ::: "memory");
}

__device__ __forceinline__ void attn_phase_diff(unsigned char* lds_generic, LAS unsigned char* lds, int vcu, int tid, int wave, const bf16* Q, const bf16* K, const bf16* V, bf16* O0, bf16* O1, const float* rel_bias) {
    LAS float* tab = (LAS float*)(lds + ATT_TAB_OFF);
    for (int e = tid; e < 1024; e += NWAVES * 64) { const int h = e >> 7, n = e & 127;
        int bk; if (n < 16) bk = n; else { bk = 16 + (int)(logf((float)n / 16.0f) / 2.0794415416798357f * 16.0f); bk = bk < 31 ? bk : 31; }
        tab[e] = (rel_bias[bk * 8 + h] - rel_bias[31 * 8 + h]) * 1.4426950408889634f; }
    asm volatile("s_waitcnt lgkmcnt(0)\n\ts_barrier" ::: "memory");
    const int g = vcu >> 3, s = vcu & 7, b = g >> 3, h = g & 7;
    for (int i = 0; i < 16; ++i) {
        const int sub = i >> 2, c = sub >> 1, vh = sub & 1, j = i & 3;
        const int qb = (j == 0) ? s : (j == 1) ? 15 - s : (j == 2) ? 16 + s : 31 - s;
        attn_body::attn_unit<8>(b, h * 2 + c, h * 2 + vh, qb, (const attn_body::bf16*)Q, (const attn_body::bf16*)K, (const attn_body::bf16*)V, (attn_body::bf16*)(c == 0 ? O0 : O1), (char*)lds_generic,
                                (attn_body::lds_fptr)(tab + h * 128), wave);
    }
}

struct Args { const float* in[23]; float* out; unsigned char* ws; int ph_lo, ph_hi; };
typedef const __attribute__((address_space(4))) Args* KArgs;
__device__ __forceinline__ KArgs kargs() { auto p = __builtin_amdgcn_kernarg_segment_ptr(); asm volatile("" : "+s"(p)); return (KArgs)p; }
__device__ __forceinline__ int lane_id() { int l; asm volatile("v_mbcnt_lo_u32_b32 %0, -1, 0\n\tv_mbcnt_hi_u32_b32 %0, -1, %0" : "=v"(l)); return l; }
__global__ void __launch_bounds__(NWAVES * 64, 2) mk_fwd(Args args) {
    extern __shared__ __attribute__((aligned(16))) unsigned char lds_[];
    LAS unsigned char* lds = (LAS unsigned char*)lds_;
    volatile LAS unsigned* MISC = (volatile LAS unsigned*)(lds + MISC_OFF);
    const int wave = __builtin_amdgcn_readfirstlane((int)threadIdx.x >> 6);
    const int G = gridDim.x; const int vcu = (G % 8 == 0) ? ((int)blockIdx.x % 8) * (G / 8) + (int)blockIdx.x / 8 : (int)blockIdx.x;
    const int gw = vcu * NWAVES + wave, NGW = G * NWAVES;
    gu32* ctl = (gu32*)(args.ws + WS_CTL);
    for (int u = threadIdx.x; u < (LDS_BYTES - LDSCTL_OFF) / 4; u += NWAVES * 64) ((LAS unsigned*)(lds + LDSCTL_OFF))[u] = 0u;
    __syncthreads();
    const int lo = args.ph_lo, hi = args.ph_hi;
    const bool use_bar = (hi - lo) > 1;
    XcdBarrier bar; bar.bar = (unsigned*)(ctl + CW_BAR); bar.x = 0; bar.st = nullptr;
    if (use_bar) bar = xcd_barrier_post((unsigned*)(ctl + CW_BAR), MISC + 8);
#define IN(k) (lo <= (k) && (k) < hi)
#define SEAM(k) do { if (IN(k) && IN((k) + 1)) xcd_barrier(bar, wave == 0 && lane_id() == 0); } while (0)

    if (IN(0)) {
        KArgs A = kargs(); const int lane = lane_id(), tid = wave * 64 + lane; (void)tid;
        const float* cvec = A->in[1];
        const float* w_ada = A->in[2];
        const float* b_ada = A->in[3];
        const float* w_in = A->in[4];
        const float* w_rnn_out = A->in[18];
        const float* w_attn_out = A->in[19];
        const float* w_out = A->in[20];
        float* modf = (float*)(A->ws + WS_MODF);
        bf16* win_t = (bf16*)(A->ws + WS_WIN);
        bf16* wcat_t = (bf16*)(A->ws + WS_WCAT);
        bf16* wout_t = (bf16*)(A->ws + WS_WOUT);

        if (vcu < 192) {
            LAS float* scv = (LAS float*)lds;
            LAS float* red = (LAS float*)(lds + 16384);
#pragma unroll
            for (int i = 0; i < 8; ++i) { const int e = tid * 8 + i; const float cv = cvec[e]; scv[e] = cv * sigm(cv); }
            __syncthreads();
            const int e0 = vcu * 16, col = lane & 15, kg = lane >> 4;
            float a0 = 0.f, a1 = 0.f, a2 = 0.f, a3 = 0.f;
#pragma unroll 8
            for (int i = 0; i < 32; ++i) { const int k = wave * 128 + kg * 32 + i; const float w = w_ada[(size_t)k * 3072 + e0 + col];
                a0 += scv[k] * w; a1 += scv[1024 + k] * w; a2 += scv[2048 + k] * w; a3 += scv[3072 + k] * w; }
            a0 += __shfl_xor(a0, 16); a0 += __shfl_xor(a0, 32); a1 += __shfl_xor(a1, 16); a1 += __shfl_xor(a1, 32);
            a2 += __shfl_xor(a2, 16); a2 += __shfl_xor(a2, 32); a3 += __shfl_xor(a3, 16); a3 += __shfl_xor(a3, 32);
            if (kg == 0) { red[(wave * 4 + 0) * 16 + col] = a0; red[(wave * 4 + 1) * 16 + col] = a1; red[(wave * 4 + 2) * 16 + col] = a2; red[(wave * 4 + 3) * 16 + col] = a3; }
            __syncthreads();
            if (tid < 64) { const int bb = tid >> 4, cc = tid & 15; float sacc = b_ada[e0 + cc];
#pragma unroll
                for (int w2 = 0; w2 < 8; ++w2) sacc += red[(w2 * 4 + bb) * 16 + cc];
                modf[bb * 3072 + e0 + cc] = sacc; }
            __syncthreads();
        }
        LAS float* scr = (LAS float*)(lds + RING_OFF + wave * 16384);
        constexpr int I_IN = (DM / 64) * (NIN / 32), I_SQ = (DM / 64) * (DM / 32), NITEMS = I_IN + 3 * I_SQ;
        for (int it = gw; it < NITEMS; it += NGW) {
            int r = it;
            if (r < I_IN) { p0_transpose_item(w_in, NIN, win_t, DM, 0, scr, r, lane); continue; } r -= I_IN;
            if (r < I_SQ) { p0_transpose_item(w_rnn_out, DM, wcat_t, 2048, 0, scr, r, lane); continue; } r -= I_SQ;
            if (r < I_SQ) { p0_transpose_item(w_attn_out, DM, wcat_t, 2048, 1024, scr, r, lane); continue; } r -= I_SQ;
            p0_transpose_item(w_out, DM, wout_t, DM, 0, scr, r, lane);
        }
    }
    SEAM(0);
    if (IN(1)) {
        KArgs A = kargs(); const int lane = lane_id(), tid = wave * 64 + lane; (void)tid;
        const float* x = A->in[0];
        float* modf = (float*)(A->ws + WS_MODF);
        bf16* ubuf = (bf16*)((unsigned char*)A->out + DO_U);

        for (int blk = gw; blk < MTOK / 16; blk += NGW) {
            const int bb = (blk * 16) / SEQ; f32x4 sc4[4], sh4[4];
#pragma unroll
            for (int j = 0; j < 4; ++j) { sh4[j] = *(const GAS f32x4*)(modf + bb * 3072 + 256 * j + 4 * lane); sc4[j] = *(const GAS f32x4*)(modf + bb * 3072 + 1024 + 256 * j + 4 * lane) + 1.0f; }
            for (int rr = 0; rr < 16; ++rr) { const size_t row = (size_t)blk * 16 + rr;
                const GAS f32x4* xr = (const GAS f32x4*)(x + row * DM) + lane; GAS unsigned long long* o8 = (GAS unsigned long long*)(ubuf + row * DM) + lane;
#pragma unroll
                for (int j = 0; j < 4; ++j) { const f32x4 v = xr[64 * j] * sc4[j] + sh4[j]; o8[64 * j] = (unsigned long long)pk2(v.x, v.y) | ((unsigned long long)pk2(v.z, v.w) << 32); } }
        }
    }
    SEAM(1);
    if (IN(2)) {
        KArgs A = kargs(); const int lane = lane_id(), tid = wave * 64 + lane; (void)tid;
        bf16* ubuf = (bf16*)((unsigned char*)A->out + DO_U);
        bf16* win_t = (bf16*)(A->ws + WS_WIN);
        bf16* rxb = (bf16*)((unsigned char*)A->out + DO_RX);
        bf16* ya = (bf16*)(A->ws + WS_YA);
        bf16* qbuf = (bf16*)(A->ws + WS_Q);
        bf16* kbuf = (bf16*)(A->ws + WS_K);
        bf16* vbuf = (bf16*)(A->ws + WS_V);
        bf16* mgb = (bf16*)(A->ws + WS_MG);

        pg8::Gemm g{ubuf, win_t, MTOK, NIN, DM}; pg8::StaticOrder S; S.init(MTOK, NIN, G, (int)blockIdx.x);
        pg8::EpiProjV E{A->ws, (unsigned char*)A->out};
        pg8::gemm_phase<pg8::EpiProjV, pg8::StaticOrder, MK_ALIGN, MK_SP2>(lds + RING_OFF, g, S, E, tid);
    }
    SEAM(2);
    if (IN(3)) {
        KArgs A = kargs(); const int lane = lane_id(), tid = wave * 64 + lane; (void)tid;
        bf16* rxb = (bf16*)((unsigned char*)A->out + DO_RX);
        bf16* ya = (bf16*)(A->ws + WS_YA);
        const float* conv_w = A->in[5];
        const float* conv_b = A->in[6];
        const float* w_rg_a = A->in[7];
        const float* b_rg_a = A->in[8];
        const float* w_rg_x = A->in[9];
        const float* b_rg_x = A->in[10];
        const float* lru_lambda = A->in[11];
 if (G == 256) rnn_phase(lds, vcu, lane, wave, rxb, ya, conv_w, conv_b, w_rg_a, b_rg_a, w_rg_x, b_rg_x, lru_lambda); }
    SEAM(3);
    if (IN(4)) {
        KArgs A = kargs(); const int lane = lane_id(), tid = wave * 64 + lane; (void)tid;
        bf16* qbuf = (bf16*)(A->ws + WS_Q);
        bf16* kbuf = (bf16*)(A->ws + WS_K);
        bf16* vbuf = (bf16*)(A->ws + WS_V);
        bf16* o0 = (bf16*)((unsigned char*)A->out + DO_O0);
        bf16* o1 = (bf16*)((unsigned char*)A->out + DO_O1);
        const float* rel_bias = A->in[17];
 if (G == 256) attn_phase_diff(lds_, lds, vcu, tid, wave, qbuf, kbuf, vbuf, o0, o1, rel_bias); }
    SEAM(4);
    if (IN(5)) {
        KArgs A = kargs(); const int lane = lane_id(), tid = wave * 64 + lane; (void)tid;
        const float* lq1 = A->in[12];
        const float* lk1 = A->in[13];
        const float* lq2 = A->in[14];
        const float* lk2 = A->in[15];
        const float* subln_w = A->in[16];
        bf16* o0 = (bf16*)((unsigned char*)A->out + DO_O0);
        bf16* o1 = (bf16*)((unsigned char*)A->out + DO_O1);
        bf16* ya = (bf16*)(A->ws + WS_YA);

        float s1 = lq1[lane] * lk1[lane], s2 = lq2[lane] * lk2[lane]; s1 = wave_sum(s1); s2 = wave_sum(s2);
        const float lamv = __expf(s1) - __expf(s2) + 0.2f;
        float sw[16];
#pragma unroll
        for (int i = 0; i < 16; ++i) sw[i] = subln_w[(lane * 16 + i) & 127] * 0.8f;
        for (int row = gw; row < MTOK; row += NGW) {
            const GAS v4u* p0 = (const GAS v4u*)(o0 + (size_t)row * 1024 + lane * 16); const GAS v4u* p1 = (const GAS v4u*)(o1 + (size_t)row * 1024 + lane * 16);
            GAS v4u* pa = (GAS v4u*)(ya + (size_t)row * 2048 + 1024 + lane * 16);
            float v[16]; float ss = 0.f; v4u agv[2];
#pragma unroll
            for (int hh = 0; hh < 2; ++hh) { const v4u a = p0[hh], bq = p1[hh]; agv[hh] = pa[hh];
                const unsigned aw[4] = {a.x, a.y, a.z, a.w}, bw[4] = {bq.x, bq.y, bq.z, bq.w};
#pragma unroll
                for (int e = 0; e < 4; ++e) { v[hh * 8 + 2 * e] = __uint_as_float(aw[e] << 16) - lamv * __uint_as_float(bw[e] << 16); v[hh * 8 + 2 * e + 1] = __uint_as_float(aw[e] & 0xffff0000u) - lamv * __uint_as_float(bw[e] & 0xffff0000u); } }
#pragma unroll
            for (int i = 0; i < 16; ++i) ss += v[i] * v[i];
            ss += __shfl_xor(ss, 1); ss += __shfl_xor(ss, 2); ss += __shfl_xor(ss, 4);
            const float rs = rsqrtf(ss * (1.f / 128.f) + LN_EPS);
#pragma unroll
            for (int hh = 0; hh < 2; ++hh) { const unsigned gwd[4] = {agv[hh].x, agv[hh].y, agv[hh].z, agv[hh].w}; v4u o;
                unsigned ow[4];
#pragma unroll
                for (int e = 0; e < 4; ++e) { const int i = hh * 8 + 2 * e; ow[e] = pk2(v[i] * rs * sw[i] * __uint_as_float(gwd[e] << 16), v[i + 1] * rs * sw[i + 1] * __uint_as_float(gwd[e] & 0xffff0000u)); }
                o.x = ow[0]; o.y = ow[1]; o.z = ow[2]; o.w = ow[3]; pa[hh] = o; }
        }
    }
    SEAM(5);
    if (IN(6)) {
        KArgs A = kargs(); const int lane = lane_id(), tid = wave * 64 + lane; (void)tid;
        bf16* ya = (bf16*)(A->ws + WS_YA);
        bf16* wcat_t = (bf16*)(A->ws + WS_WCAT);
        bf16* mgb = (bf16*)(A->ws + WS_MG);
        bf16* merged = (bf16*)(A->ws + WS_Q);

        pg8::Gemm g{ya, wcat_t, MTOK, DM, 2048}; pg8::StaticOrder S; S.init(MTOK, DM, G, (int)blockIdx.x);
        pg8::EpiMergeV E{mgb, merged};
        pg8::gemm_phase<pg8::EpiMergeV, pg8::StaticOrder, MK_ALIGN, MK_SP2>(lds + RING_OFF, g, S, E, tid);
    }
    SEAM(6);
    if (IN(7)) {
        KArgs A = kargs(); const int lane = lane_id(), tid = wave * 64 + lane; (void)tid;
        bf16* merged = (bf16*)(A->ws + WS_Q);
        bf16* wout_t = (bf16*)(A->ws + WS_WOUT);
        const float* x = A->in[0];
        float* modf = (float*)(A->ws + WS_MODF);
        float* outp = A->out;

        pg8::Gemm g{merged, wout_t, MTOK, DM, DM}; pg8::StaticOrder S; S.init(MTOK, DM, G, (int)blockIdx.x);
        pg8::EpiOutV E{x, modf, outp};
        pg8::gemm_phase<pg8::EpiOutV, pg8::StaticOrder, MK_ALIGN, MK_SP2>(lds + RING_OFF, g, S, E, tid);
    }
    SEAM(7);
    if (IN(8)) {
        KArgs A = kargs(); const int lane = lane_id(), tid = wave * 64 + lane; (void)tid;
        const float* ln_g = A->in[21];
        const float* ln_b = A->in[22];
        float* outp = A->out;

        f32x4 gg[4], bb[4];
#pragma unroll
        for (int j = 0; j < 4; ++j) { gg[j] = *(const GAS f32x4*)(ln_g + 256 * j + 4 * lane); bb[j] = *(const GAS f32x4*)(ln_b + 256 * j + 4 * lane); }
        for (int row = gw; row < MTOK; row += NGW) {
            GAS f32x4* p = (GAS f32x4*)(outp + (size_t)row * DM) + lane; f32x4 v[4]; float s = 0.f;
#pragma unroll
            for (int j = 0; j < 4; ++j) { v[j] = p[64 * j]; s += (v[j].x + v[j].y) + (v[j].z + v[j].w); }
            const float mean = wave_sum(s) * (1.f / DM); float s2 = 0.f;
#pragma unroll
            for (int j = 0; j < 4; ++j) { v[j] = v[j] - mean; s2 += (v[j].x * v[j].x + v[j].y * v[j].y) + (v[j].z * v[j].z + v[j].w * v[j].w); }
            const float rstd = rsqrtf(wave_sum(s2) * (1.f / DM) + LN_EPS);
#pragma unroll
            for (int j = 0; j < 4; ++j) p[64 * j] = v[j] * rstd * gg[j] + bb[j];
        }
    }
#undef IN
#undef SEAM
}

#ifndef MK_STEP
#define MK_STEP 4
#define MK_C0 6144
#define MK_C1 7168
#endif
extern "C" void kernel_launch(void* const* d_in, const int* in_sizes, int n_in, void* d_out, int out_size, void* d_ws, size_t ws_size, hipStream_t stream) {
    static int grid = 0;
    if (grid == 0) {
        if (n_in != 23 || out_size != MTOK * DM || ws_size < WS_END) { fprintf(stderr, "kernel_launch: unexpected shapes (n_in %d out %d ws %zu)\n", n_in, out_size, ws_size); grid = -1; return; }
        int dev = 0, cus = 0;
        if (hipGetDevice(&dev) != hipSuccess || hipDeviceGetAttribute(&cus, hipDeviceAttributeMultiprocessorCount, dev) != hipSuccess) { grid = -1; return; }
        if (hipFuncSetAttribute((const void*)mk_fwd, hipFuncAttributeMaxDynamicSharedMemorySize, LDS_BYTES) != hipSuccess) { fprintf(stderr, "kernel_launch: hipFuncSetAttribute failed\n"); grid = -1; return; }
        (void)hipGetLastError();
        grid = cus;
        if (grid != 256) { fprintf(stderr, "kernel_launch: built for 256 CUs, found %d\n", grid); }
    }
    if (grid < 0) return;
    (void)hipMemsetAsync((char*)d_ws + WS_CTL, 0, CTL_ZERO_BYTES, stream);
    Args a{};
    for (int i = 0; i < 23; ++i) a.in[i] = (const float*)d_in[i];
    a.out = (float*)d_out; a.ws = (unsigned char*)d_ws;
#define MK_RUN(lo_, hi_) do { a.ph_lo = (lo_); a.ph_hi = (hi_); hipLaunchKernelGGL(mk_fwd, dim3(grid), dim3(NWAVES * 64), LDS_BYTES, stream, a); } while (0)
    unsigned char* ws = (unsigned char*)d_ws; unsigned char* dob = (unsigned char*)d_out;
    bf16_t* ya = (bf16_t*)(ws + WS_YA); bf16_t* qb = (bf16_t*)(ws + WS_Q); bf16_t* kb = (bf16_t*)(ws + WS_K); bf16_t* vb = (bf16_t*)(ws + WS_V);
    bf16_t* rx = (bf16_t*)(dob + DO_RX); bf16_t* o0 = (bf16_t*)(dob + DO_O0); bf16_t* o1 = (bf16_t*)(dob + DO_O1);
    const float* conv_w = (const float*)d_in[5]; const float* conv_b = (const float*)d_in[6];
    const float* w_rg_a = (const float*)d_in[7]; const float* b_rg_a = (const float*)d_in[8]; const float* w_rg_x = (const float*)d_in[9]; const float* b_rg_x = (const float*)d_in[10];
    const float* lru_lambda = (const float*)d_in[11]; const float* lq1 = (const float*)d_in[12]; const float* lk1 = (const float*)d_in[13]; const float* lq2 = (const float*)d_in[14]; const float* lk2 = (const float*)d_in[15];
    const float* subln_w = (const float*)d_in[16]; const float* rel_bias = (const float*)d_in[17]; const float* ln_g = (const float*)d_in[21]; const float* ln_b = (const float*)d_in[22];
#if MK_STEP == 1
    MK_RUN(0, 1); MK_RUN(1, 2); MK_RUN(2, 3);
    k_rnn_simple<<<NB * 16, 64, 0, stream>>>(rx, ya, conv_w, conv_b, w_rg_a, b_rg_a, w_rg_x, b_rg_x, lru_lambda);
    k_attn_simple<<<NB * 8 * 2 * 32, 256, 0, stream>>>(qb, kb, vb, o0, o1, rel_bias);
    k_combine<<<MTOK / 4, 256, 0, stream>>>(o0, o1, ya, lq1, lk1, lq2, lk2, subln_w);
    MK_RUN(6, 7); MK_RUN(7, 8);
    k_ln<<<MTOK / 4, 256, 0, stream>>>((float*)d_out, ln_g, ln_b);
#elif MK_STEP == 11
    MK_RUN(0, 1); MK_RUN(1, 2); MK_RUN(2, 3);
    k_rnn_simple<<<NB * 16, 64, 0, stream>>>(rx, ya, conv_w, conv_b, w_rg_a, b_rg_a, w_rg_x, b_rg_x, lru_lambda);
    k_attn_simple<<<NB * 8 * 2 * 32, 256, 0, stream>>>(qb, kb, vb, o0, o1, rel_bias);
    k_combine<<<MTOK / 4, 256, 0, stream>>>(o0, o1, ya, lq1, lk1, lq2, lk2, subln_w);
    { EpiMerge e{(bf16_t*)(ws + WS_MG), qb}; k_gemm_simple<EpiMerge, true><<<dim3(DM / 64, MTOK / 64), 256, 0, stream>>>(ya, (bf16_t*)(ws + WS_WCAT), MTOK, DM, 2048, e); }
    { EpiOut e{(const float*)d_in[0], (const float*)(ws + WS_MODF), (float*)d_out}; k_gemm_simple<EpiOut, false><<<dim3(DM / 64, MTOK / 64), 256, 0, stream>>>(qb, (bf16_t*)(ws + WS_WOUT), MTOK, DM, DM, e); }
    k_ln<<<MTOK / 4, 256, 0, stream>>>((float*)d_out, ln_g, ln_b);
#elif MK_STEP == 12 || MK_STEP == 13
    MK_RUN(0, 1);
#if MK_STEP == 13
    MK_RUN(1, 2);
#else
    k_u<<<(unsigned)(((size_t)MTOK * DM + 255) / 256), 256, 0, stream>>>((const float*)d_in[0], (const float*)(ws + WS_MODF), (bf16_t*)(dob + DO_U));
#endif
    { EpiProj e{rx, ya, qb, kb, vb, (bf16_t*)(ws + WS_MG)}; k_gemm_simple<EpiProj, false><<<dim3(NIN / 64, MTOK / 64), 256, 0, stream>>>((bf16_t*)(dob + DO_U), (bf16_t*)(ws + WS_WIN), MTOK, NIN, DM, e); }
    k_rnn_simple<<<NB * 16, 64, 0, stream>>>(rx, ya, conv_w, conv_b, w_rg_a, b_rg_a, w_rg_x, b_rg_x, lru_lambda);
    k_attn_simple<<<NB * 8 * 2 * 32, 256, 0, stream>>>(qb, kb, vb, o0, o1, rel_bias);
    k_combine<<<MTOK / 4, 256, 0, stream>>>(o0, o1, ya, lq1, lk1, lq2, lk2, subln_w);
    { EpiMerge e{(bf16_t*)(ws + WS_MG), qb}; k_gemm_simple<EpiMerge, true><<<dim3(DM / 64, MTOK / 64), 256, 0, stream>>>(ya, (bf16_t*)(ws + WS_WCAT), MTOK, DM, 2048, e); }
    { EpiOut e{(const float*)d_in[0], (const float*)(ws + WS_MODF), (float*)d_out}; k_gemm_simple<EpiOut, false><<<dim3(DM / 64, MTOK / 64), 256, 0, stream>>>(qb, (bf16_t*)(ws + WS_WOUT), MTOK, DM, DM, e); }
    k_ln<<<MTOK / 4, 256, 0, stream>>>((float*)d_out, ln_g, ln_b);
#elif MK_STEP == 14
    MK_RUN(0, 1); MK_RUN(1, 2);
    { EpiProj e{rx, ya, qb, kb, vb, (bf16_t*)(ws + WS_MG)}; k_gemm_simple<EpiProj, false><<<dim3(NIN / 64, MTOK / 64), 256, 0, stream>>>((bf16_t*)(dob + DO_U), (bf16_t*)(ws + WS_WIN), MTOK, NIN, DM, e); }
    k_rnn_simple<<<NB * 16, 64, 0, stream>>>(rx, ya, conv_w, conv_b, w_rg_a, b_rg_a, w_rg_x, b_rg_x, lru_lambda);
    k_attn_simple<<<NB * 8 * 2 * 32, 256, 0, stream>>>(qb, kb, vb, o0, o1, rel_bias);
    k_combine<<<MTOK / 4, 256, 0, stream>>>(o0, o1, ya, lq1, lk1, lq2, lk2, subln_w);
    MK_RUN(6, 7); MK_RUN(7, 8);
    k_ln<<<MTOK / 4, 256, 0, stream>>>((float*)d_out, ln_g, ln_b);
#elif MK_STEP == 15
    MK_RUN(0, 1); MK_RUN(1, 2); MK_RUN(2, 3);
    { EpiProj e{rx, ya, qb, kb, vb, (bf16_t*)(ws + WS_MG)}; k_gemm_simple<EpiProj, false><<<dim3((MK_C1 - MK_C0) / 64, MTOK / 64), 256, 0, stream>>>((bf16_t*)(dob + DO_U), (bf16_t*)(ws + WS_WIN), MTOK, NIN, DM, e, MK_C0 / 64); }
    k_rnn_simple<<<NB * 16, 64, 0, stream>>>(rx, ya, conv_w, conv_b, w_rg_a, b_rg_a, w_rg_x, b_rg_x, lru_lambda);
    k_attn_simple<<<NB * 8 * 2 * 32, 256, 0, stream>>>(qb, kb, vb, o0, o1, rel_bias);
    k_combine<<<MTOK / 4, 256, 0, stream>>>(o0, o1, ya, lq1, lk1, lq2, lk2, subln_w);
    MK_RUN(6, 7); MK_RUN(7, 8);
    k_ln<<<MTOK / 4, 256, 0, stream>>>((float*)d_out, ln_g, ln_b);
#elif MK_STEP == 2
    MK_RUN(0, 1); MK_RUN(1, 2); MK_RUN(2, 3);
    k_rnn_simple<<<NB * 16, 64, 0, stream>>>(rx, ya, conv_w, conv_b, w_rg_a, b_rg_a, w_rg_x, b_rg_x, lru_lambda);
    MK_RUN(4, 5); MK_RUN(5, 6); MK_RUN(6, 7); MK_RUN(7, 8); MK_RUN(8, 9);
#elif MK_STEP == 3
    for (int p = 0; p < N_PHASES; ++p) MK_RUN(p, p + 1);
#else
    MK_RUN(0, N_PHASES);
#endif
}
```

```cpp
#include <hip/hip_runtime.h>
#include <cstdio>
#include <cstdint>
#include <cmath>

typedef unsigned short bf16_t;
#ifndef MK_ROT
#define MK_ROT 8
#endif
constexpr int NB = 4, SEQ = 8192, DM = 1024, MTOK = NB * SEQ, NIN = 8192;
constexpr float LN_EPS = 1e-5f;
constexpr float ALPHA = 1.189207115002721f;
constexpr float LOG2E = 1.4426950408889634f;
constexpr float C2 = 0.125f * LOG2E;

__device__ __forceinline__ float bf2f_(bf16_t v) { return __uint_as_float(((unsigned)v) << 16); }
__device__ __forceinline__ bf16_t f2bf_(float f) { unsigned u = __float_as_uint(f); return (bf16_t)((u + 0x7fffu + ((u >> 16) & 1u)) >> 16); }
__device__ __forceinline__ float sigmoidf_(float x) { return 1.f / (1.f + __expf(-x)); }
__device__ __forceinline__ float siluf_(float x) { return x / (1.f + __expf(-x)); }

constexpr size_t MiB = 1u << 20;
constexpr size_t WS_CTL = 0;
constexpr size_t WS_MODF = 1 * MiB + 512 * 1024;
constexpr size_t CTL_ZERO_BYTES = 512 * 1024;
constexpr size_t WS_WIN = 2 * MiB;
constexpr size_t WS_WCAT = 18 * MiB;
constexpr size_t WS_WOUT = 22 * MiB;
constexpr size_t WS_YA = 24 * MiB;
constexpr size_t WS_Q = 152 * MiB;
constexpr size_t WS_K = 216 * MiB;
constexpr size_t WS_V = 280 * MiB;
constexpr size_t WS_MG = 344 * MiB;
constexpr size_t WS_END = 472 * MiB;
constexpr size_t DO_U = 0, DO_RX = 64 * MiB, DO_O0 = 0, DO_O1 = 64 * MiB;

__global__ void k_mod(const float* __restrict__ c, const float* __restrict__ w_ada, const float* __restrict__ b_ada, float* __restrict__ modf) {
    const int idx = blockIdx.x * blockDim.x + threadIdx.x; if (idx >= NB * 3072) return;
    const int b = idx / 3072, e = idx % 3072; float acc = 0.f;
    for (int k = 0; k < DM; ++k) acc += siluf_(c[b * DM + k]) * w_ada[(size_t)k * 3072 + e];
    modf[idx] = acc + b_ada[e];
}
__global__ void k_u(const float* __restrict__ x, const float* __restrict__ modf, bf16_t* __restrict__ u) {
    const size_t idx = (size_t)blockIdx.x * blockDim.x + threadIdx.x; if (idx >= (size_t)MTOK * DM) return;
    const int d = (int)(idx % DM); const int b = (int)(idx / ((size_t)SEQ * DM));
    u[idx] = f2bf_(x[idx] * (1.f + modf[b * 3072 + 1024 + d]) + modf[b * 3072 + d]);
}
__global__ void k_transpose(const float* __restrict__ W, int K, int N, bf16_t* __restrict__ WT, int ldt, int koff) {
    const size_t idx = (size_t)blockIdx.x * blockDim.x + threadIdx.x; if (idx >= (size_t)K * N) return;
    const int k = (int)(idx / N), n = (int)(idx % N);
    WT[(size_t)n * ldt + koff + k] = f2bf_(W[idx]);
}

struct EpiProj {
    bf16_t *rx, *ya, *q, *k, *v, *mg;
    __device__ __forceinline__ void mid(int, int, float&) const {}
    __device__ __forceinline__ void operator()(int m, int n, float a) const {
        const int g = n >> 10, c = n & 1023;
        if (g == 0) rx[(size_t)m * 1024 + c] = f2bf_(a);
        else if (g == 1) ya[(size_t)m * 2048 + c] = f2bf_(siluf_(a));
        else if (g == 2) q[(size_t)m * 1024 + c] = f2bf_(a * C2);
        else if (g == 3) k[(size_t)m * 1024 + c] = f2bf_(a);
        else if (g == 4) v[(size_t)m * 1024 + c] = f2bf_(a);
        else if (g == 5) ya[(size_t)m * 2048 + 1024 + c] = f2bf_(siluf_(a));
        else mg[(size_t)m * 2048 + (n - 6144)] = f2bf_(sigmoidf_(a));
    }
};
struct EpiMerge {
    const bf16_t* mg; bf16_t* merged;
    __device__ __forceinline__ void mid(int m, int n, float& a) const { a *= bf2f_(mg[(size_t)m * 2048 + n]) / bf2f_(mg[(size_t)m * 2048 + 1024 + n]); }
    __device__ __forceinline__ void operator()(int m, int n, float a) const { merged[(size_t)m * 1024 + n] = f2bf_(a * bf2f_(mg[(size_t)m * 2048 + 1024 + n])); }
};
struct EpiOut {
    const float* x; const float* modf; float* z;
    __device__ __forceinline__ void mid(int, int, float&) const {}
    __device__ __forceinline__ void operator()(int m, int n, float a) const { const int b = m / SEQ; z[(size_t)m * 1024 + n] = ALPHA * x[(size_t)m * 1024 + n] + modf[b * 3072 + 2048 + n] * a; }
};

template <class Epi, bool MID>
__global__ void __launch_bounds__(256) k_gemm_simple(const bf16_t* __restrict__ A, const bf16_t* __restrict__ Bt, int M, int N, int K, Epi epi, int nblk0 = 0) {
    __shared__ float As[16][68], Bs[16][68];
    const int tid = threadIdx.x, tx = tid & 15, ty = tid >> 4;
    const int m0 = blockIdx.y * 64, n0 = (blockIdx.x + nblk0) * 64;
    float acc[4][4];
#pragma unroll
    for (int i = 0; i < 4; ++i)
#pragma unroll
        for (int j = 0; j < 4; ++j) acc[i][j] = 0.f;
    for (int k0 = 0; k0 < K; k0 += 16) {
        if (MID && k0 == K / 2) {
#pragma unroll
            for (int i = 0; i < 4; ++i)
#pragma unroll
                for (int j = 0; j < 4; ++j) epi.mid(m0 + ty * 4 + i, n0 + tx * 4 + j, acc[i][j]);
        }
#pragma unroll
        for (int e = 0; e < 4; ++e) {
            const int idx = tid + e * 256, r = idx >> 4, kk = idx & 15;
            As[kk][r] = bf2f_(A[(size_t)(m0 + r) * K + k0 + kk]);
            Bs[kk][r] = bf2f_(Bt[(size_t)(n0 + r) * K + k0 + kk]);
        }
        __syncthreads();
#pragma unroll
        for (int kk = 0; kk < 16; ++kk) {
            float a[4], b[4];
#pragma unroll
            for (int i = 0; i < 4; ++i) { a[i] = As[kk][ty * 4 + i]; b[i] = Bs[kk][tx * 4 + i]; }
#pragma unroll
            for (int i = 0; i < 4; ++i)
#pragma unroll
                for (int j = 0; j < 4; ++j) acc[i][j] += a[i] * b[j];
        }
        __syncthreads();
    }
#pragma unroll
    for (int i = 0; i < 4; ++i)
#pragma unroll
        for (int j = 0; j < 4; ++j) epi(m0 + ty * 4 + i, n0 + tx * 4 + j, acc[i][j]);
}

__global__ void __launch_bounds__(64) k_rnn_simple(const bf16_t* __restrict__ rx, bf16_t* __restrict__ ya, const float* __restrict__ conv_w, const float* __restrict__ conv_b,
                                                   const float* __restrict__ w_a, const float* __restrict__ b_a, const float* __restrict__ w_x, const float* __restrict__ b_x, const float* __restrict__ lam) {
    __shared__ float xs[64];
    const int b = blockIdx.x / 16, hb = blockIdx.x % 16, j = threadIdx.x, ch = hb * 64 + j;
    float wa[64], wx[64];
#pragma unroll
    for (int i = 0; i < 64; ++i) { wa[i] = w_a[(size_t)hb * 4096 + i * 64 + j]; wx[i] = w_x[(size_t)hb * 4096 + i * 64 + j]; }
    const float cw0 = conv_w[ch], cw1 = conv_w[1024 + ch], cw2 = conv_w[2048 + ch], cw3 = conv_w[3072 + ch], cb = conv_b[ch];
    const float ba = b_a[ch], bx = b_x[ch];
    const float L = lam[ch]; const float sp = log1pf(expf(-L));
    const float logu = -8.0f * sp;
    float x1 = 0.f, x2 = 0.f, x3 = 0.f, h = 0.f;
    for (int t = 0; t < SEQ; ++t) {
        const size_t row = (size_t)b * SEQ + t;
        const float x0 = bf2f_(rx[row * 1024 + ch]);
        const float xc = cw0 * x3 + cw1 * x2 + cw2 * x1 + cw3 * x0 + cb;
        x3 = x2; x2 = x1; x1 = x0;
        __syncthreads(); xs[j] = xc; __syncthreads();
        float ra = ba, ri = bx;
#pragma unroll
        for (int i = 0; i < 64; ++i) { const float xv = xs[i]; ra += xv * wa[i]; ri += xv * wx[i]; }
        const float r = sigmoidf_(ra), ig = sigmoidf_(ri);
        const float la = r * logu; const float a = expf(la); const float bin = sqrtf(-expm1f(2.f * la)) * (ig * xc);
        h = a * h + bin;
        const size_t o = row * 2048 + ch;
        ya[o] = f2bf_(h * bf2f_(ya[o]));
    }
}

__device__ __forceinline__ int t5_bucket(int n) {
    if (n < 16) return n;
    int l = 16 + (int)(logf((float)n / 16.0f) / 2.0794415416798357f * 16.0f);
    return l < 31 ? l : 31;
}
__global__ void __launch_bounds__(256) k_attn_simple(const bf16_t* __restrict__ Q, const bf16_t* __restrict__ K, const bf16_t* __restrict__ V, bf16_t* __restrict__ O0, bf16_t* __restrict__ O1, const float* __restrict__ rel_bias) {
    __shared__ float tab[128];
    const int qb = blockIdx.x % 32, c = (blockIdx.x / 32) % 2, h = (blockIdx.x / 64) % 8, b = blockIdx.x / 512;
    if (threadIdx.x < 128) tab[threadIdx.x] = rel_bias[t5_bucket(threadIdx.x) * 8 + h] * LOG2E;
    __syncthreads();
    const float far = rel_bias[31 * 8 + h] * LOG2E;
    const int qi = qb * 256 + threadIdx.x; const size_t rowq = (size_t)b * SEQ + qi;
    float q[64], o[128];
#pragma unroll
    for (int d = 0; d < 64; ++d) q[d] = bf2f_(Q[rowq * 1024 + h * 128 + c * 64 + d]);
#pragma unroll
    for (int e = 0; e < 128; ++e) o[e] = 0.f;
    float m = -INFINITY, l = 0.f;
    const int kend = qb * 256 + 255;
    for (int kk = 0; kk <= kend; ++kk) {
        const size_t rowk = (size_t)b * SEQ + kk;
        const bf16_t* kp = K + rowk * 1024 + h * 128 + c * 64;
        float s = 0.f;
#pragma unroll
        for (int d = 0; d < 64; ++d) s += q[d] * bf2f_(kp[d]);
        const int n = qi - kk;
        if (n >= 0) {
            s += (n < 128) ? tab[n] : far;
            if (s > m) { const float f = exp2f(m - s); l *= f;
#pragma unroll
                for (int e = 0; e < 128; ++e) o[e] *= f;
                m = s; }
            const float p = exp2f(s - m); l += p;
            const bf16_t* vp = V + rowk * 1024 + h * 128;
#pragma unroll
            for (int e = 0; e < 128; ++e) o[e] += p * bf2f_(vp[e]);
        }
    }
    bf16_t* Op = (c == 0 ? O0 : O1) + rowq * 1024 + h * 128; const float il = 1.f / l;
#pragma unroll
    for (int e = 0; e < 128; ++e) Op[e] = f2bf_(o[e] * il);
}

__global__ void __launch_bounds__(256) k_combine(const bf16_t* __restrict__ O0, const bf16_t* __restrict__ O1, bf16_t* __restrict__ ya, const float* __restrict__ lq1, const float* __restrict__ lk1,
                                                 const float* __restrict__ lq2, const float* __restrict__ lk2, const float* __restrict__ subw) {
    const int lane = threadIdx.x & 63, row = blockIdx.x * 4 + (threadIdx.x >> 6);
    float s1 = lq1[lane] * lk1[lane], s2 = lq2[lane] * lk2[lane];
#pragma unroll
    for (int o = 1; o < 64; o <<= 1) { s1 += __shfl_xor(s1, o); s2 += __shfl_xor(s2, o); }
    const float lam = expf(s1) - expf(s2) + 0.2f;
    const int col = lane * 16;
    float v[16]; float ss = 0.f;
#pragma unroll
    for (int i = 0; i < 16; ++i) { v[i] = bf2f_(O0[(size_t)row * 1024 + col + i]) - lam * bf2f_(O1[(size_t)row * 1024 + col + i]); ss += v[i] * v[i]; }
    ss += __shfl_xor(ss, 1); ss += __shfl_xor(ss, 2); ss += __shfl_xor(ss, 4);
    const float rs = rsqrtf(ss * (1.f / 128.f) + LN_EPS) * 0.8f;
#pragma unroll
    for (int i = 0; i < 16; ++i) { const size_t o = (size_t)row * 2048 + 1024 + col + i; ya[o] = f2bf_(v[i] * rs * subw[(col + i) & 127] * bf2f_(ya[o])); }
}

__global__ void __launch_bounds__(256) k_ln(float* __restrict__ z, const float* __restrict__ g, const float* __restrict__ bta) {
    const int lane = threadIdx.x & 63, row = blockIdx.x * 4 + (threadIdx.x >> 6);
    float4* p = (float4*)(z + (size_t)row * 1024) + lane; float4 v[4]; float s = 0.f;
#pragma unroll
    for (int j = 0; j < 4; ++j) { v[j] = p[64 * j]; s += (v[j].x + v[j].y) + (v[j].z + v[j].w); }
#pragma unroll
    for (int o = 1; o < 64; o <<= 1) s += __shfl_xor(s, o);
    const float mean = s * (1.f / 1024.f); float q = 0.f;
#pragma unroll
    for (int j = 0; j < 4; ++j) { v[j].x -= mean; v[j].y -= mean; v[j].z -= mean; v[j].w -= mean; q += (v[j].x * v[j].x + v[j].y * v[j].y) + (v[j].z * v[j].z + v[j].w * v[j].w); }
#pragma unroll
    for (int o = 1; o < 64; o <<= 1) q += __shfl_xor(q, o);
    const float rstd = rsqrtf(q * (1.f / 1024.f) + LN_EPS);
#pragma unroll
    for (int j = 0; j < 4; ++j) { const float4 gg = ((const float4*)g)[lane + 64 * j], bb = ((const float4*)bta)[lane + 64 * j];
        float4 o; o.x = v[j].x * rstd * gg.x + bb.x; o.y = v[j].y * rstd * gg.y + bb.y; o.z = v[j].z * rstd * gg.z + bb.z; o.w = v[j].w * rstd * gg.w + bb.w; p[64 * j] = o; }
}

namespace pg8 {
#define PG8_LAS __attribute__((address_space(3)))
typedef unsigned short bf16_t;
typedef short bf16x8 __attribute__((ext_vector_type(8)));
typedef float f32x4 __attribute__((ext_vector_type(4)));
typedef unsigned u32x4 __attribute__((ext_vector_type(4)));
constexpr int BM = 256, BK = 64, HALF = 128, HTB = HALF * BK * 2  , STAGE_BYTES = 8 * HTB, NXCD = 8, WGM = 8;

__host__ __device__ __forceinline__ int lds_byte(int r, int c) { const int st = (r >> 4) * 2 + (c >> 5), rr = r & 15, cc = c & 31, ob = rr * 64 + cc * 2; return st * 1024 + (ob ^ (((ob >> 9) & 1) << 5)); }
__host__ __device__ __forceinline__ void stage_rc(int b, int& R, int& C) { const int st = b / 1024, sb = b % 1024, swz = sb ^ (((sb >> 9) & 1) << 5); R = (st >> 1) * 16 + swz / 64; C = (st & 1) * 32 + (swz % 64) / 2; }
__host__ __device__ __forceinline__ int perm32(int rho) { const int n = rho >> 4, i = rho & 15; return 8 * (i >> 2) + 4 * n + (i & 3); }

struct Unit { int pm, pn; };
struct Gemm { const bf16_t* A; const bf16_t* Bt; int M, N, K; };

struct StaticOrder {
    int nM, nN, nwg, G, c;
    __host__ __device__ void init(int M, int N, int G_, int c_) { nM = M / BM; nN = N / BM; nwg = nM * nN; G = G_; c = c_; }
    __host__ __device__ bool next(int i, Unit& u) const {
        const long L = (long)i * G + c; if (L >= nwg) return false;
        int wgid = (int)L; { const int q = nwg / NXCD, r = nwg % NXCD, xcd = wgid % NXCD, off = wgid / NXCD; wgid = (xcd < r ? xcd * (q + 1) : r * (q + 1) + (xcd - r) * q) + off; }
        const int nig = WGM * nN, gid = wgid / nig, fm = gid * WGM, gsz = (nM - fm) < WGM ? (nM - fm) : WGM;
        u.pm = fm + ((wgid % nig) % gsz); u.pn = (wgid % nig) / gsz; return true;
    }
    __device__ __forceinline__ void a_ready(const Unit&) const {}
    __device__ __forceinline__ void done(const Unit&) const {}
};


typedef float f32x2_cv __attribute__((ext_vector_type(2))); typedef __bf16 bf16x2_cv __attribute__((ext_vector_type(2)));
__device__ __forceinline__ unsigned cvt_pk_bf16(float lo, float hi) { f32x2_cv v = {lo, hi}; bf16x2_cv b = __builtin_convertvector(v, bf16x2_cv); return __builtin_bit_cast(unsigned, b); }
__device__ __forceinline__ float fast_sigmoid(float x) { return __builtin_amdgcn_rcpf(1.0f + __builtin_amdgcn_exp2f(-1.4426950408889634f * x)); }
__device__ __forceinline__ float bflo(unsigned w) { return __uint_as_float(w << 16); }
__device__ __forceinline__ float bfhi(unsigned w) { return __uint_as_float(w & 0xffff0000u); }

struct EpiProjV {
    static constexpr bool PERM = true, AFTER_DRAIN = false, HAS_MID = false;
    unsigned char* ws; unsigned char* dob;
    template <int ACT> __device__ __forceinline__ void run(const f32x4 (&acc)[2][2][4][2], bf16_t* base, int ldc, int row0, float sc) const {
#pragma unroll
        for (int ai = 0; ai < 2; ++ai)
#pragma unroll
            for (int m = 0; m < 4; ++m) { bf16_t* rowp = base + (size_t)(row0 + ai * HALF + m * 16) * ldc;
#pragma unroll
                for (int bj = 0; bj < 2; ++bj) { f32x4 v0 = acc[ai][bj][m][0], v1 = acc[ai][bj][m][1];
                    if (ACT == 0) { v0 = v0 * sc; v1 = v1 * sc; }
                    if (ACT == 1) {
#pragma unroll
                        for (int e = 0; e < 4; ++e) { v0[e] = v0[e] * fast_sigmoid(v0[e]); v1[e] = v1[e] * fast_sigmoid(v1[e]); } }
                    if (ACT == 2) {
#pragma unroll
                        for (int e = 0; e < 4; ++e) { v0[e] = fast_sigmoid(v0[e]); v1[e] = fast_sigmoid(v1[e]); } }
                    u32x4 w; w.x = cvt_pk_bf16(v0[0], v0[1]); w.y = cvt_pk_bf16(v0[2], v0[3]); w.z = cvt_pk_bf16(v1[0], v1[1]); w.w = cvt_pk_bf16(v1[2], v1[3]);
                    *(u32x4*)(rowp + bj * HALF) = w; } }
    }
    __device__ __forceinline__ void operator()(const f32x4 (&acc)[2][2][4][2], const Unit& u, int wr, int wc, int fr, int fq) const {
        const int g = u.pn >> 2, colt = (u.pn & 3) * BM + wc * 32 + 8 * fq; int row0 = u.pm * BM + wr * 64 + fr; asm volatile("" : "+v"(row0));
        const size_t goff = (g == 0) ? DO_RX : (g == 1) ? WS_YA : (g == 2) ? WS_Q : (g == 3) ? WS_K : (g == 4) ? WS_V : (g == 5) ? WS_YA + 2048 : (g == 6) ? WS_MG : WS_MG + 2048;
        bf16_t* base = (bf16_t*)((g == 0 ? dob : ws) + goff) + colt;
        const int ldc = (g == 1 || g >= 5) ? 2048 : 1024;
        if (g == 1 || g == 5) run<1>(acc, base, ldc, row0, 1.0f);
        else if (g >= 6) run<2>(acc, base, ldc, row0, 1.0f);
        else run<0>(acc, base, ldc, row0, g == 2 ? C2 : 1.0f);
    }
};

struct EpiMergeV {
    static constexpr bool PERM = true, AFTER_DRAIN = false, HAS_MID = true;
    const bf16_t* mg; bf16_t* merged;
    __device__ __forceinline__ void mid(f32x4 (&acc)[2][2][4][2], const Unit& u, int wr, int wc, int fr, int fq) const {
        const int col0 = u.pn * BM + wc * 32 + 8 * fq; int row0 = u.pm * BM + wr * 64 + fr; asm volatile("" : "+v"(row0));
#pragma unroll
        for (int ai = 0; ai < 2; ++ai)
#pragma unroll
            for (int m = 0; m < 4; ++m) { const bf16_t* rowp = mg + (size_t)(row0 + ai * HALF + m * 16) * 2048 + col0;
#pragma unroll
                for (int bj = 0; bj < 2; ++bj) { const u32x4 a = *(const u32x4*)(rowp + bj * HALF), b = *(const u32x4*)(rowp + 1024 + bj * HALF);
                    f32x4 r0, r1;
                    r0[0] = bflo(a.x) * __builtin_amdgcn_rcpf(bflo(b.x)); r0[1] = bfhi(a.x) * __builtin_amdgcn_rcpf(bfhi(b.x)); r0[2] = bflo(a.y) * __builtin_amdgcn_rcpf(bflo(b.y)); r0[3] = bfhi(a.y) * __builtin_amdgcn_rcpf(bfhi(b.y));
                    r1[0] = bflo(a.z) * __builtin_amdgcn_rcpf(bflo(b.z)); r1[1] = bfhi(a.z) * __builtin_amdgcn_rcpf(bfhi(b.z)); r1[2] = bflo(a.w) * __builtin_amdgcn_rcpf(bflo(b.w)); r1[3] = bfhi(a.w) * __builtin_amdgcn_rcpf(bfhi(b.w));
                    acc[ai][bj][m][0] = acc[ai][bj][m][0] * r0; acc[ai][bj][m][1] = acc[ai][bj][m][1] * r1; } }
    }
    __device__ __forceinline__ void operator()(const f32x4 (&acc)[2][2][4][2], const Unit& u, int wr, int wc, int fr, int fq) const {
        const int col0 = u.pn * BM + wc * 32 + 8 * fq; int row0 = u.pm * BM + wr * 64 + fr; asm volatile("" : "+v"(row0));
#pragma unroll
        for (int ai = 0; ai < 2; ++ai)
#pragma unroll
            for (int m = 0; m < 4; ++m) { const size_t r = (size_t)(row0 + ai * HALF + m * 16);
#pragma unroll
                for (int bj = 0; bj < 2; ++bj) { const u32x4 b = *(const u32x4*)(mg + r * 2048 + 1024 + col0 + bj * HALF);
                    f32x4 v0 = acc[ai][bj][m][0], v1 = acc[ai][bj][m][1];
                    v0[0] *= bflo(b.x); v0[1] *= bfhi(b.x); v0[2] *= bflo(b.y); v0[3] *= bfhi(b.y); v1[0] *= bflo(b.z); v1[1] *= bfhi(b.z); v1[2] *= bflo(b.w); v1[3] *= bfhi(b.w);
                    u32x4 w; w.x = cvt_pk_bf16(v0[0], v0[1]); w.y = cvt_pk_bf16(v0[2], v0[3]); w.z = cvt_pk_bf16(v1[0], v1[1]); w.w = cvt_pk_bf16(v1[2], v1[3]);
                    *(u32x4*)(merged + r * 1024 + col0 + bj * HALF) = w; } }
    }
};

struct EpiOutV {
    static constexpr bool PERM = false, AFTER_DRAIN = false, HAS_MID = false;
    const float* x; const float* modf; float* z;
    __device__ __forceinline__ void operator()(const f32x4 (&acc)[2][2][4][2], const Unit& u, int wr, int wc, int fr, int fq) const {
        const int col0 = u.pn * BM + wc * 32 + 4 * fq, b = (u.pm * BM) / SEQ; int row0 = u.pm * BM + wr * 64 + fr; asm volatile("" : "+v"(row0));
        f32x4 gv[2][2];
#pragma unroll
        for (int bj = 0; bj < 2; ++bj)
#pragma unroll
            for (int n = 0; n < 2; ++n) gv[bj][n] = *(const f32x4*)(modf + b * 3072 + 2048 + col0 + bj * HALF + n * 16);
#pragma unroll
        for (int ai = 0; ai < 2; ++ai)
#pragma unroll
            for (int m = 0; m < 4; ++m) { const size_t off = (size_t)(row0 + ai * HALF + m * 16) * 1024 + col0;
#pragma unroll
                for (int bj = 0; bj < 2; ++bj)
#pragma unroll
                    for (int n = 0; n < 2; ++n) { const f32x4 xv = *(const f32x4*)(x + off + bj * HALF + n * 16);
                        *(f32x4*)(z + off + bj * HALF + n * 16) = xv * ALPHA + gv[bj][n] * acc[ai][bj][m][n]; } }
    }
};

template <class Epi, class Sched, bool ALIGN_EPI = false, bool SP2 = false>
__device__ __forceinline__ void gemm_phase(PG8_LAS unsigned char* lds, const Gemm g, const Sched& S, const Epi& E, const int tid_in) {
    const int tid = tid_in, wid = __builtin_amdgcn_readfirstlane(tid >> 6), lane = tid & 63, wr = wid >> 2, wc = wid & 3, fr = lane & 15, fq = lane >> 4;
    const int K = g.K, nt = K / BK;
    unsigned voffA[2], voffB[2];
#pragma unroll
    for (int i = 0; i < 2; ++i) { int R, C; stage_rc(tid * 16 + i * 8192, R, C); const int Rb = Epi::PERM ? ((R & ~31) + perm32(R & 31)) : R;
        voffA[i] = (unsigned)(R * K + C) * 2u; voffB[i] = (unsigned)(Rb * K + C) * 2u; }
    const size_t kstep = (size_t)(BK * 2);
    const size_t hstep = (size_t)HALF * K * 2;
    const size_t tstep = 2 * hstep;
    const unsigned ldsw = (unsigned)wid * 1024u;
    const int aoff = lds_byte(wr * 64 + fr, fq * 8), boff = lds_byte(wc * 32 + fr, fq * 8);
#define PG8_SA(b, h) (((b) * 2 + (h)) * HTB)
#define PG8_SB(b, h) ((4 + (b) * 2 + (h)) * HTB)
#define PG8_STAGE(bufoff, gbase, voff) do { _Pragma("unroll") for (int _i = 0; _i < 2; ++_i) \
        __builtin_amdgcn_global_load_lds((const unsigned*)((const char*)(gbase) + (voff)[_i]), (PG8_LAS unsigned*)(lds + (bufoff) + ldsw + _i * 8192), 16, 0, 0); } while (0)
#define PG8_LDA(dst, b, h) do { _Pragma("unroll") for (int m = 0; m < 4; ++m) _Pragma("unroll") for (int k = 0; k < 2; ++k) dst[m][k] = *(const PG8_LAS bf16x8*)(lds + PG8_SA(b, h) + aoff + m * 2048 + k * 1024); } while (0)
#define PG8_LDB(dst, b, h) do { _Pragma("unroll") for (int n = 0; n < 2; ++n) _Pragma("unroll") for (int k = 0; k < 2; ++k) dst[n][k] = *(const PG8_LAS bf16x8*)(lds + PG8_SB(b, h) + boff + n * 2048 + k * 1024); } while (0)
#define PG8_MMA(ai, bj, At, Bt) do { __builtin_amdgcn_s_setprio(1); _Pragma("unroll") for (int m = 0; m < 4; ++m) _Pragma("unroll") for (int n = 0; n < 2; ++n) _Pragma("unroll") for (int k = 0; k < 2; ++k) \
        acc[ai][bj][m][n] = __builtin_amdgcn_mfma_f32_16x16x32_bf16(Bt[n][k], At[m][k], acc[ai][bj][m][n], 0, 0, 0); __builtin_amdgcn_s_setprio(0); } while (0)
#define PG8_WAIT_V(n) asm volatile("s_waitcnt vmcnt(" #n ")" ::: "memory")
#define PG8_WAIT_L(n) asm volatile("s_waitcnt lgkmcnt(" #n ")" ::: "memory")
#define PG8_BAR __builtin_amdgcn_s_barrier()
#define PG8_SCHED __builtin_amdgcn_sched_barrier(0)
    Unit cur, nxt; int ui = 0;
    if (!S.next(0, cur)) return;
    f32x4 acc[2][2][4][2];
#pragma unroll
    for (int a = 0; a < 2; ++a)
#pragma unroll
        for (int b = 0; b < 2; ++b)
#pragma unroll
            for (int m = 0; m < 4; ++m)
#pragma unroll
                for (int n = 0; n < 2; ++n) acc[a][b][m][n] = (f32x4){0.f, 0.f, 0.f, 0.f};
    bf16x8 At[4][2], B0[2][2], B1[2][2];
    const char* cA = (const char*)g.A + (size_t)cur.pm * tstep; const char* cB = (const char*)g.Bt + (size_t)cur.pn * tstep;
    S.a_ready(cur);
    if constexpr (SP2) {
        PG8_STAGE(PG8_SB(0, 0), cB, voffB); PG8_STAGE(PG8_SB(0, 1), cB + hstep, voffB); PG8_STAGE(PG8_SA(0, 0), cA, voffA); PG8_STAGE(PG8_SA(0, 1), cA + hstep, voffA);
        if (wr == 1) PG8_BAR;
        PG8_WAIT_V(2); PG8_BAR;
        PG8_STAGE(PG8_SB(1, 0), cB + kstep, voffB); PG8_STAGE(PG8_SA(1, 0), cA + kstep, voffA); PG8_STAGE(PG8_SB(1, 1), cB + hstep + kstep, voffB);
        PG8_WAIT_V(6); PG8_BAR;
    } else {
        PG8_STAGE(PG8_SB(0, 0), cB, voffB); PG8_STAGE(PG8_SA(0, 0), cA, voffA); PG8_STAGE(PG8_SB(0, 1), cB + hstep, voffB); PG8_STAGE(PG8_SA(0, 1), cA + hstep, voffA);
        if (wr == 1) PG8_BAR;
        PG8_WAIT_V(4); PG8_BAR;
        PG8_STAGE(PG8_SB(1, 0), cB + kstep, voffB); PG8_STAGE(PG8_SA(1, 0), cA + kstep, voffA); PG8_STAGE(PG8_SB(1, 1), cB + hstep + kstep, voffB);
        PG8_WAIT_V(6); PG8_BAR;
    }
    for (;;) {
        const bool has_next = S.next(ui + 1, nxt);
        const char* nA = has_next ? (const char*)g.A + (size_t)nxt.pm * tstep : cA; const char* nB = has_next ? (const char*)g.Bt + (size_t)nxt.pn * tstep : cB;
        for (int t = 0; t < nt; t += 2) {
            if constexpr (Epi::HAS_MID) { if (t == (nt >> 1)) { PG8_SCHED; E.mid(acc, cur, wr, wc, fr, fq); PG8_SCHED; } }
            const bool last = (t == nt - 2);
            const char* a1 = cA + (size_t)(t + 1) * kstep;
            const char* a2 = last ? nA : cA + (size_t)(t + 2) * kstep; const char* b2 = last ? nB : cB + (size_t)(t + 2) * kstep;
            const char* a3 = a2 + kstep; const char* b3 = b2 + kstep;
            if (last && has_next) S.a_ready(nxt);
            if constexpr (SP2) {
            PG8_LDB(B0, 0, 0); PG8_LDB(B1, 0, 1); PG8_SCHED; PG8_LDA(At, 0, 0); PG8_STAGE(PG8_SA(1, 1), a1 + hstep, voffA);
            PG8_WAIT_V(8); PG8_WAIT_L(0); PG8_BAR; PG8_MMA(0, 0, At, B0); PG8_MMA(0, 1, At, B1); PG8_BAR; PG8_SCHED;
            PG8_LDA(At, 0, 1); PG8_STAGE(PG8_SB(0, 0), b2, voffB); PG8_STAGE(PG8_SB(0, 1), b2 + hstep, voffB); PG8_STAGE(PG8_SA(0, 0), a2, voffA);
            PG8_WAIT_V(8); PG8_WAIT_L(0); PG8_BAR; PG8_MMA(1, 0, At, B0); PG8_MMA(1, 1, At, B1); PG8_BAR; PG8_SCHED;
            PG8_LDB(B0, 1, 0); PG8_LDB(B1, 1, 1); PG8_SCHED; PG8_LDA(At, 1, 0); PG8_STAGE(PG8_SA(0, 1), a2 + hstep, voffA);
            PG8_WAIT_V(8); PG8_WAIT_L(0); PG8_BAR; PG8_MMA(0, 0, At, B0); PG8_MMA(0, 1, At, B1); PG8_BAR; PG8_SCHED;
            PG8_LDA(At, 1, 1); PG8_STAGE(PG8_SB(1, 0), b3, voffB); PG8_STAGE(PG8_SB(1, 1), b3 + hstep, voffB); PG8_STAGE(PG8_SA(1, 0), a3, voffA);
            PG8_WAIT_V(8); PG8_WAIT_L(0); PG8_BAR; PG8_MMA(1, 0, At, B0); PG8_MMA(1, 1, At, B1); PG8_BAR; PG8_SCHED;
            } else {
            PG8_LDB(B0, 0, 0); PG8_SCHED; PG8_LDA(At, 0, 0); PG8_STAGE(PG8_SA(1, 1), a1 + hstep, voffA);
            PG8_WAIT_L(8); PG8_BAR; PG8_WAIT_L(0); PG8_MMA(0, 0, At, B0); PG8_BAR; PG8_SCHED;
            PG8_LDB(B1, 0, 1); PG8_STAGE(PG8_SB(0, 0), b2, voffB);
            PG8_BAR; PG8_WAIT_L(0); PG8_MMA(0, 1, At, B1); PG8_BAR;
            PG8_LDA(At, 0, 1); PG8_STAGE(PG8_SA(0, 0), a2, voffA);
            PG8_BAR; PG8_WAIT_L(0); PG8_MMA(1, 0, At, B0); PG8_BAR; PG8_SCHED;
            PG8_STAGE(PG8_SB(0, 1), b2 + hstep, voffB);
            PG8_WAIT_V(6); PG8_BAR; PG8_MMA(1, 1, At, B1); PG8_BAR;
            PG8_LDB(B0, 1, 0); PG8_SCHED; PG8_LDA(At, 1, 0); PG8_STAGE(PG8_SA(0, 1), a2 + hstep, voffA);
            PG8_WAIT_L(8); PG8_BAR; PG8_WAIT_L(0); PG8_MMA(0, 0, At, B0); PG8_BAR; PG8_SCHED;
            PG8_LDB(B1, 1, 1); PG8_STAGE(PG8_SB(1, 0), b3, voffB);
            PG8_BAR; PG8_WAIT_L(0); PG8_MMA(0, 1, At, B1); PG8_BAR;
            PG8_LDA(At, 1, 1); PG8_STAGE(PG8_SA(1, 0), a3, voffA);
            PG8_BAR; PG8_WAIT_L(0); PG8_MMA(1, 0, At, B0); PG8_BAR; PG8_SCHED;
            PG8_STAGE(PG8_SB(1, 1), b3 + hstep, voffB);
            PG8_WAIT_V(6); PG8_BAR; PG8_MMA(1, 1, At, B1); PG8_BAR;
            }
        }
        if constexpr (ALIGN_EPI) { if (wr == 0) PG8_BAR; }
        if constexpr (!Epi::AFTER_DRAIN) { E(acc, cur, wr, wc, fr, fq); S.done(cur); }
        if (!has_next) break;
#pragma unroll
        for (int a = 0; a < 2; ++a)
#pragma unroll
            for (int b = 0; b < 2; ++b)
#pragma unroll
                for (int m = 0; m < 4; ++m)
#pragma unroll
                    for (int n = 0; n < 2; ++n) acc[a][b][m][n] = (f32x4){0.f, 0.f, 0.f, 0.f};
        cur = nxt; cA = nA; cB = nB; ++ui;
        if constexpr (ALIGN_EPI) { if (wr == 1) PG8_BAR; }
    }
    PG8_WAIT_V(0);
    if constexpr (!ALIGN_EPI) { if (wr == 0) PG8_BAR; }
    PG8_BAR;
    if constexpr (Epi::AFTER_DRAIN) { E.fused(acc, cur, wr, wc, fr, fq, lds, wid, lane); S.done(cur); }
#undef PG8_SA
#undef PG8_SB
#undef PG8_STAGE
#undef PG8_LDA
#undef PG8_LDB
#undef PG8_MMA
#undef PG8_WAIT_V
#undef PG8_WAIT_L
#undef PG8_BAR
#undef PG8_SCHED
}
}

#include <hip/hip_bf16.h>
#include <cmath>
namespace attn_body {
using bf16=__hip_bfloat16;
using bf16x8=__attribute__((ext_vector_type(8)))short;
using s16x4=__attribute__((ext_vector_type(4)))short;
using f32x16=__attribute__((ext_vector_type(16)))float;
using u32x4=__attribute__((ext_vector_type(4)))unsigned;
constexpr int BATCH=4,NHEAD=16,SEQ=8192,D=64,DM=NHEAD*D;
constexpr int NW=8,QBLK=32,QB=QBLK*NW,KVBLK=64,NQB=SEQ/QB;
constexpr int ATTN_PITCH=DM, ATTN_UNIT_ROWS=QB;
__device__ __forceinline__ int crow(int r,int hi){return (r&3)+8*(r>>2)+4*hi;}
#define SBAR() __builtin_amdgcn_sched_barrier(0)
typedef __attribute__((address_space(3))) const float* lds_fptr;
__device__ __forceinline__ void bmask(f32x16&p0,f32x16&p1,int jb,int qrel,int hi,lds_fptr tab){
  const float NEG=-INFINITY; const int nb=qrel-64*jb-4*hi;
  #pragma unroll
  for(int r=0;r<16;++r){ const int n0=nb-((r&3)+8*(r>>2)), n1=n0-32;
    const int i0=n0<0?0:(n0>127?127:n0), i1=n1<0?0:(n1>127?127:n1);
    const float t0=tab[i0], t1=tab[i1];
    p0[r]=n0<0?NEG:p0[r]+t0; p1[r]=n1<0?NEG:p1[r]+t1; }
}
constexpr int NSLOT=3, SLOTB=8192;
constexpr int LDS_K=0, LDS_V=NSLOT*SLOTB, LDS_WS=2*NSLOT*SLOTB, LDS_OST=LDS_WS+NW*64*4, LDS_BYTES=LDS_OST+NW*4096;
constexpr float C2=0.125f*1.4426950408889634f;
__device__ __forceinline__ void glds16(const void*gsrc,unsigned lds_dst){unsigned keep;
  asm volatile("s_mov_b32 %0, m0\n\ts_mov_b32 m0, %2\n\ts_nop 0\n\tglobal_load_lds_dwordx4 %1, off\n\ts_mov_b32 m0, %0":"=&s"(keep):"v"(gsrc),"s"(lds_dst):"memory");}
__device__ __forceinline__ float max3f(float a,float b,float c){float r;asm("v_max3_f32 %0, %1, %2, %3":"=v"(r):"v"(a),"v"(b),"v"(c));return r;}
__device__ __forceinline__ float max2f(float a,float b){float r;asm("v_max_f32_e32 %0, %1, %2":"=v"(r):"v"(a),"v"(b));return r;}
__device__ __forceinline__ float fadd_s(float a,float b){float r;asm("v_add_f32_e32 %0, %1, %2":"=v"(r):"v"(a),"v"(b));return r;}
__device__ __forceinline__ float fsub_s(float a,float b){float r;asm("v_sub_f32_e32 %0, %1, %2":"=v"(r):"v"(a),"v"(b));return r;}
typedef float f32x2_t __attribute__((ext_vector_type(2))); typedef __bf16 bf16x2_t __attribute__((ext_vector_type(2)));
__device__ __forceinline__ unsigned cvtpk_s(float lo,float hi){f32x2_t v={lo,hi};bf16x2_t b=__builtin_convertvector(v,bf16x2_t);return __builtin_bit_cast(unsigned,b);}
#define WAIT_BAR(N) asm volatile("s_waitcnt vmcnt(" #N ") lgkmcnt(0)\n\ts_barrier":::"memory")

__device__ __forceinline__ void qkt(f32x16&p0,f32x16&p1,const char*Kslot,const bf16x8*qr,const f32x16&negm,int r32,int hi){
  const char*kb=Kslot+hi*1024+r32*16;
  #pragma unroll
  for(int d0=0;d0<4;++d0){
    const bf16x8 b0=*reinterpret_cast<const bf16x8*>(kb+d0*2048);
    const bf16x8 b1=*reinterpret_cast<const bf16x8*>(kb+d0*2048+512);
    if(d0==0){p0=__builtin_amdgcn_mfma_f32_32x32x16_bf16(b0,qr[0],negm,0,0,0);p1=__builtin_amdgcn_mfma_f32_32x32x16_bf16(b1,qr[0],negm,0,0,0);}
    else{p0=__builtin_amdgcn_mfma_f32_32x32x16_bf16(b0,qr[d0],p0,0,0,0);p1=__builtin_amdgcn_mfma_f32_32x32x16_bf16(b1,qr[d0],p1,0,0,0);}}
}
typedef __attribute__((address_space(3))) const char* lds_cptr;
typedef short v4i16_t __attribute__((ext_vector_type(4)));
__device__ __forceinline__ void kload8(bf16x8*kf,lds_cptr kp){
  kf[0]=*(const __attribute__((address_space(3))) bf16x8*)(kp);      kf[1]=*(const __attribute__((address_space(3))) bf16x8*)(kp+512);
  kf[2]=*(const __attribute__((address_space(3))) bf16x8*)(kp+2048); kf[3]=*(const __attribute__((address_space(3))) bf16x8*)(kp+2560);
  kf[4]=*(const __attribute__((address_space(3))) bf16x8*)(kp+4096); kf[5]=*(const __attribute__((address_space(3))) bf16x8*)(kp+4608);
  kf[6]=*(const __attribute__((address_space(3))) bf16x8*)(kp+6144); kf[7]=*(const __attribute__((address_space(3))) bf16x8*)(kp+6656);
}
__device__ __forceinline__ void kload2(bf16x8*kf,lds_cptr kp,int j){ kf[2*j]=*(const __attribute__((address_space(3))) bf16x8*)(kp+j*2048); kf[2*j+1]=*(const __attribute__((address_space(3))) bf16x8*)(kp+j*2048+512); }
__device__ __forceinline__ s16x4 vtr(lds_cptr p){ return __builtin_bit_cast(s16x4,__builtin_amdgcn_ds_read_tr16_b64_v4i16((__attribute__((address_space(3))) v4i16_t*)p)); }
__device__ __forceinline__ float rowmax(const f32x16&p0,const f32x16&p1){
  float a=max3f(p0[0],p0[1],p1[0]),b=max3f(p0[2],p0[3],p1[1]);a=max3f(a,p1[2],p1[3]);
  #pragma unroll
  for(int r=4;r<16;r+=4){a=max3f(a,p0[r],p0[r+1]);b=max3f(b,p0[r+2],p0[r+3]);a=max3f(a,p1[r],p1[r+1]);b=max3f(b,p1[r+2],p1[r+3]);}
  const float m=max2f(a,b);
  auto rr=__builtin_amdgcn_permlane32_swap(__float_as_uint(m),__float_as_uint(m),false,false);
  return max2f(__uint_as_float(rr[0]),__uint_as_float(rr[1]));
}
__device__ __forceinline__ void pv(f32x16*o,int vb,bf16x8 pa0,bf16x8 pa1,bf16x8 pa2,bf16x8 pa3){
  #pragma unroll
  for(int d0=0;d0<2;++d0){s16x4 lo[4],hi[4];
    #pragma unroll
    for(int ks=0;ks<4;++ks){
      asm volatile("ds_read_b64_tr_b16 %0,%1 offset:%c2":"=&v"(lo[ks]):"v"(vb),"i"(d0*4096+ks*1024):"memory");
      asm volatile("ds_read_b64_tr_b16 %0,%1 offset:%c2":"=&v"(hi[ks]):"v"(vb),"i"(d0*4096+ks*1024+512):"memory");}
    asm volatile("s_waitcnt lgkmcnt(0)":::"memory");SBAR();
    #define PK(k) (bf16x8){lo[k][0],lo[k][1],lo[k][2],lo[k][3],hi[k][0],hi[k][1],hi[k][2],hi[k][3]}
    o[d0]=__builtin_amdgcn_mfma_f32_32x32x16_bf16(pa0,PK(0),o[d0],0,0,0);
    o[d0]=__builtin_amdgcn_mfma_f32_32x32x16_bf16(pa1,PK(1),o[d0],0,0,0);
    o[d0]=__builtin_amdgcn_mfma_f32_32x32x16_bf16(pa2,PK(2),o[d0],0,0,0);
    o[d0]=__builtin_amdgcn_mfma_f32_32x32x16_bf16(pa3,PK(3),o[d0],0,0,0);
    #undef PK
  }
}

#ifndef ATTN_STORE16
#define ATTN_STORE16(p,v) (*(u32x4*)(p)=(v))
#endif
template<int THRL> __device__ __forceinline__ void attn_unit(int b,int hq,int hv,int qb,const bf16*Q,const bf16*__restrict__ K,const bf16*__restrict__ V,bf16*O,char*shm,lds_fptr tab,int wid_in){
  int lane; asm volatile("v_mbcnt_lo_u32_b32 %0, -1, 0\n\tv_mbcnt_hi_u32_b32 %0, -1, %0" : "=v"(lane)); const int r32=lane&31,hi=lane>>5; const int wid=wid_in;
  const long rowbase=(long)b*SEQ; const int q0=qb*QB;
  const bf16*Qw=Q+(rowbase+q0+wid*QBLK)*DM+hq*D;
  const bf16*Kh=K+rowbase*DM+hq*D,*Vh=V+rowbase*DM+hv*D;
  const unsigned lds0=(unsigned)(uintptr_t)shm;
  float*wsf=(float*)(shm+LDS_WS)+wid*64;
  const bf16*ksrc=Kh+(long)lane*DM+wid*8;
  const bf16*vsrc=Vh+(long)(16*(wid&3)+(lane>>2))*DM+(wid>>2)*32+(lane&3)*8;
  const unsigned kdst=lds0+LDS_K+wid*1024, vdst=lds0+LDS_V+wid*1024;
  #define DMA_K(t,slot) glds16(ksrc+(long)(t)*KVBLK*DM,(unsigned)__builtin_amdgcn_readfirstlane(kdst+(slot)))
  #define DMA_V(t,slot) glds16(vsrc+(long)(t)*KVBLK*DM,(unsigned)__builtin_amdgcn_readfirstlane(vdst+(slot)))
  const int vb0=(int)(lds0+LDS_V)+((lane>>4)&1)*32+(lane&3)*8+(4*hi+((lane&15)>>2))*64;
  const char*Kbase=shm+LDS_K; bf16x8 kf[8];
  const lds_cptr shm3=(lds_cptr)shm; const lds_cptr kp0=shm3+LDS_K+hi*1024+r32*16; const lds_cptr vp0=shm3+LDS_V+((lane>>4)&1)*32+(lane&3)*8+(4*hi+((lane&15)>>2))*64;
  const int NT=(q0+QB)/KVBLK;
  DMA_K(0,0);DMA_V(0,0);DMA_K(1,SLOTB);
  bf16x8 qr[4];
  #pragma unroll
  for(int d0=0;d0<4;++d0)qr[d0]=*reinterpret_cast<const bf16x8*>(&Qw[(long)r32*DM+d0*16+hi*8]);
  float mhat=0.f,l_reg=0.f;f32x16 o[2],negm; { float z_; asm volatile("v_mov_b32 %0, 0":"=v"(z_)); _Pragma("unroll") for(int r=0;r<16;++r){o[0][r]=z_;o[1][r]=z_;negm[r]=z_;} } asm volatile("":"+v"(negm));
  const int qrel=wid*QBLK+r32;
  #define CMASK(P0,P1,t) do{int jb_=(t)-(NT-4); if(jb_>=-2)bmask(P0,P1,jb_,qrel,hi,tab);}while(0)
  bool resc=false;
  #define START(P0,P1) do{ const float rm=rowmax(P0,P1); resc=false; \
    { const float dl=rm; mhat=fadd_s(mhat,dl); \
      _Pragma("unroll") for(int r=0;r<16;++r){P0[r]=fsub_s(P0[r],dl);P1[r]=fsub_s(P1[r],dl);} \
      _Pragma("unroll") for(int r=0;r<16;++r)negm[r]=-mhat; asm volatile("":"+v"(negm)); } \
    _Pragma("unroll") for(int r=0;r<16;++r)P0[r]=__builtin_amdgcn_exp2f(P0[r]); }while(0)
  #define RESC() do{ if(resc){ asm volatile("s_waitcnt lgkmcnt(0)":::"memory"); \
      _Pragma("unroll") for(int d_=0;d_<2;++d_) _Pragma("unroll") for(int r=0;r<16;++r)o[d_][r]*=wsf[crow(r,hi)]; } }while(0)
  f32x16 pA0,pA1,pB0,pB1;
  int sl_prev=0,sl_cur=0,sl_next=SLOTB;
  #define ROT() do{sl_prev=sl_cur;sl_cur=sl_next;sl_next=(sl_next==(NSLOT-1)*SLOTB)?0:sl_next+SLOTB;}while(0)
  DMA_K(2,2*SLOTB);
  WAIT_BAR(3);
  qkt(pA0,pA1,Kbase,qr,negm,r32,hi);asm volatile("s_nop 15\n\ts_nop 7":"+v"(pA0),"+v"(pA1));CMASK(pA0,pA1,0);
  START(pA0,pA1);
  _Pragma("unroll") for(int r=0;r<16;++r)pA1[r]=__builtin_amdgcn_exp2f(pA1[r]);
  WAIT_BAR(0);
  DMA_K(3,0);DMA_V(1,SLOTB);
  ROT();
  kload8(kf,kp0+sl_cur);
  WAIT_BAR(2);
  s16x4 vlo[8],vhi[8]; u32x4 pw0,pw1,pw2,pw3;
  #define PKW(P,B) cvtpk_s(P[B],P[B+1])
  #define PAF(k) __builtin_bit_cast(bf16x8,pw##k)
  #define VFR(i) (bf16x8){vlo[i][0],vlo[i][1],vlo[i][2],vlo[i][3],vhi[i][0],vhi[i][1],vhi[i][2],vhi[i][3]}
  #define PIN(x) asm volatile("":"+v"(x))
  #define MX3(a,b,c) __builtin_fmaxf(__builtin_fmaxf((a),(b)),(c))
  #define GAPA(MF,A0,A1,A2,A3,W0,W1,PW) do{ MF; sacc+=A0; sacc+=A1; sacc+=A2; sacc+=A3; PIN(sacc); W0; W1; PIN(PW); SBAR(); }while(0)
  #define EX(v) __builtin_amdgcn_exp2f(v)
  #define GAPB(MF,X,B) do{ MF; X[B]=EX(X[B]); X[B+1]=EX(X[B+1]); X[B+2]=EX(X[B+2]); X[B+3]=EX(X[B+3]); PIN(X); SBAR(); }while(0)
  #define VRD(i) do{ vlo[i]=vtr(vp_+(((i)>>2)*4096+((i)&3)*1024)); vhi[i]=vtr(vp_+(((i)>>2)*4096+((i)&3)*1024+512)); }while(0)
  #define KRD(G,j) do{ if(G){ kload2(kf,kp0+sl_next,j); SBAR(); } }while(0)
  #define STEP(C0,C1,P0,P1,t,GK,GV,GL) do{ SBAR(); \
    const lds_cptr vp_=vp0+sl_prev; \
    VRD(0); SBAR(); float sacc=(P0[0]+P0[1]); \
    GAPA(C0=__builtin_amdgcn_mfma_f32_32x32x16_bf16(kf[0],qr[0],negm,0,0,0), P0[2],P0[3],P0[4],P0[5],     pw0[0]=PKW(P0,0), pw0[1]=PKW(P0,2), pw0); \
    VRD(4); SBAR(); GAPA(C1=__builtin_amdgcn_mfma_f32_32x32x16_bf16(kf[1],qr[0],negm,0,0,0), P0[6],P0[7],P0[8],P0[9],     pw0[2]=PKW(P0,4), pw0[3]=PKW(P0,6), pw0); \
    VRD(1); SBAR(); GAPA(C0=__builtin_amdgcn_mfma_f32_32x32x16_bf16(kf[2],qr[1],C0,0,0,0),   P0[10],P0[11],P0[12],P0[13], pw1[0]=PKW(P0,8), pw1[1]=PKW(P0,10), pw1); \
    VRD(5); SBAR(); GAPA(C1=__builtin_amdgcn_mfma_f32_32x32x16_bf16(kf[3],qr[1],C1,0,0,0),   P0[14],P0[15],P1[0],P1[1],   pw1[2]=PKW(P0,12),pw1[3]=PKW(P0,14), pw1); \
    VRD(2); SBAR(); GAPA(C0=__builtin_amdgcn_mfma_f32_32x32x16_bf16(kf[4],qr[2],C0,0,0,0),   P1[2],P1[3],P1[4],P1[5],     pw2[0]=PKW(P1,0), pw2[1]=PKW(P1,2), pw2); \
    VRD(6); SBAR(); GAPA(C1=__builtin_amdgcn_mfma_f32_32x32x16_bf16(kf[5],qr[2],C1,0,0,0),   P1[6],P1[7],P1[8],P1[9],     pw2[2]=PKW(P1,4), pw2[3]=PKW(P1,6), pw2); \
    VRD(3); SBAR(); GAPA(C0=__builtin_amdgcn_mfma_f32_32x32x16_bf16(kf[6],qr[3],C0,0,0,0),   P1[10],P1[11],P1[12],P1[13], pw3[0]=PKW(P1,8), pw3[1]=PKW(P1,10), pw3); \
    VRD(7); SBAR(); GAPA(C1=__builtin_amdgcn_mfma_f32_32x32x16_bf16(kf[7],qr[3],C1,0,0,0),   P1[14],P1[15],0.f,0.f,       pw3[2]=PKW(P1,12),pw3[3]=PKW(P1,14), pw3); \
    l_reg+=sacc; \
    if(GK){DMA_K((t)+3,sl_cur);} if(GV){DMA_V((t)+1,sl_next);} \
    CMASK(C0,C1,t); \
    { float a=MX3(C0[0],C0[1],C1[0]),b=MX3(C0[2],C0[3],C1[1]); a=MX3(a,C1[2],C1[3]); \
      _Pragma("unroll") for(int r=4;r<16;r+=4){a=MX3(a,C0[r],C0[r+1]);b=MX3(b,C0[r+2],C0[r+3]);a=MX3(a,C1[r],C1[r+1]);b=MX3(b,C1[r+2],C1[r+3]);} \
      float rm=__builtin_fmaxf(a,b); { auto rr=__builtin_amdgcn_permlane32_swap(__float_as_uint(rm),__float_as_uint(rm),false,false); rm=__builtin_fmaxf(__uint_as_float(rr[0]),__uint_as_float(rr[1])); } \
      resc=false; \
      if(__builtin_expect(__any(rm>(float)THRL),0)){ const float dl=__builtin_fmaxf(rm,0.f); mhat+=dl; \
        _Pragma("unroll") for(int r=0;r<16;++r){C0[r]-=dl;C1[r]-=dl;} \
        _Pragma("unroll") for(int r=0;r<16;++r)negm[r]=-mhat; asm volatile("":"+v"(negm)); \
        const float f=__builtin_amdgcn_exp2f(-dl); l_reg*=f; if(hi==0)wsf[r32]=f; resc=true; } } \
    SBAR(); \
    GAPB(o[0]=__builtin_amdgcn_mfma_f32_32x32x16_bf16(PAF(0),VFR(0),o[0],0,0,0), C0,0); \
    GAPB(o[1]=__builtin_amdgcn_mfma_f32_32x32x16_bf16(PAF(0),VFR(4),o[1],0,0,0), C0,4); \
    KRD(GL,0); GAPB(o[0]=__builtin_amdgcn_mfma_f32_32x32x16_bf16(PAF(1),VFR(1),o[0],0,0,0), C0,8); \
    KRD(GL,1); GAPB(o[1]=__builtin_amdgcn_mfma_f32_32x32x16_bf16(PAF(1),VFR(5),o[1],0,0,0), C0,12); \
    KRD(GL,2); GAPB(o[0]=__builtin_amdgcn_mfma_f32_32x32x16_bf16(PAF(2),VFR(2),o[0],0,0,0), C1,0); \
    KRD(GL,3); GAPB(o[1]=__builtin_amdgcn_mfma_f32_32x32x16_bf16(PAF(2),VFR(6),o[1],0,0,0), C1,4); \
    GAPB(o[0]=__builtin_amdgcn_mfma_f32_32x32x16_bf16(PAF(3),VFR(3),o[0],0,0,0), C1,8); \
    GAPB(o[1]=__builtin_amdgcn_mfma_f32_32x32x16_bf16(PAF(3),VFR(7),o[1],0,0,0), C1,12); \
    }while(0)
  int t=1;
  #undef CMASK
  #define CMASK(P0,P1,t) do{}while(0)
  for(;t+7<NT;t+=2){
    STEP(pB0,pB1,pA0,pA1,t,true,true,true);     WAIT_BAR(2); RESC(); ROT();
    STEP(pA0,pA1,pB0,pB1,t+1,true,true,true);   WAIT_BAR(2); RESC(); ROT();
  }
  #undef CMASK
  #define CMASK(P0,P1,t) do{int jb_=(t)-(NT-4); if(jb_>=-2)bmask(P0,P1,jb_,qrel,hi,tab);}while(0)
  #define ENDW(tt) do{ if((tt)+3<NT){WAIT_BAR(2);} else if((tt)+2<NT){WAIT_BAR(1);} else {WAIT_BAR(0);} }while(0)
  for(;t+1<NT;t+=2){
    STEP(pB0,pB1,pA0,pA1,t,(t+3<NT),(t+1<NT),(t+1<NT));       ENDW(t);   RESC(); ROT();
    STEP(pA0,pA1,pB0,pB1,t+1,(t+4<NT),(t+2<NT),(t+2<NT));     ENDW(t+1); RESC(); ROT();
  }
  STEP(pB0,pB1,pA0,pA1,NT-1,false,false,false); RESC();
  { float sacc=pB0[0]+pB0[1]; _Pragma("unroll") for(int r=2;r<16;++r)sacc+=pB0[r]; _Pragma("unroll") for(int r=0;r<16;++r)sacc+=pB1[r]; l_reg+=sacc;
    pw0=(u32x4){PKW(pB0,0),PKW(pB0,2),PKW(pB0,4),PKW(pB0,6)};pw1=(u32x4){PKW(pB0,8),PKW(pB0,10),PKW(pB0,12),PKW(pB0,14)};pw2=(u32x4){PKW(pB1,0),PKW(pB1,2),PKW(pB1,4),PKW(pB1,6)};pw3=(u32x4){PKW(pB1,8),PKW(pB1,10),PKW(pB1,12),PKW(pB1,14)};
    SBAR(); pv(o,vb0+sl_cur,PAF(0),PAF(1),PAF(2),PAF(3)); }
  #undef PKW
  #undef PAF
  #undef VFR
  #undef PIN
  #undef MX3
  #undef GAPA
  #undef GAPB
  #undef EX
  #undef VRD
  #undef KRD
  #undef STEP
  #undef ENDW
  {auto rr=__builtin_amdgcn_permlane32_swap(__float_as_uint(l_reg),__float_as_uint(l_reg),false,false);l_reg=__uint_as_float(rr[0])+__uint_as_float(rr[1]);}
  if(hi==0)wsf[32+r32]=l_reg;asm volatile("s_waitcnt lgkmcnt(0)":::"memory");
  float rli[16];
  #pragma unroll
  for(int r=0;r<16;++r)rli[r]=__builtin_amdgcn_rcpf(wsf[32+crow(r,hi)]);
  bf16*Ow=O+(rowbase+q0+wid*QBLK)*DM+hv*D;
  { bf16*stg=(bf16*)(shm+LDS_OST)+wid*2048;
    #pragma unroll
    for(int r=0;r<16;++r){const int orow=crow(r,hi);
      #pragma unroll
      for(int d0=0;d0<2;++d0)stg[orow*64+d0*32+r32]=__float2bfloat16(o[d0][r]*rli[r]);}
    asm volatile("s_waitcnt lgkmcnt(0)":::"memory");
    #pragma unroll
    for(int i=0;i<4;++i){const int row=i*8+(lane>>3),ch=lane&7; const u32x4 v=*(const u32x4*)(stg+row*64+ch*8); ATTN_STORE16(Ow+(long)row*DM+ch*8,v);} }
  asm volatile("s_waitcnt lgkmcnt(0)\n\ts_barrier":::"memory");
  #undef DMA_K
  #undef DMA_V
  #undef CMASK
  #undef START
  #undef RESC
  #undef ROT
}
constexpr int ATTN_LDS_BYTES=LDS_BYTES;
#undef SBAR
#undef WAIT_BAR
}


namespace attn_body {
#define SBAR() __builtin_amdgcn_sched_barrier(0)
#define WAIT_BAR(N) asm volatile("s_waitcnt vmcnt(" #N ") lgkmcnt(0)\n\ts_barrier":::"memory")
constexpr int SLOTK=8192, SLOTV=16384, L2_K=0, L2_V=NSLOT*SLOTK, L2_WS=L2_V+NSLOT*SLOTV, L2_OST=L2_WS+NW*64*4, L2_BYTES=L2_OST+NW*4096;
__device__ __forceinline__ void pv4(f32x16*o,int vb,bf16x8 pa0,bf16x8 pa1,bf16x8 pa2,bf16x8 pa3){
  #pragma unroll
  for(int d0=0;d0<4;++d0){s16x4 lo[4],hi[4];
    #pragma unroll
    for(int ks=0;ks<4;++ks){
      asm volatile("ds_read_b64_tr_b16 %0,%1 offset:%c2":"=&v"(lo[ks]):"v"(vb),"i"(d0*4096+ks*1024):"memory");
      asm volatile("ds_read_b64_tr_b16 %0,%1 offset:%c2":"=&v"(hi[ks]):"v"(vb),"i"(d0*4096+ks*1024+512):"memory");}
    asm volatile("s_waitcnt lgkmcnt(0)":::"memory");SBAR();
    #define PK(k) (bf16x8){lo[k][0],lo[k][1],lo[k][2],lo[k][3],hi[k][0],hi[k][1],hi[k][2],hi[k][3]}
    o[d0]=__builtin_amdgcn_mfma_f32_32x32x16_bf16(pa0,PK(0),o[d0],0,0,0);
    o[d0]=__builtin_amdgcn_mfma_f32_32x32x16_bf16(pa1,PK(1),o[d0],0,0,0);
    o[d0]=__builtin_amdgcn_mfma_f32_32x32x16_bf16(pa2,PK(2),o[d0],0,0,0);
    o[d0]=__builtin_amdgcn_mfma_f32_32x32x16_bf16(pa3,PK(3),o[d0],0,0,0);
    #undef PK
  }
}
#define ZERO16 (f32x16){0.f,0.f,0.f,0.f,0.f,0.f,0.f,0.f,0.f,0.f,0.f,0.f,0.f,0.f,0.f,0.f}
#define MFMA32(a,b,c) __builtin_amdgcn_mfma_f32_32x32x16_bf16(a,b,c,0,0,0)
template<int THRL> __device__ __forceinline__ void attn_unit2(int b,int hq,int hvb,int qb,const bf16*Q,const bf16*__restrict__ K,const bf16*__restrict__ V,bf16*O,char*shm,lds_fptr tab,int wid_in){
  int lane; asm volatile("v_mbcnt_lo_u32_b32 %0, -1, 0\n\tv_mbcnt_hi_u32_b32 %0, -1, %0" : "=v"(lane)); const int r32=lane&31,hi=lane>>5; const int wid=wid_in;
  const long rowbase=(long)b*SEQ; const int q0=qb*QB;
  const bf16*Qw=Q+(rowbase+q0+wid*QBLK)*DM+hq*D;
  const bf16*Kh=K+rowbase*DM+hq*D,*Vh=V+rowbase*DM+hvb*D;
  const unsigned lds0=(unsigned)(uintptr_t)shm;
  float*wsf=(float*)(shm+L2_WS)+wid*64;
  const bf16*ksrc=Kh+(long)lane*DM+wid*8;
  const bf16*vsrc=Vh+(long)(16*(wid&3)+(lane>>2))*DM+(wid>>2)*32+(lane&3)*8;
  const unsigned kdst=lds0+L2_K+wid*1024, vdst=lds0+L2_V+wid*1024;
  #define DMA_K(t,slot) glds16(ksrc+(long)(t)*KVBLK*DM,(unsigned)__builtin_amdgcn_readfirstlane(kdst+(slot)))
  #define DMA_V(t,slot) do{ glds16(vsrc+(long)(t)*KVBLK*DM,(unsigned)__builtin_amdgcn_readfirstlane(vdst+2*(slot))); glds16(vsrc+(long)(t)*KVBLK*DM+64,(unsigned)__builtin_amdgcn_readfirstlane(vdst+2*(slot)+8192)); }while(0)
  const int vb0=(int)(lds0+L2_V)+((lane>>4)&1)*32+(lane&3)*8+(4*hi+((lane&15)>>2))*64;
  const char*Kbase=shm+L2_K; bf16x8 kf[8];
  const lds_cptr shm3=(lds_cptr)shm; const lds_cptr kp0=shm3+L2_K+hi*1024+r32*16; const lds_cptr vp0=shm3+L2_V+((lane>>4)&1)*32+(lane&3)*8+(4*hi+((lane&15)>>2))*64;
  const int NT=(q0+QB)/KVBLK;
  DMA_K(0,0);DMA_V(0,0);DMA_K(1,SLOTK);
  bf16x8 qr[4];
  #pragma unroll
  for(int d0=0;d0<4;++d0)qr[d0]=*reinterpret_cast<const bf16x8*>(&Qw[(long)r32*DM+d0*16+hi*8]);
  float mh=0.f,l_reg=0.f;f32x16 o[4]; { float z_; asm volatile("v_mov_b32 %0, 0":"=v"(z_)); _Pragma("unroll") for(int r=0;r<16;++r){o[0][r]=z_;o[1][r]=z_;o[2][r]=z_;o[3][r]=z_;} }
  const int qrel=wid*QBLK+r32;
  #define CMASK(P0,P1,t) do{int jb_=(t)-(NT-4); if(jb_>=-2)bmask(P0,P1,jb_,qrel,hi,tab);}while(0)
  bool resc=false;
  #define RESC() do{ if(resc){ asm volatile("s_waitcnt lgkmcnt(0)":::"memory"); \
      _Pragma("unroll") for(int d_=0;d_<4;++d_) _Pragma("unroll") for(int r=0;r<16;++r)o[d_][r]*=wsf[crow(r,hi)]; } }while(0)
  f32x16 pA0,pA1,pB0,pB1;
  int sl_prev=0,sl_cur=0,sl_next=SLOTK;
  #define ROT() do{sl_prev=sl_cur;sl_cur=sl_next;sl_next=(sl_next==(NSLOT-1)*SLOTK)?0:sl_next+SLOTK;}while(0)
  DMA_K(2,2*SLOTK);
  WAIT_BAR(4);
  { const char*kb=Kbase+hi*1024+r32*16;
    #pragma unroll
    for(int d0=0;d0<4;++d0){ const bf16x8 b0=*reinterpret_cast<const bf16x8*>(kb+d0*2048); const bf16x8 b1=*reinterpret_cast<const bf16x8*>(kb+d0*2048+512);
      if(d0==0){pA0=MFMA32(b0,qr[0],ZERO16);pA1=MFMA32(b1,qr[0],ZERO16);} else{pA0=MFMA32(b0,qr[d0],pA0);pA1=MFMA32(b1,qr[d0],pA1);} } }
  CMASK(pA0,pA1,0);
  { float a=__builtin_fmaxf(__builtin_fmaxf(pA0[0],pA0[1]),pA1[0]),b_=__builtin_fmaxf(__builtin_fmaxf(pA0[2],pA0[3]),pA1[1]); a=__builtin_fmaxf(__builtin_fmaxf(a,pA1[2]),pA1[3]);
    _Pragma("unroll") for(int r=4;r<16;r+=4){a=__builtin_fmaxf(__builtin_fmaxf(a,pA0[r]),pA0[r+1]);b_=__builtin_fmaxf(__builtin_fmaxf(b_,pA0[r+2]),pA0[r+3]);a=__builtin_fmaxf(__builtin_fmaxf(a,pA1[r]),pA1[r+1]);b_=__builtin_fmaxf(__builtin_fmaxf(b_,pA1[r+2]),pA1[r+3]);}
    float rm=__builtin_fmaxf(a,b_); { auto rr=__builtin_amdgcn_permlane32_swap(__float_as_uint(rm),__float_as_uint(rm),false,false); rm=__builtin_fmaxf(__uint_as_float(rr[0]),__uint_as_float(rr[1])); }
    mh=rm;
    _Pragma("unroll") for(int r=0;r<16;++r){pA0[r]=__builtin_amdgcn_exp2f(pA0[r]-mh);pA1[r]=__builtin_amdgcn_exp2f(pA1[r]-mh);} }
  WAIT_BAR(0);
  DMA_K(3,0);DMA_V(1,SLOTK);
  ROT();
  kload8(kf,kp0+sl_cur);
  WAIT_BAR(3);
  s16x4 vlo[8],vhi[8]; u32x4 pw0,pw1,pw2,pw3;
  #define PKW(P,B) cvtpk_s(P[B],P[B+1])
  #define PAF(k) __builtin_bit_cast(bf16x8,pw##k)
  #define VFR(i) (bf16x8){vlo[i][0],vlo[i][1],vlo[i][2],vlo[i][3],vhi[i][0],vhi[i][1],vhi[i][2],vhi[i][3]}
  #define PIN(x) asm volatile("":"+v"(x))
  #define MX3(a,b,c) __builtin_fmaxf(__builtin_fmaxf((a),(b)),(c))
  #define GAPA(MF,A0,A1,A2,A3,W0,W1,PW) do{ MF; sacc+=A0; sacc+=A1; sacc+=A2; sacc+=A3; PIN(sacc); W0; W1; PIN(PW); SBAR(); }while(0)
  #define EX(v) __builtin_amdgcn_exp2f((v)-mh)
  #define GAPB(MF,X,B) do{ MF; X[B]=EX(X[B]); X[B+1]=EX(X[B+1]); PIN(X); SBAR(); }while(0)
  #define VRDX(i,j) do{ vlo[i]=vtr(vp_+(((j)>>2)*4096+((j)&3)*1024)); vhi[i]=vtr(vp_+(((j)>>2)*4096+((j)&3)*1024+512)); }while(0)
  #define KRD(G,j) do{ if(G){ kload2(kf,kp0+sl_next,j); SBAR(); } }while(0)
  #define STEP(C0,C1,P0,P1,t,GK,GV,GL) do{ SBAR(); \
    const lds_cptr vp_=vp0+2*sl_prev; \
    VRDX(0,0); SBAR(); float sacc=(P0[0]+P0[1]); \
    GAPA(C0=MFMA32(kf[0],qr[0],ZERO16), P0[2],P0[3],P0[4],P0[5],     pw0[0]=PKW(P0,0), pw0[1]=PKW(P0,2), pw0); \
    VRDX(4,4); SBAR(); GAPA(C1=MFMA32(kf[1],qr[0],ZERO16), P0[6],P0[7],P0[8],P0[9],     pw0[2]=PKW(P0,4), pw0[3]=PKW(P0,6), pw0); \
    VRDX(1,1); SBAR(); GAPA(C0=MFMA32(kf[2],qr[1],C0),   P0[10],P0[11],P0[12],P0[13], pw1[0]=PKW(P0,8), pw1[1]=PKW(P0,10), pw1); \
    VRDX(5,5); SBAR(); GAPA(C1=MFMA32(kf[3],qr[1],C1),   P0[14],P0[15],P1[0],P1[1],   pw1[2]=PKW(P0,12),pw1[3]=PKW(P0,14), pw1); \
    VRDX(2,2); SBAR(); GAPA(C0=MFMA32(kf[4],qr[2],C0),   P1[2],P1[3],P1[4],P1[5],     pw2[0]=PKW(P1,0), pw2[1]=PKW(P1,2), pw2); \
    VRDX(6,6); SBAR(); GAPA(C1=MFMA32(kf[5],qr[2],C1),   P1[6],P1[7],P1[8],P1[9],     pw2[2]=PKW(P1,4), pw2[3]=PKW(P1,6), pw2); \
    VRDX(3,3); SBAR(); GAPA(C0=MFMA32(kf[6],qr[3],C0),   P1[10],P1[11],P1[12],P1[13], pw3[0]=PKW(P1,8), pw3[1]=PKW(P1,10), pw3); \
    VRDX(7,7); SBAR(); GAPA(C1=MFMA32(kf[7],qr[3],C1),   P1[14],P1[15],0.f,0.f,       pw3[2]=PKW(P1,12),pw3[3]=PKW(P1,14), pw3); \
    l_reg+=sacc; \
    if(GK){DMA_K((t)+3,sl_cur);} if(GV){DMA_V((t)+1,sl_next);} \
    CMASK(C0,C1,t); \
    { float a=MX3(C0[0],C0[1],C1[0]),b_=MX3(C0[2],C0[3],C1[1]); a=MX3(a,C1[2],C1[3]); \
      _Pragma("unroll") for(int r=4;r<16;r+=4){a=MX3(a,C0[r],C0[r+1]);b_=MX3(b_,C0[r+2],C0[r+3]);a=MX3(a,C1[r],C1[r+1]);b_=MX3(b_,C1[r+2],C1[r+3]);} \
      float rm=__builtin_fmaxf(a,b_); { auto rr=__builtin_amdgcn_permlane32_swap(__float_as_uint(rm),__float_as_uint(rm),false,false); rm=__builtin_fmaxf(__uint_as_float(rr[0]),__uint_as_float(rr[1])); } \
      resc=false; \
      if(__builtin_expect(__any(rm-mh>(float)THRL),0)){ const float dl=__builtin_fmaxf(rm-mh,0.f); mh+=dl; \
        const float f=__builtin_amdgcn_exp2f(-dl); l_reg*=f; if(hi==0)wsf[r32]=f; resc=true; } } \
    SBAR(); \
    GAPB(o[0]=MFMA32(PAF(0),VFR(0),o[0]), C0,0);  VRDX(0,8);  SBAR(); \
    GAPB(o[1]=MFMA32(PAF(0),VFR(4),o[1]), C0,2);  VRDX(4,12); SBAR(); \
    GAPB(o[0]=MFMA32(PAF(1),VFR(1),o[0]), C0,4);  VRDX(1,9);  SBAR(); \
    GAPB(o[1]=MFMA32(PAF(1),VFR(5),o[1]), C0,6);  VRDX(5,13); SBAR(); \
    GAPB(o[0]=MFMA32(PAF(2),VFR(2),o[0]), C0,8);  VRDX(2,10); SBAR(); \
    GAPB(o[1]=MFMA32(PAF(2),VFR(6),o[1]), C0,10); VRDX(6,14); SBAR(); \
    GAPB(o[0]=MFMA32(PAF(3),VFR(3),o[0]), C0,12); VRDX(3,11); SBAR(); \
    GAPB(o[1]=MFMA32(PAF(3),VFR(7),o[1]), C0,14); VRDX(7,15); SBAR(); \
    GAPB(o[2]=MFMA32(PAF(0),VFR(0),o[2]), C1,0); \
    GAPB(o[3]=MFMA32(PAF(0),VFR(4),o[3]), C1,2); \
    KRD(GL,0); GAPB(o[2]=MFMA32(PAF(1),VFR(1),o[2]), C1,4); \
    KRD(GL,1); GAPB(o[3]=MFMA32(PAF(1),VFR(5),o[3]), C1,6); \
    KRD(GL,2); GAPB(o[2]=MFMA32(PAF(2),VFR(2),o[2]), C1,8); \
    KRD(GL,3); GAPB(o[3]=MFMA32(PAF(2),VFR(6),o[3]), C1,10); \
    GAPB(o[2]=MFMA32(PAF(3),VFR(3),o[2]), C1,12); \
    GAPB(o[3]=MFMA32(PAF(3),VFR(7),o[3]), C1,14); \
    }while(0)
  int t=1;
  #undef CMASK
  #define CMASK(P0,P1,t) do{}while(0)
  for(;t+7<NT;t+=2){
    STEP(pB0,pB1,pA0,pA1,t,true,true,true);     WAIT_BAR(3); RESC(); ROT();
    STEP(pA0,pA1,pB0,pB1,t+1,true,true,true);   WAIT_BAR(3); RESC(); ROT();
  }
  #undef CMASK
  #define CMASK(P0,P1,t) do{int jb_=(t)-(NT-4); if(jb_>=-2)bmask(P0,P1,jb_,qrel,hi,tab);}while(0)
  #define ENDW(tt) do{ if((tt)+3<NT){WAIT_BAR(3);} else if((tt)+2<NT){WAIT_BAR(2);} else {WAIT_BAR(0);} }while(0)
  for(;t+1<NT;t+=2){
    STEP(pB0,pB1,pA0,pA1,t,(t+3<NT),(t+1<NT),(t+1<NT));       ENDW(t);   RESC(); ROT();
    STEP(pA0,pA1,pB0,pB1,t+1,(t+4<NT),(t+2<NT),(t+2<NT));     ENDW(t+1); RESC(); ROT();
  }
  STEP(pB0,pB1,pA0,pA1,NT-1,false,false,false); RESC();
  { float sacc=pB0[0]+pB0[1]; _Pragma("unroll") for(int r=2;r<16;++r)sacc+=pB0[r]; _Pragma("unroll") for(int r=0;r<16;++r)sacc+=pB1[r]; l_reg+=sacc;
    pw0=(u32x4){PKW(pB0,0),PKW(pB0,2),PKW(pB0,4),PKW(pB0,6)};pw1=(u32x4){PKW(pB0,8),PKW(pB0,10),PKW(pB0,12),PKW(pB0,14)};pw2=(u32x4){PKW(pB1,0),PKW(pB1,2),PKW(pB1,4),PKW(pB1,6)};pw3=(u32x4){PKW(pB1,8),PKW(pB1,10),PKW(pB1,12),PKW(pB1,14)};
    SBAR(); pv4(o,vb0+2*sl_cur,PAF(0),PAF(1),PAF(2),PAF(3)); }
  {auto rr=__builtin_amdgcn_permlane32_swap(__float_as_uint(l_reg),__float_as_uint(l_reg),false,false);l_reg=__uint_as_float(rr[0])+__uint_as_float(rr[1]);}
  if(hi==0)wsf[32+r32]=l_reg;asm volatile("s_waitcnt lgkmcnt(0)":::"memory");
  float rli[16];
  #pragma unroll
  for(int r=0;r<16;++r)rli[r]=__builtin_amdgcn_rcpf(wsf[32+crow(r,hi)]);
  bf16*Ow=O+(rowbase+q0+wid*QBLK)*DM+hvb*D;
  { bf16*stg=(bf16*)(shm+L2_OST)+wid*2048;
    #pragma unroll
    for(int hf=0;hf<2;++hf){
      #pragma unroll
      for(int r=0;r<16;++r){const int orow=crow(r,hi);
        #pragma unroll
        for(int d0=0;d0<2;++d0)stg[orow*64+d0*32+r32]=__float2bfloat16(o[2*hf+d0][r]*rli[r]);}
      asm volatile("s_waitcnt lgkmcnt(0)":::"memory");
      #pragma unroll
      for(int i=0;i<4;++i){const int row=i*8+(lane>>3),ch=lane&7; const u32x4 v=*(const u32x4*)(stg+row*64+ch*8); ATTN_STORE16(Ow+(long)row*DM+hf*64+ch*8,v);}
      asm volatile("s_waitcnt lgkmcnt(0)":::"memory");
    } }
  asm volatile("s_waitcnt lgkmcnt(0)\n\ts_barrier":::"memory");
  #undef DMA_K
  #undef DMA_V
  #undef CMASK
  #undef RESC
  #undef ROT
  #undef PKW
  #undef PAF
  #undef VFR
  #undef PIN
  #undef MX3
  #undef GAPA
  #undef GAPB
  #undef EX
  #undef VRDX
  #undef KRD
  #undef STEP
  #undef ENDW
}
constexpr int ATTN2_LDS_BYTES=L2_BYTES;
#undef ZERO16
#undef MFMA32
#undef SBAR
#undef WAIT_BAR
}

#define GAS __attribute__((address_space(1)))
#define LAS __attribute__((address_space(3)))
typedef unsigned short bf16;
typedef unsigned v4u __attribute__((ext_vector_type(4)));
typedef float f32x4 __attribute__((ext_vector_type(4)));
typedef short bf16x8 __attribute__((ext_vector_type(8)));
typedef GAS unsigned gu32;
typedef GAS unsigned long long gu64;
#define RLX_AGENT __ATOMIC_RELAXED, __HIP_MEMORY_SCOPE_AGENT
#define LDS_WAIT() asm volatile("s_waitcnt lgkmcnt(0)" ::: "memory")
#define VM_WAIT() asm volatile("s_waitcnt vmcnt(0)" ::: "memory")
__device__ __forceinline__ unsigned long long rt() { return __builtin_amdgcn_s_memrealtime(); }
__device__ __forceinline__ unsigned f2bf(float f) { unsigned u = __builtin_bit_cast(unsigned, f); return (u + 0x7fffu + ((u >> 16) & 1u)) >> 16; }
__device__ __forceinline__ unsigned pk2(float lo, float hi) { return f2bf(lo) | (f2bf(hi) << 16); }

#define XB_TMO      128
#define XB_XCNT(j)  (256  + 64 * (j))
#define XB_XSUB(j)  (1280 + 64 * (j))
#define XB_XGEN(j)  (2304 + 64 * (j))
#define XB_TOP      3328
#define XB_TOPGEN   3392
#define XCD_BAR_WORDS 3456
#define XB_SPIN_CAP (1u << 18)

__device__ __forceinline__ unsigned xb_ld(unsigned* p)              { return __hip_atomic_load(p, __ATOMIC_RELAXED, __HIP_MEMORY_SCOPE_AGENT); }
__device__ __forceinline__ unsigned xb_add(unsigned* p, unsigned v) { return __hip_atomic_fetch_add(p, v, __ATOMIC_RELAXED, __HIP_MEMORY_SCOPE_AGENT); }
__device__ __forceinline__ unsigned xb_xcc_id() { return (unsigned)__builtin_amdgcn_s_getreg((3 << 11) | 20) & 0xFu; }
#define XB_SPIN(cond, bar) do { unsigned _sp = 0; while (cond) { __builtin_amdgcn_s_sleep(1); \
    if ((++_sp & 255u) == 0u) { if (xb_ld(&(bar)[XB_TMO])) break; if (_sp > XB_SPIN_CAP) { atomicAdd(&(bar)[XB_TMO], 1u); break; } } } } while (0)

struct XcdBarrier {
    unsigned* bar; unsigned x;
    volatile LAS unsigned* st;
};

__device__ __forceinline__ XcdBarrier xcd_barrier_post(unsigned* bar, volatile LAS unsigned* st) {
    XcdBarrier b; b.bar = bar; b.x = xb_xcc_id(); b.st = st;
    if (threadIdx.x == 0) (void)xb_add(&bar[XB_XCNT(b.x)], 1u);
    return b;
}
__device__ __forceinline__ void xcd_barrier_complete(unsigned* bar, unsigned x, unsigned& nloc, unsigned& nx) {
    const unsigned G = gridDim.x * gridDim.y * gridDim.z;
    unsigned sum, cnt, mine, sp = 0u;
    for (;;) {
        sum = 0u; cnt = 0u; mine = 0u;
#pragma unroll
        for (unsigned j = 0; j < 16; ++j) { const unsigned c = xb_ld(&bar[XB_XCNT(j)]); sum += c; cnt += (c > 0u) ? 1u : 0u; mine = (j == x) ? c : mine; }
        if (sum == G) break;
        __builtin_amdgcn_s_sleep(1);
        if ((++sp & 255u) == 0u) { if (xb_ld(&bar[XB_TMO])) break; if (sp > XB_SPIN_CAP) { atomicAdd(&bar[XB_TMO], 1u); break; } }
    }
    nloc = mine > 0u ? mine : 1u; nx = cnt > 0u ? cnt : 1u;
}

__device__ __forceinline__ void xcd_barrier(const XcdBarrier& b, const bool leader) {
    asm volatile("s_waitcnt vmcnt(0)" ::: "memory");
    __syncthreads();
    if (leader) {
        unsigned* bar = b.bar;
        __builtin_amdgcn_s_waitcnt(0);
        unsigned nloc = b.st[0], nx = b.st[1];
        if (nloc == 0u) { xcd_barrier_complete(bar, b.x, nloc, nx); b.st[0] = nloc; b.st[1] = nx; }
        const unsigned old = xb_add(&bar[XB_XSUB(b.x)], 1u);
        const unsigned gen = old / nloc;
        if (old + 1u == (gen + 1u) * nloc) {
            __builtin_amdgcn_fence(__ATOMIC_RELEASE, "agent");
            asm volatile("s_waitcnt vmcnt(0)" ::: "memory");
            const unsigned og = xb_add(&bar[XB_TOP], 1u);
            const unsigned tg = og / nx;
            if (og + 1u == (tg + 1u) * nx) xb_add(&bar[XB_TOPGEN], 1u);
            else XB_SPIN(xb_ld(&bar[XB_TOPGEN]) == tg, bar);
            __builtin_amdgcn_fence(__ATOMIC_ACQUIRE, "agent");
            xb_add(&bar[XB_XGEN(b.x)], 1u);
            asm volatile("s_waitcnt vmcnt(0)" ::: "memory");
        } else {
            XB_SPIN(xb_ld(&bar[XB_XGEN(b.x)]) == gen, bar);
            __builtin_amdgcn_fence(__ATOMIC_ACQUIRE, "agent");
            asm volatile("s_waitcnt vmcnt(0)" ::: "memory");
        }
    }
    __syncthreads();
}


constexpr int NWAVES = 8;
constexpr int RING_OFF = 0, RING_BYTES = 131072;
constexpr int LDSCTL_OFF = RING_BYTES, MISC_OFF = LDSCTL_OFF + 320;
constexpr int LDS_BYTES = 147456;
constexpr int ATT_TAB_OFF = 110592;
static_assert(attn_body::ATTN_LDS_BYTES <= ATT_TAB_OFF && attn_body::ATTN2_LDS_BYTES <= ATT_TAB_OFF && ATT_TAB_OFF + 4096 <= RING_BYTES, "attention LDS map");
constexpr int CW_TMO = 0, CW_CODE = 1, CW_BAR = 4096;
static_assert((CW_BAR + XCD_BAR_WORDS) * 4 <= (int)CTL_ZERO_BYTES, "control words inside the memset region");
constexpr int N_PHASES = 9;
#ifndef MK_DUP_ATTN
#define MK_DUP_ATTN 1
#endif
#ifndef MK_ATTN2
#define MK_ATTN2 1
#endif
#ifndef MK_ALIGN
#define MK_ALIGN true
#endif
#ifndef MK_SP2
#define MK_SP2 true
#endif

__device__ __forceinline__ float wave_sum(float v) {
#pragma unroll
    for (int o = 1; o < 64; o <<= 1) v += __shfl_xor(v, o);
    return v;
}
__device__ __forceinline__ float sigm(float x) { return __builtin_amdgcn_rcpf(1.0f + __builtin_amdgcn_exp2f(-1.4426950408889634f * x)); }

__device__ __forceinline__ void p0_transpose_item(const float* W, int N, bf16* WT, int ldt, int koff, LAS float* scr, int item, int lane, int rot = 0) {
    const int nblk = N / 32, kb = item / nblk, nb = item % nblk, k0 = 64 * kb, n0 = 32 * nb;
#pragma unroll 8
    for (int i = 0; i < 32; ++i) { const int kk = 2 * i + (lane >> 5); scr[kk * 33 + (lane & 31)] = W[(size_t)(k0 + kk) * N + n0 + (lane & 31)]; }
    LDS_WAIT(); asm volatile("" ::: "memory");
    const int c = lane & 7;
#pragma unroll
    for (int j = 0; j < 4; ++j) { const int n = (lane >> 3) + 8 * j; const LAS float* s = scr + (8 * c) * 33 + n;
        v4u o; o.x = pk2(s[0 * 33], s[1 * 33]); o.y = pk2(s[2 * 33], s[3 * 33]); o.z = pk2(s[4 * 33], s[5 * 33]); o.w = pk2(s[6 * 33], s[7 * 33]);
        *(GAS v4u*)(WT + (size_t)((n0 + n + rot) & (N - 1)) * ldt + koff + k0 + 8 * c) = o; }
    LDS_WAIT(); asm volatile("" ::: "memory");
}

__device__ __forceinline__ void rnn_phase(LAS unsigned char* lds, int vcu, int lane, int wave, const bf16* RX, bf16* YA, const float* conv_w, const float* conv_b,
                                          const float* w_a, const float* b_a, const float* w_x, const float* b_x, const float* lam) {
    const int b = vcu >> 6, hb = (vcu >> 2) & 15, qd = vcu & 3, fr = lane & 15, fq = lane >> 4;
    const int cin0 = hb * 64, co = hb * 64 + qd * 16 + fr;
    bf16x8 Ba[2], Bx[2], Bs[2];
#pragma unroll
    for (int ks = 0; ks < 2; ++ks)
#pragma unroll
        for (int j = 0; j < 8; ++j) { const int i = 32 * ks + 8 * fq + j, jo = qd * 16 + fr;
            Ba[ks][j] = (short)f2bf(w_a[(size_t)hb * 4096 + i * 64 + jo]); Bx[ks][j] = (short)f2bf(w_x[(size_t)hb * 4096 + i * 64 + jo]); Bs[ks][j] = (i == jo) ? (short)0x3f80 : (short)0; }
    float cw[2][4][8], cb[2][8];
#pragma unroll
    for (int ks = 0; ks < 2; ++ks)
#pragma unroll
        for (int j = 0; j < 8; ++j) { const int ch = cin0 + 32 * ks + 8 * fq + j; cb[ks][j] = conv_b[ch];
#pragma unroll
            for (int tp = 0; tp < 4; ++tp) cw[ks][tp][j] = conv_w[tp * 1024 + ch]; }
    const float bav = b_a[co], bxv = b_x[co]; const float logu = -8.0f * log1pf(expf(-lam[co]));
    float hsc = 0.f;
    LAS float* tot = (LAS float*)lds;
    const bf16* RXb = RX + (size_t)b * SEQ * 1024 + cin0 + 8 * fq;
    bf16* YAb = YA + (size_t)b * SEQ * 2048 + co;
    for (int sc = 0; sc < SEQ / 512; ++sc) {
        const int t0 = sc * 512 + wave * 64;
        unsigned short rg[4][4];
#pragma unroll
        for (int m = 0; m < 4; ++m)
#pragma unroll
            for (int r = 0; r < 4; ++r) rg[m][r] = YAb[(size_t)(t0 + 16 * m + 4 * fq + r) * 2048];
        float hl[4][4], ac[4][4]; float Ach = 1.f, Hch = 0.f;
#pragma unroll
        for (int m = 0; m < 4; ++m) {
            const int tok = t0 + 16 * m + fr;
            bf16x8 Af[2];
#pragma unroll
            for (int ks = 0; ks < 2; ++ks) {
                float xc[8];
#pragma unroll
                for (int j = 0; j < 8; ++j) xc[j] = cb[ks][j];
#pragma unroll
                for (int tp = 0; tp < 4; ++tp) { const int tt = tok - 3 + tp; v4u xr = (v4u){0u, 0u, 0u, 0u};
                    if (tt >= 0) xr = *(const GAS v4u*)(RXb + (size_t)tt * 1024 + 32 * ks);
                    xc[0] += cw[ks][tp][0] * __uint_as_float(xr.x << 16); xc[1] += cw[ks][tp][1] * __uint_as_float(xr.x & 0xffff0000u);
                    xc[2] += cw[ks][tp][2] * __uint_as_float(xr.y << 16); xc[3] += cw[ks][tp][3] * __uint_as_float(xr.y & 0xffff0000u);
                    xc[4] += cw[ks][tp][4] * __uint_as_float(xr.z << 16); xc[5] += cw[ks][tp][5] * __uint_as_float(xr.z & 0xffff0000u);
                    xc[6] += cw[ks][tp][6] * __uint_as_float(xr.w << 16); xc[7] += cw[ks][tp][7] * __uint_as_float(xr.w & 0xffff0000u); }
                v4u pk; pk.x = pk2(xc[0], xc[1]); pk.y = pk2(xc[2], xc[3]); pk.z = pk2(xc[4], xc[5]); pk.w = pk2(xc[6], xc[7]);
                Af[ks] = __builtin_bit_cast(bf16x8, pk);
            }
            f32x4 Dr = (f32x4){0.f, 0.f, 0.f, 0.f}, Di = Dr, Dx = Dr;
#pragma unroll
            for (int ks = 0; ks < 2; ++ks) { Dr = __builtin_amdgcn_mfma_f32_16x16x32_bf16(Af[ks], Ba[ks], Dr, 0, 0, 0); Di = __builtin_amdgcn_mfma_f32_16x16x32_bf16(Af[ks], Bx[ks], Di, 0, 0, 0);
                Dx = __builtin_amdgcn_mfma_f32_16x16x32_bf16(Af[ks], Bs[ks], Dx, 0, 0, 0); }
            float al[4], hh[4];
#pragma unroll
            for (int r = 0; r < 4; ++r) { const float rr = sigm(Dr[r] + bav), ii = sigm(Di[r] + bxv); const float la = rr * logu; const float a = __expf(la);
                const float bin = sqrtf(-expm1f(2.0f * la)) * (ii * Dx[r]);
                if (r == 0) { al[0] = a; hh[0] = bin; } else { al[r] = a * al[r - 1]; hh[r] = a * hh[r - 1] + bin; } }
            float Ai = al[3], Hi = hh[3];
            { const float Ap = __shfl_up(Ai, 16), Hp = __shfl_up(Hi, 16); if (fq >= 1) { Hi = Ai * Hp + Hi; Ai = Ai * Ap; } }
            { const float Ap = __shfl_up(Ai, 32), Hp = __shfl_up(Hi, 32); if (fq >= 2) { Hi = Ai * Hp + Hi; Ai = Ai * Ap; } }
            float Ae = __shfl_up(Ai, 16), He = __shfl_up(Hi, 16); if (fq == 0) { Ae = 1.f; He = 0.f; }
            const float hin = Ae * Hch + He, Ain = Ae * Ach;
#pragma unroll
            for (int r = 0; r < 4; ++r) { hl[m][r] = hh[r] + al[r] * hin; ac[m][r] = al[r] * Ain; }
            const float Am = __shfl(Ai, 48 + fr), Hm = __shfl(Hi, 48 + fr);
            Hch = Am * Hch + Hm; Ach = Am * Ach;
        }
        LAS float* tw = tot + ((sc & 1) * 8 + wave) * 32;
        if (fq == 0) { tw[fr * 2] = Ach; tw[fr * 2 + 1] = Hch; }
        asm volatile("s_waitcnt lgkmcnt(0)\n\ts_barrier" ::: "memory");
        float cin = 0.f, c = hsc;
#pragma unroll
        for (int w2 = 0; w2 < 8; ++w2) { const LAS float* tr = tot + ((sc & 1) * 8 + w2) * 32 + fr * 2; const float A = tr[0], H = tr[1]; if (w2 == wave) cin = c; c = A * c + H; }
        hsc = c;
#pragma unroll
        for (int m = 0; m < 4; ++m)
#pragma unroll
            for (int r = 0; r < 4; ++r) { const float h = hl[m][r] + ac[m][r] * cin;
                YAb[(size_t)(t0 + 16 * m + 4 * fq + r) * 2048] = (bf16)f2bf(h * __uint_as_float(((unsigned)rg[m][r]) << 16)); }
    }
    asm volatile("s_waitcnt lgkmcnt(0)\n\ts_barrier" ::: "memory");
}

__device__ __forceinline__ void attn_phase_diff(unsigned char* lds_generic, LAS unsigned char* lds, int vcu, int tid, int wave, const bf16* Q, const bf16* K, const bf16* V, bf16* O0, bf16* O1, const float* rel_bias) {
    LAS float* tab = (LAS float*)(lds + ATT_TAB_OFF);
    for (int e = tid; e < 1024; e += NWAVES * 64) { const int h = e >> 7, n = e & 127;
        int bk; if (n < 16) bk = n; else { bk = 16 + (int)(logf((float)n / 16.0f) / 2.0794415416798357f * 16.0f); bk = bk < 31 ? bk : 31; }
        tab[e] = (rel_bias[bk * 8 + h] - rel_bias[31 * 8 + h]) * 1.4426950408889634f; }
    asm volatile("s_waitcnt lgkmcnt(0)\n\ts_barrier" ::: "memory");
    const int g = vcu >> 3, s = vcu & 7, b = g >> 3, h = g & 7;
#if MK_ATTN2
    for (int i = 0; i < 8; ++i) {
        const int c = i >> 2, j = i & 3;
        const int qb = (j == 0) ? s : (j == 1) ? 15 - s : (j == 2) ? 16 + s : 31 - s;
        attn_body::attn_unit2<8>(b, h * 2 + c, h * 2, qb, (const attn_body::bf16*)Q, (const attn_body::bf16*)K, (const attn_body::bf16*)V, (attn_body::bf16*)(c == 0 ? O0 : O1), (char*)lds_generic,
                                 (attn_body::lds_fptr)(tab + h * 128), wave);
    }
#else
    for (int i = 0; i < 16; ++i) {
        const int sub = i >> 2, c = sub >> 1, vh = sub & 1, j = i & 3;
        const int qb = (j == 0) ? s : (j == 1) ? 15 - s : (j == 2) ? 16 + s : 31 - s;
        attn_body::attn_unit<8>(b, h * 2 + c, h * 2 + vh, qb, (const attn_body::bf16*)Q, (const attn_body::bf16*)K, (const attn_body::bf16*)V, (attn_body::bf16*)(c == 0 ? O0 : O1), (char*)lds_generic,
                                (attn_body::lds_fptr)(tab + h * 128), wave);
    }
#endif
}

struct Args { const float* in[23]; float* out; unsigned char* ws; int ph_lo, ph_hi; };
typedef const __attribute__((address_space(4))) Args* KArgs;
__device__ __forceinline__ KArgs kargs() { auto p = __builtin_amdgcn_kernarg_segment_ptr(); asm volatile("" : "+s"(p)); return (KArgs)p; }
__device__ __forceinline__ int lane_id() { int l; asm volatile("v_mbcnt_lo_u32_b32 %0, -1, 0\n\tv_mbcnt_hi_u32_b32 %0, -1, %0" : "=v"(l)); return l; }
__global__ void __launch_bounds__(NWAVES * 64, 2) mk_fwd(Args args) {
    extern __shared__ __attribute__((aligned(16))) unsigned char lds_[];
    LAS unsigned char* lds = (LAS unsigned char*)lds_;
    volatile LAS unsigned* MISC = (volatile LAS unsigned*)(lds + MISC_OFF);
    const int wave = __builtin_amdgcn_readfirstlane((int)threadIdx.x >> 6);
    const int G = gridDim.x; const int vcu = (G % 8 == 0) ? ((int)blockIdx.x % 8) * (G / 8) + (int)blockIdx.x / 8 : (int)blockIdx.x;
    const int gw = vcu * NWAVES + wave, NGW = G * NWAVES;
    gu32* ctl = (gu32*)(args.ws + WS_CTL);
    for (int u = threadIdx.x; u < (LDS_BYTES - LDSCTL_OFF) / 4; u += NWAVES * 64) ((LAS unsigned*)(lds + LDSCTL_OFF))[u] = 0u;
    __syncthreads();
    const int lo = args.ph_lo, hi = args.ph_hi;
    const bool use_bar = (hi - lo) > 1;
    XcdBarrier bar; bar.bar = (unsigned*)(ctl + CW_BAR); bar.x = 0; bar.st = nullptr;
    if (use_bar) bar = xcd_barrier_post((unsigned*)(ctl + CW_BAR), MISC + 8);
#define IN(k) (lo <= (k) && (k) < hi)
#define SEAM(k) do { if (IN(k) && IN((k) + 1)) xcd_barrier(bar, wave == 0 && lane_id() == 0); } while (0)

    if (IN(0)) {
        KArgs A = kargs(); const int lane = lane_id(), tid = wave * 64 + lane; (void)tid;
        const float* cvec = A->in[1];
        const float* w_ada = A->in[2];
        const float* b_ada = A->in[3];
        const float* w_in = A->in[4];
        const float* w_rnn_out = A->in[18];
        const float* w_attn_out = A->in[19];
        const float* w_out = A->in[20];
        float* modf = (float*)(A->ws + WS_MODF);
        bf16* win_t = (bf16*)(A->ws + WS_WIN);
        bf16* wcat_t = (bf16*)(A->ws + WS_WCAT);
        bf16* wout_t = (bf16*)(A->ws + WS_WOUT);

        if (vcu < 192) {
            LAS float* scv = (LAS float*)lds;
            LAS float* red = (LAS float*)(lds + 16384);
#pragma unroll
            for (int i = 0; i < 8; ++i) { const int e = tid * 8 + i; const float cv = cvec[e]; scv[e] = cv * sigm(cv); }
            __syncthreads();
            const int e0 = vcu * 16, col = lane & 15, kg = lane >> 4;
            float a0 = 0.f, a1 = 0.f, a2 = 0.f, a3 = 0.f;
#pragma unroll 8
            for (int i = 0; i < 32; ++i) { const int k = wave * 128 + kg * 32 + i; const float w = w_ada[(size_t)k * 3072 + e0 + col];
                a0 += scv[k] * w; a1 += scv[1024 + k] * w; a2 += scv[2048 + k] * w; a3 += scv[3072 + k] * w; }
            a0 += __shfl_xor(a0, 16); a0 += __shfl_xor(a0, 32); a1 += __shfl_xor(a1, 16); a1 += __shfl_xor(a1, 32);
            a2 += __shfl_xor(a2, 16); a2 += __shfl_xor(a2, 32); a3 += __shfl_xor(a3, 16); a3 += __shfl_xor(a3, 32);
            if (kg == 0) { red[(wave * 4 + 0) * 16 + col] = a0; red[(wave * 4 + 1) * 16 + col] = a1; red[(wave * 4 + 2) * 16 + col] = a2; red[(wave * 4 + 3) * 16 + col] = a3; }
            __syncthreads();
            if (tid < 64) { const int bb = tid >> 4, cc = tid & 15; float sacc = b_ada[e0 + cc];
#pragma unroll
                for (int w2 = 0; w2 < 8; ++w2) sacc += red[(w2 * 4 + bb) * 16 + cc];
                modf[bb * 3072 + e0 + cc] = sacc; }
            __syncthreads();
        }
        LAS float* scr = (LAS float*)(lds + RING_OFF + wave * 16384);
        constexpr int I_IN = (DM / 64) * (NIN / 32), I_SQ = (DM / 64) * (DM / 32), NITEMS = I_IN + 3 * I_SQ;
        for (int it = gw; it < NITEMS; it += NGW) {
            int r = it;
            if (r < I_IN) { p0_transpose_item(w_in, NIN, win_t, DM, 0, scr, r, lane); continue; } r -= I_IN;
            if (r < I_SQ) { p0_transpose_item(w_rnn_out, DM, wcat_t, 2048, 0, scr, r, lane); continue; } r -= I_SQ;
            if (r < I_SQ) { p0_transpose_item(w_attn_out, DM, wcat_t, 2048, 1024, scr, r, lane); continue; } r -= I_SQ;
            p0_transpose_item(w_out, DM, wout_t, DM, 0, scr, r, lane);
        }
    }
    SEAM(0);
    if (IN(1)) {
        KArgs A = kargs(); const int lane = lane_id(), tid = wave * 64 + lane; (void)tid;
        const float* x = A->in[0];
        float* modf = (float*)(A->ws + WS_MODF);
        bf16* ubuf = (bf16*)((unsigned char*)A->out + DO_U);

        for (int blk = gw; blk < MTOK / 16; blk += NGW) {
            const int bb = (blk * 16) / SEQ; f32x4 sc4[4], sh4[4];
#pragma unroll
            for (int j = 0; j < 4; ++j) { sh4[j] = *(const GAS f32x4*)(modf + bb * 3072 + 256 * j + 4 * lane); sc4[j] = *(const GAS f32x4*)(modf + bb * 3072 + 1024 + 256 * j + 4 * lane) + 1.0f; }
            for (int rr = 0; rr < 16; ++rr) { const size_t row = (size_t)blk * 16 + rr;
                const GAS f32x4* xr = (const GAS f32x4*)(x + row * DM) + lane; GAS unsigned long long* o8 = (GAS unsigned long long*)(ubuf + row * DM) + lane;
#pragma unroll
                for (int j = 0; j < 4; ++j) { const f32x4 v = xr[64 * j] * sc4[j] + sh4[j]; o8[64 * j] = (unsigned long long)pk2(v.x, v.y) | ((unsigned long long)pk2(v.z, v.w) << 32); } }
        }
    }
    SEAM(1);
    if (IN(2)) {
        KArgs A = kargs(); const int lane = lane_id(), tid = wave * 64 + lane; (void)tid;
        bf16* ubuf = (bf16*)((unsigned char*)A->out + DO_U);
        bf16* win_t = (bf16*)(A->ws + WS_WIN);
        bf16* rxb = (bf16*)((unsigned char*)A->out + DO_RX);
        bf16* ya = (bf16*)(A->ws + WS_YA);
        bf16* qbuf = (bf16*)(A->ws + WS_Q);
        bf16* kbuf = (bf16*)(A->ws + WS_K);
        bf16* vbuf = (bf16*)(A->ws + WS_V);
        bf16* mgb = (bf16*)(A->ws + WS_MG);

        pg8::Gemm g{ubuf, win_t, MTOK, NIN, DM}; pg8::StaticOrder S; S.init(MTOK, NIN, G, (int)blockIdx.x);
        pg8::EpiProjV E{A->ws, (unsigned char*)A->out};
        pg8::gemm_phase<pg8::EpiProjV, pg8::StaticOrder, MK_ALIGN, MK_SP2>(lds + RING_OFF, g, S, E, tid);
    }
    SEAM(2);
    if (IN(3)) {
        KArgs A = kargs(); const int lane = lane_id(), tid = wave * 64 + lane; (void)tid;
        bf16* rxb = (bf16*)((unsigned char*)A->out + DO_RX);
        bf16* ya = (bf16*)(A->ws + WS_YA);
        const float* conv_w = A->in[5];
        const float* conv_b = A->in[6];
        const float* w_rg_a = A->in[7];
        const float* b_rg_a = A->in[8];
        const float* w_rg_x = A->in[9];
        const float* b_rg_x = A->in[10];
        const float* lru_lambda = A->in[11];
 if (G == 256) rnn_phase(lds, vcu, lane, wave, rxb, ya, conv_w, conv_b, w_rg_a, b_rg_a, w_rg_x, b_rg_x, lru_lambda); }
    SEAM(3);
    if (IN(4)) {
        KArgs A = kargs(); const int lane = lane_id(), tid = wave * 64 + lane; (void)tid;
        bf16* qbuf = (bf16*)(A->ws + WS_Q);
        bf16* kbuf = (bf16*)(A->ws + WS_K);
        bf16* vbuf = (bf16*)(A->ws + WS_V);
        bf16* o0 = (bf16*)((unsigned char*)A->out + DO_O0);
        bf16* o1 = (bf16*)((unsigned char*)A->out + DO_O1);
        const float* rel_bias = A->in[17];
 if (G == 256) { for (int rep_ = 0; rep_ < MK_DUP_ATTN; ++rep_) attn_phase_diff(lds_, lds, vcu, tid, wave, qbuf, kbuf, vbuf, o0, o1, rel_bias); } }
    SEAM(4);
    if (IN(5)) {
        KArgs A = kargs(); const int lane = lane_id(), tid = wave * 64 + lane; (void)tid;
        const float* lq1 = A->in[12];
        const float* lk1 = A->in[13];
        const float* lq2 = A->in[14];
        const float* lk2 = A->in[15];
        const float* subln_w = A->in[16];
        bf16* o0 = (bf16*)((unsigned char*)A->out + DO_O0);
        bf16* o1 = (bf16*)((unsigned char*)A->out + DO_O1);
        bf16* ya = (bf16*)(A->ws + WS_YA);

        float s1 = lq1[lane] * lk1[lane], s2 = lq2[lane] * lk2[lane]; s1 = wave_sum(s1); s2 = wave_sum(s2);
        const float lamv = __expf(s1) - __expf(s2) + 0.2f;
        float sw[16];
#pragma unroll
        for (int i = 0; i < 16; ++i) sw[i] = subln_w[(lane * 16 + i) & 127] * 0.8f;
        for (int row = gw; row < MTOK; row += NGW) {
            const GAS v4u* p0 = (const GAS v4u*)(o0 + (size_t)row * 1024 + lane * 16); const GAS v4u* p1 = (const GAS v4u*)(o1 + (size_t)row * 1024 + lane * 16);
            GAS v4u* pa = (GAS v4u*)(ya + (size_t)row * 2048 + 1024 + lane * 16);
            float v[16]; float ss = 0.f; v4u agv[2];
#pragma unroll
            for (int hh = 0; hh < 2; ++hh) { const v4u a = p0[hh], bq = p1[hh]; agv[hh] = pa[hh];
                const unsigned aw[4] = {a.x, a.y, a.z, a.w}, bw[4] = {bq.x, bq.y, bq.z, bq.w};
#pragma unroll
                for (int e = 0; e < 4; ++e) { v[hh * 8 + 2 * e] = __uint_as_float(aw[e] << 16) - lamv * __uint_as_float(bw[e] << 16); v[hh * 8 + 2 * e + 1] = __uint_as_float(aw[e] & 0xffff0000u) - lamv * __uint_as_float(bw[e] & 0xffff0000u); } }
#pragma unroll
            for (int i = 0; i < 16; ++i) ss += v[i] * v[i];
            ss += __shfl_xor(ss, 1); ss += __shfl_xor(ss, 2); ss += __shfl_xor(ss, 4);
            const float rs = rsqrtf(ss * (1.f / 128.f) + LN_EPS);
#pragma unroll
            for (int hh = 0; hh < 2; ++hh) { const unsigned gwd[4] = {agv[hh].x, agv[hh].y, agv[hh].z, agv[hh].w}; v4u o;
                unsigned ow[4];
#pragma unroll
                for (int e = 0; e < 4; ++e) { const int i = hh * 8 + 2 * e; ow[e] = pk2(v[i] * rs * sw[i] * __uint_as_float(gwd[e] << 16), v[i + 1] * rs * sw[i + 1] * __uint_as_float(gwd[e] & 0xffff0000u)); }
                o.x = ow[0]; o.y = ow[1]; o.z = ow[2]; o.w = ow[3]; pa[hh] = o; }
        }
    }
    SEAM(5);
    if (IN(6)) {
        KArgs A = kargs(); const int lane = lane_id(), tid = wave * 64 + lane; (void)tid;
        bf16* ya = (bf16*)(A->ws + WS_YA);
        bf16* wcat_t = (bf16*)(A->ws + WS_WCAT);
        bf16* mgb = (bf16*)(A->ws + WS_MG);
        bf16* merged = (bf16*)(A->ws + WS_Q);

        pg8::Gemm g{ya, wcat_t, MTOK, DM, 2048}; pg8::StaticOrder S; S.init(MTOK, DM, G, (int)blockIdx.x);
        pg8::EpiMergeV E{mgb, merged};
        pg8::gemm_phase<pg8::EpiMergeV, pg8::StaticOrder, MK_ALIGN, MK_SP2>(lds + RING_OFF, g, S, E, tid);
    }
    SEAM(6);
    if (IN(7)) {
        KArgs A = kargs(); const int lane = lane_id(), tid = wave * 64 + lane; (void)tid;
        bf16* merged = (bf16*)(A->ws + WS_Q);
        bf16* wout_t = (bf16*)(A->ws + WS_WOUT);
        const float* x = A->in[0];
        float* modf = (float*)(A->ws + WS_MODF);
        float* outp = A->out;

        pg8::Gemm g{merged, wout_t, MTOK, DM, DM}; pg8::StaticOrder S; S.init(MTOK, DM, G, (int)blockIdx.x);
        pg8::EpiOutV E{x, modf, outp};
        pg8::gemm_phase<pg8::EpiOutV, pg8::StaticOrder, MK_ALIGN, MK_SP2>(lds + RING_OFF, g, S, E, tid);
    }
    SEAM(7);
    if (IN(8)) {
        KArgs A = kargs(); const int lane = lane_id(), tid = wave * 64 + lane; (void)tid;
        const float* ln_g = A->in[21];
        const float* ln_b = A->in[22];
        float* outp = A->out;

        f32x4 gg[4], bb[4];
#pragma unroll
        for (int j = 0; j < 4; ++j) { gg[j] = *(const GAS f32x4*)(ln_g + 256 * j + 4 * lane); bb[j] = *(const GAS f32x4*)(ln_b + 256 * j + 4 * lane); }
        for (int row = gw; row < MTOK; row += NGW) {
            GAS f32x4* p = (GAS f32x4*)(outp + (size_t)row * DM) + lane; f32x4 v[4]; float s = 0.f;
#pragma unroll
            for (int j = 0; j < 4; ++j) { v[j] = p[64 * j]; s += (v[j].x + v[j].y) + (v[j].z + v[j].w); }
            const float mean = wave_sum(s) * (1.f / DM); float s2 = 0.f;
#pragma unroll
            for (int j = 0; j < 4; ++j) { v[j] = v[j] - mean; s2 += (v[j].x * v[j].x + v[j].y * v[j].y) + (v[j].z * v[j].z + v[j].w * v[j].w); }
            const float rstd = rsqrtf(wave_sum(s2) * (1.f / DM) + LN_EPS);
#pragma unroll
            for (int j = 0; j < 4; ++j) p[64 * j] = v[j] * rstd * gg[j] + bb[j];
        }
    }
#undef IN
#undef SEAM
}

#ifndef MK_STEP
#define MK_STEP 4
#define MK_C0 6144
#define MK_C1 7168
#endif
extern "C" void kernel_launch(void* const* d_in, const int* in_sizes, int n_in, void* d_out, int out_size, void* d_ws, size_t ws_size, hipStream_t stream) {
    static int grid = 0;
    if (grid == 0) {
        if (n_in != 23 || out_size != MTOK * DM || ws_size < WS_END) { fprintf(stderr, "kernel_launch: unexpected shapes (n_in %d out %d ws %zu)\n", n_in, out_size, ws_size); grid = -1; return; }
        int dev = 0, cus = 0;
        if (hipGetDevice(&dev) != hipSuccess || hipDeviceGetAttribute(&cus, hipDeviceAttributeMultiprocessorCount, dev) != hipSuccess) { grid = -1; return; }
        if (hipFuncSetAttribute((const void*)mk_fwd, hipFuncAttributeMaxDynamicSharedMemorySize, LDS_BYTES) != hipSuccess) { fprintf(stderr, "kernel_launch: hipFuncSetAttribute failed\n"); grid = -1; return; }
        (void)hipGetLastError();
        grid = cus;
        if (grid != 256) { fprintf(stderr, "kernel_launch: built for 256 CUs, found %d\n", grid); }
    }
    if (grid < 0) return;
    (void)hipMemsetAsync((char*)d_ws + WS_CTL, 0, CTL_ZERO_BYTES, stream);
    Args a{};
    for (int i = 0; i < 23; ++i) a.in[i] = (const float*)d_in[i];
    a.out = (float*)d_out; a.ws = (unsigned char*)d_ws;
#define MK_RUN(lo_, hi_) do { a.ph_lo = (lo_); a.ph_hi = (hi_); hipLaunchKernelGGL(mk_fwd, dim3(grid), dim3(NWAVES * 64), LDS_BYTES, stream, a); } while (0)
    unsigned char* ws = (unsigned char*)d_ws; unsigned char* dob = (unsigned char*)d_out;
    bf16_t* ya = (bf16_t*)(ws + WS_YA); bf16_t* qb = (bf16_t*)(ws + WS_Q); bf16_t* kb = (bf16_t*)(ws + WS_K); bf16_t* vb = (bf16_t*)(ws + WS_V);
    bf16_t* rx = (bf16_t*)(dob + DO_RX); bf16_t* o0 = (bf16_t*)(dob + DO_O0); bf16_t* o1 = (bf16_t*)(dob + DO_O1);
    const float* conv_w = (const float*)d_in[5]; const float* conv_b = (const float*)d_in[6];
    const float* w_rg_a = (const float*)d_in[7]; const float* b_rg_a = (const float*)d_in[8]; const float* w_rg_x = (const float*)d_in[9]; const float* b_rg_x = (const float*)d_in[10];
    const float* lru_lambda = (const float*)d_in[11]; const float* lq1 = (const float*)d_in[12]; const float* lk1 = (const float*)d_in[13]; const float* lq2 = (const float*)d_in[14]; const float* lk2 = (const float*)d_in[15];
    const float* subln_w = (const float*)d_in[16]; const float* rel_bias = (const float*)d_in[17]; const float* ln_g = (const float*)d_in[21]; const float* ln_b = (const float*)d_in[22];
#if MK_STEP == 1
    MK_RUN(0, 1); MK_RUN(1, 2); MK_RUN(2, 3);
    k_rnn_simple<<<NB * 16, 64, 0, stream>>>(rx, ya, conv_w, conv_b, w_rg_a, b_rg_a, w_rg_x, b_rg_x, lru_lambda);
    k_attn_simple<<<NB * 8 * 2 * 32, 256, 0, stream>>>(qb, kb, vb, o0, o1, rel_bias);
    k_combine<<<MTOK / 4, 256, 0, stream>>>(o0, o1, ya, lq1, lk1, lq2, lk2, subln_w);
    MK_RUN(6, 7); MK_RUN(7, 8);
    k_ln<<<MTOK / 4, 256, 0, stream>>>((float*)d_out, ln_g, ln_b);
#elif MK_STEP == 11
    MK_RUN(0, 1); MK_RUN(1, 2); MK_RUN(2, 3);
    k_rnn_simple<<<NB * 16, 64, 0, stream>>>(rx, ya, conv_w, conv_b, w_rg_a, b_rg_a, w_rg_x, b_rg_x, lru_lambda);
    k_attn_simple<<<NB * 8 * 2 * 32, 256, 0, stream>>>(qb, kb, vb, o0, o1, rel_bias);
    k_combine<<<MTOK / 4, 256, 0, stream>>>(o0, o1, ya, lq1, lk1, lq2, lk2, subln_w);
    { EpiMerge e{(bf16_t*)(ws + WS_MG), qb}; k_gemm_simple<EpiMerge, true><<<dim3(DM / 64, MTOK / 64), 256, 0, stream>>>(ya, (bf16_t*)(ws + WS_WCAT), MTOK, DM, 2048, e); }
    { EpiOut e{(const float*)d_in[0], (const float*)(ws + WS_MODF), (float*)d_out}; k_gemm_simple<EpiOut, false><<<dim3(DM / 64, MTOK / 64), 256, 0, stream>>>(qb, (bf16_t*)(ws + WS_WOUT), MTOK, DM, DM, e); }
    k_ln<<<MTOK / 4, 256, 0, stream>>>((float*)d_out, ln_g, ln_b);
#elif MK_STEP == 12 || MK_STEP == 13
    MK_RUN(0, 1);
#if MK_STEP == 13
    MK_RUN(1, 2);
#else
    k_u<<<(unsigned)(((size_t)MTOK * DM + 255) / 256), 256, 0, stream>>>((const float*)d_in[0], (const float*)(ws + WS_MODF), (bf16_t*)(dob + DO_U));
#endif
    { EpiProj e{rx, ya, qb, kb, vb, (bf16_t*)(ws + WS_MG)}; k_gemm_simple<EpiProj, false><<<dim3(NIN / 64, MTOK / 64), 256, 0, stream>>>((bf16_t*)(dob + DO_U), (bf16_t*)(ws + WS_WIN), MTOK, NIN, DM, e); }
    k_rnn_simple<<<NB * 16, 64, 0, stream>>>(rx, ya, conv_w, conv_b, w_rg_a, b_rg_a, w_rg_x, b_rg_x, lru_lambda);
    k_attn_simple<<<NB * 8 * 2 * 32, 256, 0, stream>>>(qb, kb, vb, o0, o1, rel_bias);
    k_combine<<<MTOK / 4, 256, 0, stream>>>(o0, o1, ya, lq1, lk1, lq2, lk2, subln_w);
    { EpiMerge e{(bf16_t*)(ws + WS_MG), qb}; k_gemm_simple<EpiMerge, true><<<dim3(DM / 64, MTOK / 64), 256, 0, stream>>>(ya, (bf16_t*)(ws + WS_WCAT), MTOK, DM, 2048, e); }
    { EpiOut e{(const float*)d_in[0], (const float*)(ws + WS_MODF), (float*)d_out}; k_gemm_simple<EpiOut, false><<<dim3(DM / 64, MTOK / 64), 256, 0, stream>>>(qb, (bf16_t*)(ws + WS_WOUT), MTOK, DM, DM, e); }
    k_ln<<<MTOK / 4, 256, 0, stream>>>((float*)d_out, ln_g, ln_b);
#elif MK_STEP == 14
    MK_RUN(0, 1); MK_RUN(1, 2);
    { EpiProj e{rx, ya, qb, kb, vb, (bf16_t*)(ws + WS_MG)}; k_gemm_simple<EpiProj, false><<<dim3(NIN / 64, MTOK / 64), 256, 0, stream>>>((bf16_t*)(dob + DO_U), (bf16_t*)(ws + WS_WIN), MTOK, NIN, DM, e); }
    k_rnn_simple<<<NB * 16, 64, 0, stream>>>(rx, ya, conv_w, conv_b, w_rg_a, b_rg_a, w_rg_x, b_rg_x, lru_lambda);
    k_attn_simple<<<NB * 8 * 2 * 32, 256, 0, stream>>>(qb, kb, vb, o0, o1, rel_bias);
    k_combine<<<MTOK / 4, 256, 0, stream>>>(o0, o1, ya, lq1, lk1, lq2, lk2, subln_w);
    MK_RUN(6, 7); MK_RUN(7, 8);
    k_ln<<<MTOK / 4, 256, 0, stream>>>((float*)d_out, ln_g, ln_b);
#elif MK_STEP == 15
    MK_RUN(0, 1); MK_RUN(1, 2); MK_RUN(2, 3);
    { EpiProj e{rx, ya, qb, kb, vb, (bf16_t*)(ws + WS_MG)}; k_gemm_simple<EpiProj, false><<<dim3((MK_C1 - MK_C0) / 64, MTOK / 64), 256, 0, stream>>>((bf16_t*)(dob + DO_U), (bf16_t*)(ws + WS_WIN), MTOK, NIN, DM, e, MK_C0 / 64); }
    k_rnn_simple<<<NB * 16, 64, 0, stream>>>(rx, ya, conv_w, conv_b, w_rg_a, b_rg_a, w_rg_x, b_rg_x, lru_lambda);
    k_attn_simple<<<NB * 8 * 2 * 32, 256, 0, stream>>>(qb, kb, vb, o0, o1, rel_bias);
    k_combine<<<MTOK / 4, 256, 0, stream>>>(o0, o1, ya, lq1, lk1, lq2, lk2, subln_w);
    MK_RUN(6, 7); MK_RUN(7, 8);
    k_ln<<<MTOK / 4, 256, 0, stream>>>((float*)d_out, ln_g, ln_b);
#elif MK_STEP == 2
    MK_RUN(0, 1); MK_RUN(1, 2); MK_RUN(2, 3);
    k_rnn_simple<<<NB * 16, 64, 0, stream>>>(rx, ya, conv_w, conv_b, w_rg_a, b_rg_a, w_rg_x, b_rg_x, lru_lambda);
    MK_RUN(4, 5); MK_RUN(5, 6); MK_RUN(6, 7); MK_RUN(7, 8); MK_RUN(8, 9);
#elif MK_STEP == 3
    for (int p = 0; p < N_PHASES; ++p) MK_RUN(p, p + 1);
#else
    MK_RUN(0, N_PHASES);
#endif
}
```

```cpp
#include <hip/hip_runtime.h>
#include <cstdio>
#include <cstdint>
#include <cmath>

typedef unsigned short bf16_t;
#ifndef MK_ROT
#define MK_ROT 8
#endif
constexpr int NB = 4, SEQ = 8192, DM = 1024, MTOK = NB * SEQ, NIN = 8192;
constexpr float LN_EPS = 1e-5f;
constexpr float ALPHA = 1.189207115002721f;
constexpr float LOG2E = 1.4426950408889634f;
constexpr float C2 = 0.125f * LOG2E;

__device__ __forceinline__ float bf2f_(bf16_t v) { return __uint_as_float(((unsigned)v) << 16); }
__device__ __forceinline__ bf16_t f2bf_(float f) { unsigned u = __float_as_uint(f); return (bf16_t)((u + 0x7fffu + ((u >> 16) & 1u)) >> 16); }
__device__ __forceinline__ float sigmoidf_(float x) { return 1.f / (1.f + __expf(-x)); }
__device__ __forceinline__ float siluf_(float x) { return x / (1.f + __expf(-x)); }

constexpr size_t MiB = 1u << 20;
constexpr size_t WS_CTL = 0;
constexpr size_t WS_MODF = 1 * MiB + 512 * 1024;
constexpr size_t CTL_ZERO_BYTES = 512 * 1024;
constexpr size_t WS_ZERO = 1024;
constexpr size_t WS_WIN = 2 * MiB;
constexpr size_t WS_WCAT = 18 * MiB;
constexpr size_t WS_WOUT = 22 * MiB;
constexpr size_t WS_YA = 24 * MiB;
constexpr size_t WS_Q = 152 * MiB;
constexpr size_t WS_K = 216 * MiB;
constexpr size_t WS_V = 280 * MiB;
constexpr size_t WS_MG = 344 * MiB;
constexpr size_t WS_END = 472 * MiB;
constexpr size_t DO_U = 0, DO_RX = 64 * MiB, DO_O0 = 0, DO_O1 = 64 * MiB;

__global__ void k_mod(const float* __restrict__ c, const float* __restrict__ w_ada, const float* __restrict__ b_ada, float* __restrict__ modf) {
    const int idx = blockIdx.x * blockDim.x + threadIdx.x; if (idx >= NB * 3072) return;
    const int b = idx / 3072, e = idx % 3072; float acc = 0.f;
    for (int k = 0; k < DM; ++k) acc += siluf_(c[b * DM + k]) * w_ada[(size_t)k * 3072 + e];
    modf[idx] = acc + b_ada[e];
}
__global__ void k_u(const float* __restrict__ x, const float* __restrict__ modf, bf16_t* __restrict__ u) {
    const size_t idx = (size_t)blockIdx.x * blockDim.x + threadIdx.x; if (idx >= (size_t)MTOK * DM) return;
    const int d = (int)(idx % DM); const int b = (int)(idx / ((size_t)SEQ * DM));
    u[idx] = f2bf_(x[idx] * (1.f + modf[b * 3072 + 1024 + d]) + modf[b * 3072 + d]);
}
__global__ void k_transpose(const float* __restrict__ W, int K, int N, bf16_t* __restrict__ WT, int ldt, int koff) {
    const size_t idx = (size_t)blockIdx.x * blockDim.x + threadIdx.x; if (idx >= (size_t)K * N) return;
    const int k = (int)(idx / N), n = (int)(idx % N);
    WT[(size_t)n * ldt + koff + k] = f2bf_(W[idx]);
}

struct EpiProj {
    bf16_t *rx, *ya, *q, *k, *v, *mg;
    __device__ __forceinline__ void mid(int, int, float&) const {}
    __device__ __forceinline__ void operator()(int m, int n, float a) const {
        const int g = n >> 10, c = n & 1023;
        if (g == 0) rx[(size_t)m * 1024 + c] = f2bf_(a);
        else if (g == 1) ya[(size_t)m * 2048 + c] = f2bf_(siluf_(a));
        else if (g == 2) q[(size_t)m * 1024 + c] = f2bf_(a * C2);
        else if (g == 3) k[(size_t)m * 1024 + c] = f2bf_(a);
        else if (g == 4) v[(size_t)m * 1024 + c] = f2bf_(a);
        else if (g == 5) ya[(size_t)m * 2048 + 1024 + c] = f2bf_(siluf_(a));
        else mg[(size_t)m * 2048 + (n - 6144)] = f2bf_(sigmoidf_(a));
    }
};
struct EpiMerge {
    const bf16_t* mg; bf16_t* merged;
    __device__ __forceinline__ void mid(int m, int n, float& a) const { a *= bf2f_(mg[(size_t)m * 2048 + n]) / bf2f_(mg[(size_t)m * 2048 + 1024 + n]); }
    __device__ __forceinline__ void operator()(int m, int n, float a) const { merged[(size_t)m * 1024 + n] = f2bf_(a * bf2f_(mg[(size_t)m * 2048 + 1024 + n])); }
};
struct EpiOut {
    const float* x; const float* modf; float* z;
    __device__ __forceinline__ void mid(int, int, float&) const {}
    __device__ __forceinline__ void operator()(int m, int n, float a) const { const int b = m / SEQ; z[(size_t)m * 1024 + n] = ALPHA * x[(size_t)m * 1024 + n] + modf[b * 3072 + 2048 + n] * a; }
};

template <class Epi, bool MID>
__global__ void __launch_bounds__(256) k_gemm_simple(const bf16_t* __restrict__ A, const bf16_t* __restrict__ Bt, int M, int N, int K, Epi epi, int nblk0 = 0) {
    __shared__ float As[16][68], Bs[16][68];
    const int tid = threadIdx.x, tx = tid & 15, ty = tid >> 4;
    const int m0 = blockIdx.y * 64, n0 = (blockIdx.x + nblk0) * 64;
    float acc[4][4];
#pragma unroll
    for (int i = 0; i < 4; ++i)
#pragma unroll
        for (int j = 0; j < 4; ++j) acc[i][j] = 0.f;
    for (int k0 = 0; k0 < K; k0 += 16) {
        if (MID && k0 == K / 2) {
#pragma unroll
            for (int i = 0; i < 4; ++i)
#pragma unroll
                for (int j = 0; j < 4; ++j) epi.mid(m0 + ty * 4 + i, n0 + tx * 4 + j, acc[i][j]);
        }
#pragma unroll
        for (int e = 0; e < 4; ++e) {
            const int idx = tid + e * 256, r = idx >> 4, kk = idx & 15;
            As[kk][r] = bf2f_(A[(size_t)(m0 + r) * K + k0 + kk]);
            Bs[kk][r] = bf2f_(Bt[(size_t)(n0 + r) * K + k0 + kk]);
        }
        __syncthreads();
#pragma unroll
        for (int kk = 0; kk < 16; ++kk) {
            float a[4], b[4];
#pragma unroll
            for (int i = 0; i < 4; ++i) { a[i] = As[kk][ty * 4 + i]; b[i] = Bs[kk][tx * 4 + i]; }
#pragma unroll
            for (int i = 0; i < 4; ++i)
#pragma unroll
                for (int j = 0; j < 4; ++j) acc[i][j] += a[i] * b[j];
        }
        __syncthreads();
    }
#pragma unroll
    for (int i = 0; i < 4; ++i)
#pragma unroll
        for (int j = 0; j < 4; ++j) epi(m0 + ty * 4 + i, n0 + tx * 4 + j, acc[i][j]);
}

__global__ void __launch_bounds__(64) k_rnn_simple(const bf16_t* __restrict__ rx, bf16_t* __restrict__ ya, const float* __restrict__ conv_w, const float* __restrict__ conv_b,
                                                   const float* __restrict__ w_a, const float* __restrict__ b_a, const float* __restrict__ w_x, const float* __restrict__ b_x, const float* __restrict__ lam) {
    __shared__ float xs[64];
    const int b = blockIdx.x / 16, hb = blockIdx.x % 16, j = threadIdx.x, ch = hb * 64 + j;
    float wa[64], wx[64];
#pragma unroll
    for (int i = 0; i < 64; ++i) { wa[i] = w_a[(size_t)hb * 4096 + i * 64 + j]; wx[i] = w_x[(size_t)hb * 4096 + i * 64 + j]; }
    const float cw0 = conv_w[ch], cw1 = conv_w[1024 + ch], cw2 = conv_w[2048 + ch], cw3 = conv_w[3072 + ch], cb = conv_b[ch];
    const float ba = b_a[ch], bx = b_x[ch];
    const float L = lam[ch]; const float sp = log1pf(expf(-L));
    const float logu = -8.0f * sp;
    float x1 = 0.f, x2 = 0.f, x3 = 0.f, h = 0.f;
    for (int t = 0; t < SEQ; ++t) {
        const size_t row = (size_t)b * SEQ + t;
        const float x0 = bf2f_(rx[row * 1024 + ch]);
        const float xc = cw0 * x3 + cw1 * x2 + cw2 * x1 + cw3 * x0 + cb;
        x3 = x2; x2 = x1; x1 = x0;
        __syncthreads(); xs[j] = xc; __syncthreads();
        float ra = ba, ri = bx;
#pragma unroll
        for (int i = 0; i < 64; ++i) { const float xv = xs[i]; ra += xv * wa[i]; ri += xv * wx[i]; }
        const float r = sigmoidf_(ra), ig = sigmoidf_(ri);
        const float la = r * logu; const float a = expf(la); const float bin = sqrtf(-expm1f(2.f * la)) * (ig * xc);
        h = a * h + bin;
        const size_t o = row * 2048 + ch;
        ya[o] = f2bf_(h * bf2f_(ya[o]));
    }
}

__device__ __forceinline__ int t5_bucket(int n) {
    if (n < 16) return n;
    int l = 16 + (int)(logf((float)n / 16.0f) / 2.0794415416798357f * 16.0f);
    return l < 31 ? l : 31;
}
__global__ void __launch_bounds__(256) k_attn_simple(const bf16_t* __restrict__ Q, const bf16_t* __restrict__ K, const bf16_t* __restrict__ V, bf16_t* __restrict__ O0, bf16_t* __restrict__ O1, const float* __restrict__ rel_bias) {
    __shared__ float tab[128];
    const int qb = blockIdx.x % 32, c = (blockIdx.x / 32) % 2, h = (blockIdx.x / 64) % 8, b = blockIdx.x / 512;
    if (threadIdx.x < 128) tab[threadIdx.x] = rel_bias[t5_bucket(threadIdx.x) * 8 + h] * LOG2E;
    __syncthreads();
    const float far = rel_bias[31 * 8 + h] * LOG2E;
    const int qi = qb * 256 + threadIdx.x; const size_t rowq = (size_t)b * SEQ + qi;
    float q[64], o[128];
#pragma unroll
    for (int d = 0; d < 64; ++d) q[d] = bf2f_(Q[rowq * 1024 + h * 128 + c * 64 + d]);
#pragma unroll
    for (int e = 0; e < 128; ++e) o[e] = 0.f;
    float m = -INFINITY, l = 0.f;
    const int kend = qb * 256 + 255;
    for (int kk = 0; kk <= kend; ++kk) {
        const size_t rowk = (size_t)b * SEQ + kk;
        const bf16_t* kp = K + rowk * 1024 + h * 128 + c * 64;
        float s = 0.f;
#pragma unroll
        for (int d = 0; d < 64; ++d) s += q[d] * bf2f_(kp[d]);
        const int n = qi - kk;
        if (n >= 0) {
            s += (n < 128) ? tab[n] : far;
            if (s > m) { const float f = exp2f(m - s); l *= f;
#pragma unroll
                for (int e = 0; e < 128; ++e) o[e] *= f;
                m = s; }
            const float p = exp2f(s - m); l += p;
            const bf16_t* vp = V + rowk * 1024 + h * 128;
#pragma unroll
            for (int e = 0; e < 128; ++e) o[e] += p * bf2f_(vp[e]);
        }
    }
    bf16_t* Op = (c == 0 ? O0 : O1) + rowq * 1024 + h * 128; const float il = 1.f / l;
#pragma unroll
    for (int e = 0; e < 128; ++e) Op[e] = f2bf_(o[e] * il);
}

__global__ void __launch_bounds__(256) k_combine(const bf16_t* __restrict__ O0, const bf16_t* __restrict__ O1, bf16_t* __restrict__ ya, const float* __restrict__ lq1, const float* __restrict__ lk1,
                                                 const float* __restrict__ lq2, const float* __restrict__ lk2, const float* __restrict__ subw) {
    const int lane = threadIdx.x & 63, row = blockIdx.x * 4 + (threadIdx.x >> 6);
    float s1 = lq1[lane] * lk1[lane], s2 = lq2[lane] * lk2[lane];
#pragma unroll
    for (int o = 1; o < 64; o <<= 1) { s1 += __shfl_xor(s1, o); s2 += __shfl_xor(s2, o); }
    const float lam = expf(s1) - expf(s2) + 0.2f;
    const int col = lane * 16;
    float v[16]; float ss = 0.f;
#pragma unroll
    for (int i = 0; i < 16; ++i) { v[i] = bf2f_(O0[(size_t)row * 1024 + col + i]) - lam * bf2f_(O1[(size_t)row * 1024 + col + i]); ss += v[i] * v[i]; }
    ss += __shfl_xor(ss, 1); ss += __shfl_xor(ss, 2); ss += __shfl_xor(ss, 4);
    const float rs = rsqrtf(ss * (1.f / 128.f) + LN_EPS) * 0.8f;
#pragma unroll
    for (int i = 0; i < 16; ++i) { const size_t o = (size_t)row * 2048 + 1024 + col + i; ya[o] = f2bf_(v[i] * rs * subw[(col + i) & 127] * bf2f_(ya[o])); }
}

__global__ void __launch_bounds__(256) k_ln(float* __restrict__ z, const float* __restrict__ g, const float* __restrict__ bta) {
    const int lane = threadIdx.x & 63, row = blockIdx.x * 4 + (threadIdx.x >> 6);
    float4* p = (float4*)(z + (size_t)row * 1024) + lane; float4 v[4]; float s = 0.f;
#pragma unroll
    for (int j = 0; j < 4; ++j) { v[j] = p[64 * j]; s += (v[j].x + v[j].y) + (v[j].z + v[j].w); }
#pragma unroll
    for (int o = 1; o < 64; o <<= 1) s += __shfl_xor(s, o);
    const float mean = s * (1.f / 1024.f); float q = 0.f;
#pragma unroll
    for (int j = 0; j < 4; ++j) { v[j].x -= mean; v[j].y -= mean; v[j].z -= mean; v[j].w -= mean; q += (v[j].x * v[j].x + v[j].y * v[j].y) + (v[j].z * v[j].z + v[j].w * v[j].w); }
#pragma unroll
    for (int o = 1; o < 64; o <<= 1) q += __shfl_xor(q, o);
    const float rstd = rsqrtf(q * (1.f / 1024.f) + LN_EPS);
#pragma unroll
    for (int j = 0; j < 4; ++j) { const float4 gg = ((const float4*)g)[lane + 64 * j], bb = ((const float4*)bta)[lane + 64 * j];
        float4 o; o.x = v[j].x * rstd * gg.x + bb.x; o.y = v[j].y * rstd * gg.y + bb.y; o.z = v[j].z * rstd * gg.z + bb.z; o.w = v[j].w * rstd * gg.w + bb.w; p[64 * j] = o; }
}

namespace pg8 {
#define PG8_LAS __attribute__((address_space(3)))
typedef unsigned short bf16_t;
typedef short bf16x8 __attribute__((ext_vector_type(8)));
typedef float f32x4 __attribute__((ext_vector_type(4)));
typedef unsigned u32x4 __attribute__((ext_vector_type(4)));
constexpr int BM = 256, BK = 64, HALF = 128, HTB = HALF * BK * 2  , STAGE_BYTES = 8 * HTB, NXCD = 8, WGM = 8;

__host__ __device__ __forceinline__ int lds_byte(int r, int c) { const int st = (r >> 4) * 2 + (c >> 5), rr = r & 15, cc = c & 31, ob = rr * 64 + cc * 2; return st * 1024 + (ob ^ (((ob >> 9) & 1) << 5)); }
__host__ __device__ __forceinline__ void stage_rc(int b, int& R, int& C) { const int st = b / 1024, sb = b % 1024, swz = sb ^ (((sb >> 9) & 1) << 5); R = (st >> 1) * 16 + swz / 64; C = (st & 1) * 32 + (swz % 64) / 2; }
__host__ __device__ __forceinline__ int perm32(int rho) { const int n = rho >> 4, i = rho & 15; return 8 * (i >> 2) + 4 * n + (i & 3); }

struct Unit { int pm, pn; };
struct Gemm { const bf16_t* A; const bf16_t* Bt; int M, N, K; };

struct StaticOrder {
    int nM, nN, nwg, G, c;
    __host__ __device__ void init(int M, int N, int G_, int c_) { nM = M / BM; nN = N / BM; nwg = nM * nN; G = G_; c = c_; }
    __host__ __device__ bool next(int i, Unit& u) const {
        const long L = (long)i * G + c; if (L >= nwg) return false;
        int wgid = (int)L; { const int q = nwg / NXCD, r = nwg % NXCD, xcd = wgid % NXCD, off = wgid / NXCD; wgid = (xcd < r ? xcd * (q + 1) : r * (q + 1) + (xcd - r) * q) + off; }
        const int nig = WGM * nN, gid = wgid / nig, fm = gid * WGM, gsz = (nM - fm) < WGM ? (nM - fm) : WGM;
        u.pm = fm + ((wgid % nig) % gsz); u.pn = (wgid % nig) / gsz; return true;
    }
    __device__ __forceinline__ void a_ready(const Unit&) const {}
    __device__ __forceinline__ void done(const Unit&) const {}
};


typedef float f32x2_cv __attribute__((ext_vector_type(2))); typedef __bf16 bf16x2_cv __attribute__((ext_vector_type(2)));
__device__ __forceinline__ unsigned cvt_pk_bf16(float lo, float hi) { f32x2_cv v = {lo, hi}; bf16x2_cv b = __builtin_convertvector(v, bf16x2_cv); return __builtin_bit_cast(unsigned, b); }
__device__ __forceinline__ float fast_sigmoid(float x) { return __builtin_amdgcn_rcpf(1.0f + __builtin_amdgcn_exp2f(-1.4426950408889634f * x)); }
__device__ __forceinline__ float bflo(unsigned w) { return __uint_as_float(w << 16); }
__device__ __forceinline__ float bfhi(unsigned w) { return __uint_as_float(w & 0xffff0000u); }

struct EpiProjV {
    static constexpr bool PERM = true, AFTER_DRAIN = false, HAS_MID = false;
    unsigned char* ws; unsigned char* dob;
    template <int ACT> __device__ __forceinline__ void run(const f32x4 (&acc)[2][2][4][2], bf16_t* base, int ldc, int row0, float sc) const {
#pragma unroll
        for (int ai = 0; ai < 2; ++ai)
#pragma unroll
            for (int m = 0; m < 4; ++m) { bf16_t* rowp = base + (size_t)(row0 + ai * HALF + m * 16) * ldc;
#pragma unroll
                for (int bj = 0; bj < 2; ++bj) { f32x4 v0 = acc[ai][bj][m][0], v1 = acc[ai][bj][m][1];
                    if (ACT == 0) { v0 = v0 * sc; v1 = v1 * sc; }
                    if (ACT == 1) {
#pragma unroll
                        for (int e = 0; e < 4; ++e) { v0[e] = v0[e] * fast_sigmoid(v0[e]); v1[e] = v1[e] * fast_sigmoid(v1[e]); } }
                    if (ACT == 2) {
#pragma unroll
                        for (int e = 0; e < 4; ++e) { v0[e] = fast_sigmoid(v0[e]); v1[e] = fast_sigmoid(v1[e]); } }
                    u32x4 w; w.x = cvt_pk_bf16(v0[0], v0[1]); w.y = cvt_pk_bf16(v0[2], v0[3]); w.z = cvt_pk_bf16(v1[0], v1[1]); w.w = cvt_pk_bf16(v1[2], v1[3]);
                    *(u32x4*)(rowp + bj * HALF) = w; } }
    }
    __device__ __forceinline__ void operator()(const f32x4 (&acc)[2][2][4][2], const Unit& u, int wr, int wc, int fr, int fq) const {
        const int g = u.pn >> 2, colt = (u.pn & 3) * BM + wc * 32 + 8 * fq; int row0 = u.pm * BM + wr * 64 + fr; asm volatile("" : "+v"(row0));
        const size_t goff = (g == 0) ? DO_RX : (g == 1) ? WS_YA : (g == 2) ? WS_Q : (g == 3) ? WS_K : (g == 4) ? WS_V : (g == 5) ? WS_YA + 2048 : (g == 6) ? WS_MG : WS_MG + 2048;
        bf16_t* base = (bf16_t*)((g == 0 ? dob : ws) + goff) + colt;
        const int ldc = (g == 1 || g >= 5) ? 2048 : 1024;
        if (g == 1 || g == 5) run<1>(acc, base, ldc, row0, 1.0f);
        else if (g >= 6) run<2>(acc, base, ldc, row0, 1.0f);
        else run<0>(acc, base, ldc, row0, g == 2 ? C2 : 1.0f);
    }
};

struct EpiMergeV {
    static constexpr bool PERM = true, AFTER_DRAIN = false, HAS_MID = true;
    const bf16_t* mg; bf16_t* merged;
    __device__ __forceinline__ void mid(f32x4 (&acc)[2][2][4][2], const Unit& u, int wr, int wc, int fr, int fq) const {
        const int col0 = u.pn * BM + wc * 32 + 8 * fq; int row0 = u.pm * BM + wr * 64 + fr; asm volatile("" : "+v"(row0));
#pragma unroll
        for (int ai = 0; ai < 2; ++ai)
#pragma unroll
            for (int m = 0; m < 4; ++m) { const bf16_t* rowp = mg + (size_t)(row0 + ai * HALF + m * 16) * 2048 + col0;
#pragma unroll
                for (int bj = 0; bj < 2; ++bj) { const u32x4 a = *(const u32x4*)(rowp + bj * HALF), b = *(const u32x4*)(rowp + 1024 + bj * HALF);
                    f32x4 r0, r1;
                    r0[0] = bflo(a.x) * __builtin_amdgcn_rcpf(bflo(b.x)); r0[1] = bfhi(a.x) * __builtin_amdgcn_rcpf(bfhi(b.x)); r0[2] = bflo(a.y) * __builtin_amdgcn_rcpf(bflo(b.y)); r0[3] = bfhi(a.y) * __builtin_amdgcn_rcpf(bfhi(b.y));
                    r1[0] = bflo(a.z) * __builtin_amdgcn_rcpf(bflo(b.z)); r1[1] = bfhi(a.z) * __builtin_amdgcn_rcpf(bfhi(b.z)); r1[2] = bflo(a.w) * __builtin_amdgcn_rcpf(bflo(b.w)); r1[3] = bfhi(a.w) * __builtin_amdgcn_rcpf(bfhi(b.w));
                    acc[ai][bj][m][0] = acc[ai][bj][m][0] * r0; acc[ai][bj][m][1] = acc[ai][bj][m][1] * r1; } }
    }
    __device__ __forceinline__ void operator()(const f32x4 (&acc)[2][2][4][2], const Unit& u, int wr, int wc, int fr, int fq) const {
        const int col0 = u.pn * BM + wc * 32 + 8 * fq; int row0 = u.pm * BM + wr * 64 + fr; asm volatile("" : "+v"(row0));
#pragma unroll
        for (int ai = 0; ai < 2; ++ai)
#pragma unroll
            for (int m = 0; m < 4; ++m) { const size_t r = (size_t)(row0 + ai * HALF + m * 16);
#pragma unroll
                for (int bj = 0; bj < 2; ++bj) { const u32x4 b = *(const u32x4*)(mg + r * 2048 + 1024 + col0 + bj * HALF);
                    f32x4 v0 = acc[ai][bj][m][0], v1 = acc[ai][bj][m][1];
                    v0[0] *= bflo(b.x); v0[1] *= bfhi(b.x); v0[2] *= bflo(b.y); v0[3] *= bfhi(b.y); v1[0] *= bflo(b.z); v1[1] *= bfhi(b.z); v1[2] *= bflo(b.w); v1[3] *= bfhi(b.w);
                    u32x4 w; w.x = cvt_pk_bf16(v0[0], v0[1]); w.y = cvt_pk_bf16(v0[2], v0[3]); w.z = cvt_pk_bf16(v1[0], v1[1]); w.w = cvt_pk_bf16(v1[2], v1[3]);
                    *(u32x4*)(merged + r * 1024 + col0 + bj * HALF) = w; } }
    }
};

struct EpiOutV {
    static constexpr bool PERM = false, AFTER_DRAIN = false, HAS_MID = false;
    const float* x; const float* modf; float* z;
    __device__ __forceinline__ void operator()(const f32x4 (&acc)[2][2][4][2], const Unit& u, int wr, int wc, int fr, int fq) const {
        const int col0 = u.pn * BM + wc * 32 + 4 * fq, b = (u.pm * BM) / SEQ; int row0 = u.pm * BM + wr * 64 + fr; asm volatile("" : "+v"(row0));
        f32x4 gv[2][2];
#pragma unroll
        for (int bj = 0; bj < 2; ++bj)
#pragma unroll
            for (int n = 0; n < 2; ++n) gv[bj][n] = *(const f32x4*)(modf + b * 3072 + 2048 + col0 + bj * HALF + n * 16);
#pragma unroll
        for (int ai = 0; ai < 2; ++ai)
#pragma unroll
            for (int m = 0; m < 4; ++m) { const size_t off = (size_t)(row0 + ai * HALF + m * 16) * 1024 + col0;
#pragma unroll
                for (int bj = 0; bj < 2; ++bj)
#pragma unroll
                    for (int n = 0; n < 2; ++n) { const f32x4 xv = *(const f32x4*)(x + off + bj * HALF + n * 16);
                        *(f32x4*)(z + off + bj * HALF + n * 16) = xv * ALPHA + gv[bj][n] * acc[ai][bj][m][n]; } }
    }
};

template <class Epi, class Sched, bool ALIGN_EPI = false, bool SP2 = false>
__device__ __forceinline__ void gemm_phase(PG8_LAS unsigned char* lds, const Gemm g, const Sched& S, const Epi& E, const int tid_in) {
    const int tid = tid_in, wid = __builtin_amdgcn_readfirstlane(tid >> 6), lane = tid & 63, wr = wid >> 2, wc = wid & 3, fr = lane & 15, fq = lane >> 4;
    const int K = g.K, nt = K / BK;
    unsigned voffA[2], voffB[2];
#pragma unroll
    for (int i = 0; i < 2; ++i) { int R, C; stage_rc(tid * 16 + i * 8192, R, C); const int Rb = Epi::PERM ? ((R & ~31) + perm32(R & 31)) : R;
        voffA[i] = (unsigned)(R * K + C) * 2u; voffB[i] = (unsigned)(Rb * K + C) * 2u; }
    const size_t kstep = (size_t)(BK * 2);
    const size_t hstep = (size_t)HALF * K * 2;
    const size_t tstep = 2 * hstep;
    const unsigned ldsw = (unsigned)wid * 1024u;
    const int aoff = lds_byte(wr * 64 + fr, fq * 8), boff = lds_byte(wc * 32 + fr, fq * 8);
#define PG8_SA(b, h) (((b) * 2 + (h)) * HTB)
#define PG8_SB(b, h) ((4 + (b) * 2 + (h)) * HTB)
#define PG8_STAGE(bufoff, gbase, voff) do { _Pragma("unroll") for (int _i = 0; _i < 2; ++_i) \
        __builtin_amdgcn_global_load_lds((const unsigned*)((const char*)(gbase) + (voff)[_i]), (PG8_LAS unsigned*)(lds + (bufoff) + ldsw + _i * 8192), 16, 0, 0); } while (0)
#define PG8_LDA(dst, b, h) do { _Pragma("unroll") for (int m = 0; m < 4; ++m) _Pragma("unroll") for (int k = 0; k < 2; ++k) dst[m][k] = *(const PG8_LAS bf16x8*)(lds + PG8_SA(b, h) + aoff + m * 2048 + k * 1024); } while (0)
#define PG8_LDB(dst, b, h) do { _Pragma("unroll") for (int n = 0; n < 2; ++n) _Pragma("unroll") for (int k = 0; k < 2; ++k) dst[n][k] = *(const PG8_LAS bf16x8*)(lds + PG8_SB(b, h) + boff + n * 2048 + k * 1024); } while (0)
#define PG8_MMA(ai, bj, At, Bt) do { __builtin_amdgcn_s_setprio(1); _Pragma("unroll") for (int m = 0; m < 4; ++m) _Pragma("unroll") for (int n = 0; n < 2; ++n) _Pragma("unroll") for (int k = 0; k < 2; ++k) \
        acc[ai][bj][m][n] = __builtin_amdgcn_mfma_f32_16x16x32_bf16(Bt[n][k], At[m][k], acc[ai][bj][m][n], 0, 0, 0); __builtin_amdgcn_s_setprio(0); } while (0)
#define PG8_WAIT_V(n) asm volatile("s_waitcnt vmcnt(" #n ")" ::: "memory")
#define PG8_WAIT_L(n) asm volatile("s_waitcnt lgkmcnt(" #n ")" ::: "memory")
#define PG8_BAR __builtin_amdgcn_s_barrier()
#define PG8_SCHED __builtin_amdgcn_sched_barrier(0)
    Unit cur, nxt; int ui = 0;
    if (!S.next(0, cur)) return;
    f32x4 acc[2][2][4][2];
#pragma unroll
    for (int a = 0; a < 2; ++a)
#pragma unroll
        for (int b = 0; b < 2; ++b)
#pragma unroll
            for (int m = 0; m < 4; ++m)
#pragma unroll
                for (int n = 0; n < 2; ++n) acc[a][b][m][n] = (f32x4){0.f, 0.f, 0.f, 0.f};
    bf16x8 At[4][2], B0[2][2], B1[2][2];
    const char* cA = (const char*)g.A + (size_t)cur.pm * tstep; const char* cB = (const char*)g.Bt + (size_t)cur.pn * tstep;
    S.a_ready(cur);
    if constexpr (SP2) {
        PG8_STAGE(PG8_SB(0, 0), cB, voffB); PG8_STAGE(PG8_SB(0, 1), cB + hstep, voffB); PG8_STAGE(PG8_SA(0, 0), cA, voffA); PG8_STAGE(PG8_SA(0, 1), cA + hstep, voffA);
        if (wr == 1) PG8_BAR;
        PG8_WAIT_V(2); PG8_BAR;
        PG8_STAGE(PG8_SB(1, 0), cB + kstep, voffB); PG8_STAGE(PG8_SA(1, 0), cA + kstep, voffA); PG8_STAGE(PG8_SB(1, 1), cB + hstep + kstep, voffB);
        PG8_WAIT_V(6); PG8_BAR;
    } else {
        PG8_STAGE(PG8_SB(0, 0), cB, voffB); PG8_STAGE(PG8_SA(0, 0), cA, voffA); PG8_STAGE(PG8_SB(0, 1), cB + hstep, voffB); PG8_STAGE(PG8_SA(0, 1), cA + hstep, voffA);
        if (wr == 1) PG8_BAR;
        PG8_WAIT_V(4); PG8_BAR;
        PG8_STAGE(PG8_SB(1, 0), cB + kstep, voffB); PG8_STAGE(PG8_SA(1, 0), cA + kstep, voffA); PG8_STAGE(PG8_SB(1, 1), cB + hstep + kstep, voffB);
        PG8_WAIT_V(6); PG8_BAR;
    }
    for (;;) {
        const bool has_next = S.next(ui + 1, nxt);
        const char* nA = has_next ? (const char*)g.A + (size_t)nxt.pm * tstep : cA; const char* nB = has_next ? (const char*)g.Bt + (size_t)nxt.pn * tstep : cB;
        for (int t = 0; t < nt; t += 2) {
            if constexpr (Epi::HAS_MID) { if (t == (nt >> 1)) { PG8_SCHED; E.mid(acc, cur, wr, wc, fr, fq); PG8_SCHED; } }
            const bool last = (t == nt - 2);
            const char* a1 = cA + (size_t)(t + 1) * kstep;
            const char* a2 = last ? nA : cA + (size_t)(t + 2) * kstep; const char* b2 = last ? nB : cB + (size_t)(t + 2) * kstep;
            const char* a3 = a2 + kstep; const char* b3 = b2 + kstep;
            if (last && has_next) S.a_ready(nxt);
            if constexpr (SP2) {
            PG8_LDB(B0, 0, 0); PG8_LDB(B1, 0, 1); PG8_SCHED; PG8_LDA(At, 0, 0); PG8_STAGE(PG8_SA(1, 1), a1 + hstep, voffA);
            PG8_WAIT_V(8); PG8_WAIT_L(0); PG8_BAR; PG8_MMA(0, 0, At, B0); PG8_MMA(0, 1, At, B1); PG8_BAR; PG8_SCHED;
            PG8_LDA(At, 0, 1); PG8_STAGE(PG8_SB(0, 0), b2, voffB); PG8_STAGE(PG8_SB(0, 1), b2 + hstep, voffB); PG8_STAGE(PG8_SA(0, 0), a2, voffA);
            PG8_WAIT_V(8); PG8_WAIT_L(0); PG8_BAR; PG8_MMA(1, 0, At, B0); PG8_MMA(1, 1, At, B1); PG8_BAR; PG8_SCHED;
            PG8_LDB(B0, 1, 0); PG8_LDB(B1, 1, 1); PG8_SCHED; PG8_LDA(At, 1, 0); PG8_STAGE(PG8_SA(0, 1), a2 + hstep, voffA);
            PG8_WAIT_V(8); PG8_WAIT_L(0); PG8_BAR; PG8_MMA(0, 0, At, B0); PG8_MMA(0, 1, At, B1); PG8_BAR; PG8_SCHED;
            PG8_LDA(At, 1, 1); PG8_STAGE(PG8_SB(1, 0), b3, voffB); PG8_STAGE(PG8_SB(1, 1), b3 + hstep, voffB); PG8_STAGE(PG8_SA(1, 0), a3, voffA);
            PG8_WAIT_V(8); PG8_WAIT_L(0); PG8_BAR; PG8_MMA(1, 0, At, B0); PG8_MMA(1, 1, At, B1); PG8_BAR; PG8_SCHED;
            } else {
            PG8_LDB(B0, 0, 0); PG8_SCHED; PG8_LDA(At, 0, 0); PG8_STAGE(PG8_SA(1, 1), a1 + hstep, voffA);
            PG8_WAIT_L(8); PG8_BAR; PG8_WAIT_L(0); PG8_MMA(0, 0, At, B0); PG8_BAR; PG8_SCHED;
            PG8_LDB(B1, 0, 1); PG8_STAGE(PG8_SB(0, 0), b2, voffB);
            PG8_BAR; PG8_WAIT_L(0); PG8_MMA(0, 1, At, B1); PG8_BAR;
            PG8_LDA(At, 0, 1); PG8_STAGE(PG8_SA(0, 0), a2, voffA);
            PG8_BAR; PG8_WAIT_L(0); PG8_MMA(1, 0, At, B0); PG8_BAR; PG8_SCHED;
            PG8_STAGE(PG8_SB(0, 1), b2 + hstep, voffB);
            PG8_WAIT_V(6); PG8_BAR; PG8_MMA(1, 1, At, B1); PG8_BAR;
            PG8_LDB(B0, 1, 0); PG8_SCHED; PG8_LDA(At, 1, 0); PG8_STAGE(PG8_SA(0, 1), a2 + hstep, voffA);
            PG8_WAIT_L(8); PG8_BAR; PG8_WAIT_L(0); PG8_MMA(0, 0, At, B0); PG8_BAR; PG8_SCHED;
            PG8_LDB(B1, 1, 1); PG8_STAGE(PG8_SB(1, 0), b3, voffB);
            PG8_BAR; PG8_WAIT_L(0); PG8_MMA(0, 1, At, B1); PG8_BAR;
            PG8_LDA(At, 1, 1); PG8_STAGE(PG8_SA(1, 0), a3, voffA);
            PG8_BAR; PG8_WAIT_L(0); PG8_MMA(1, 0, At, B0); PG8_BAR; PG8_SCHED;
            PG8_STAGE(PG8_SB(1, 1), b3 + hstep, voffB);
            PG8_WAIT_V(6); PG8_BAR; PG8_MMA(1, 1, At, B1); PG8_BAR;
            }
        }
        if constexpr (ALIGN_EPI) { if (wr == 0) PG8_BAR; }
        if constexpr (!Epi::AFTER_DRAIN) { E(acc, cur, wr, wc, fr, fq); S.done(cur); }
        if (!has_next) break;
#pragma unroll
        for (int a = 0; a < 2; ++a)
#pragma unroll
            for (int b = 0; b < 2; ++b)
#pragma unroll
                for (int m = 0; m < 4; ++m)
#pragma unroll
                    for (int n = 0; n < 2; ++n) acc[a][b][m][n] = (f32x4){0.f, 0.f, 0.f, 0.f};
        cur = nxt; cA = nA; cB = nB; ++ui;
        if constexpr (ALIGN_EPI) { if (wr == 1) PG8_BAR; }
    }
    PG8_WAIT_V(0);
    if constexpr (!ALIGN_EPI) { if (wr == 0) PG8_BAR; }
    PG8_BAR;
    if constexpr (Epi::AFTER_DRAIN) { E.fused(acc, cur, wr, wc, fr, fq, lds, wid, lane); S.done(cur); }
#undef PG8_SA
#undef PG8_SB
#undef PG8_STAGE
#undef PG8_LDA
#undef PG8_LDB
#undef PG8_MMA
#undef PG8_WAIT_V
#undef PG8_WAIT_L
#undef PG8_BAR
#undef PG8_SCHED
}
}

#include <hip/hip_bf16.h>
#include <cmath>
namespace attn_body {
using bf16=__hip_bfloat16;
using bf16x8=__attribute__((ext_vector_type(8)))short;
using s16x4=__attribute__((ext_vector_type(4)))short;
using f32x16=__attribute__((ext_vector_type(16)))float;
using u32x4=__attribute__((ext_vector_type(4)))unsigned;
constexpr int BATCH=4,NHEAD=16,SEQ=8192,D=64,DM=NHEAD*D;
constexpr int NW=8,QBLK=32,QB=QBLK*NW,KVBLK=64,NQB=SEQ/QB;
constexpr int ATTN_PITCH=DM, ATTN_UNIT_ROWS=QB;
__device__ __forceinline__ int crow(int r,int hi){return (r&3)+8*(r>>2)+4*hi;}
#define SBAR() __builtin_amdgcn_sched_barrier(0)
typedef __attribute__((address_space(3))) const float* lds_fptr;
__device__ __forceinline__ void bmask(f32x16&p0,f32x16&p1,int jb,int qrel,int hi,lds_fptr tab){
  const float NEG=-INFINITY; const int nb=qrel-64*jb-4*hi;
  #pragma unroll
  for(int r=0;r<16;++r){ const int n0=nb-((r&3)+8*(r>>2)), n1=n0-32;
    const int i0=n0<0?0:(n0>127?127:n0), i1=n1<0?0:(n1>127?127:n1);
    const float t0=tab[256+i0], t1=tab[256+i1];
    p0[r]=n0<0?NEG:p0[r]+t0; p1[r]=n1<0?NEG:p1[r]+t1; }
}
constexpr int NSLOT=3, SLOTB=8192;
constexpr int LDS_K=0, LDS_V=NSLOT*SLOTB, LDS_WS=2*NSLOT*SLOTB, LDS_OST=LDS_WS+NW*64*4, LDS_BYTES=LDS_OST+NW*4096;
constexpr float C2=0.125f*1.4426950408889634f;
__device__ __forceinline__ void glds16(const void*gsrc,unsigned lds_dst){unsigned keep;
  asm volatile("s_mov_b32 %0, m0\n\ts_mov_b32 m0, %2\n\ts_nop 0\n\tglobal_load_lds_dwordx4 %1, off\n\ts_mov_b32 m0, %0":"=&s"(keep):"v"(gsrc),"s"(lds_dst):"memory");}
__device__ __forceinline__ float max3f(float a,float b,float c){float r;asm("v_max3_f32 %0, %1, %2, %3":"=v"(r):"v"(a),"v"(b),"v"(c));return r;}
__device__ __forceinline__ float max2f(float a,float b){float r;asm("v_max_f32_e32 %0, %1, %2":"=v"(r):"v"(a),"v"(b));return r;}
__device__ __forceinline__ float fadd_s(float a,float b){float r;asm("v_add_f32_e32 %0, %1, %2":"=v"(r):"v"(a),"v"(b));return r;}
__device__ __forceinline__ float fsub_s(float a,float b){float r;asm("v_sub_f32_e32 %0, %1, %2":"=v"(r):"v"(a),"v"(b));return r;}
typedef float f32x2_t __attribute__((ext_vector_type(2))); typedef __bf16 bf16x2_t __attribute__((ext_vector_type(2)));
__device__ __forceinline__ unsigned cvtpk_s(float lo,float hi){f32x2_t v={lo,hi};bf16x2_t b=__builtin_convertvector(v,bf16x2_t);return __builtin_bit_cast(unsigned,b);}
#define WAIT_BAR(N) asm volatile("s_waitcnt vmcnt(" #N ") lgkmcnt(0)\n\ts_barrier":::"memory")

__device__ __forceinline__ void qkt(f32x16&p0,f32x16&p1,const char*Kslot,const bf16x8*qr,const f32x16&negm,int r32,int hi){
  const char*kb=Kslot+hi*1024+r32*16;
  #pragma unroll
  for(int d0=0;d0<4;++d0){
    const bf16x8 b0=*reinterpret_cast<const bf16x8*>(kb+d0*2048);
    const bf16x8 b1=*reinterpret_cast<const bf16x8*>(kb+d0*2048+512);
    if(d0==0){p0=__builtin_amdgcn_mfma_f32_32x32x16_bf16(b0,qr[0],negm,0,0,0);p1=__builtin_amdgcn_mfma_f32_32x32x16_bf16(b1,qr[0],negm,0,0,0);}
    else{p0=__builtin_amdgcn_mfma_f32_32x32x16_bf16(b0,qr[d0],p0,0,0,0);p1=__builtin_amdgcn_mfma_f32_32x32x16_bf16(b1,qr[d0],p1,0,0,0);}}
}
typedef __attribute__((address_space(3))) const char* lds_cptr;
typedef short v4i16_t __attribute__((ext_vector_type(4)));
__device__ __forceinline__ void kload8(bf16x8*kf,lds_cptr kp){
  kf[0]=*(const __attribute__((address_space(3))) bf16x8*)(kp);      kf[1]=*(const __attribute__((address_space(3))) bf16x8*)(kp+512);
  kf[2]=*(const __attribute__((address_space(3))) bf16x8*)(kp+2048); kf[3]=*(const __attribute__((address_space(3))) bf16x8*)(kp+2560);
  kf[4]=*(const __attribute__((address_space(3))) bf16x8*)(kp+4096); kf[5]=*(const __attribute__((address_space(3))) bf16x8*)(kp+4608);
  kf[6]=*(const __attribute__((address_space(3))) bf16x8*)(kp+6144); kf[7]=*(const __attribute__((address_space(3))) bf16x8*)(kp+6656);
}
__device__ __forceinline__ void kload2(bf16x8*kf,lds_cptr kp,int j){ kf[2*j]=*(const __attribute__((address_space(3))) bf16x8*)(kp+j*2048); kf[2*j+1]=*(const __attribute__((address_space(3))) bf16x8*)(kp+j*2048+512); }
__device__ __forceinline__ s16x4 vtr(lds_cptr p){ return __builtin_bit_cast(s16x4,__builtin_amdgcn_ds_read_tr16_b64_v4i16((__attribute__((address_space(3))) v4i16_t*)p)); }
__device__ __forceinline__ float rowmax(const f32x16&p0,const f32x16&p1){
  float a=max3f(p0[0],p0[1],p1[0]),b=max3f(p0[2],p0[3],p1[1]);a=max3f(a,p1[2],p1[3]);
  #pragma unroll
  for(int r=4;r<16;r+=4){a=max3f(a,p0[r],p0[r+1]);b=max3f(b,p0[r+2],p0[r+3]);a=max3f(a,p1[r],p1[r+1]);b=max3f(b,p1[r+2],p1[r+3]);}
  const float m=max2f(a,b);
  auto rr=__builtin_amdgcn_permlane32_swap(__float_as_uint(m),__float_as_uint(m),false,false);
  return max2f(__uint_as_float(rr[0]),__uint_as_float(rr[1]));
}
__device__ __forceinline__ void pv(f32x16*o,int vb,bf16x8 pa0,bf16x8 pa1,bf16x8 pa2,bf16x8 pa3){
  #pragma unroll
  for(int d0=0;d0<2;++d0){s16x4 lo[4],hi[4];
    #pragma unroll
    for(int ks=0;ks<4;++ks){
      asm volatile("ds_read_b64_tr_b16 %0,%1 offset:%c2":"=&v"(lo[ks]):"v"(vb),"i"(d0*4096+ks*1024):"memory");
      asm volatile("ds_read_b64_tr_b16 %0,%1 offset:%c2":"=&v"(hi[ks]):"v"(vb),"i"(d0*4096+ks*1024+512):"memory");}
    asm volatile("s_waitcnt lgkmcnt(0)":::"memory");SBAR();
    #define PK(k) (bf16x8){lo[k][0],lo[k][1],lo[k][2],lo[k][3],hi[k][0],hi[k][1],hi[k][2],hi[k][3]}
    o[d0]=__builtin_amdgcn_mfma_f32_32x32x16_bf16(pa0,PK(0),o[d0],0,0,0);
    o[d0]=__builtin_amdgcn_mfma_f32_32x32x16_bf16(pa1,PK(1),o[d0],0,0,0);
    o[d0]=__builtin_amdgcn_mfma_f32_32x32x16_bf16(pa2,PK(2),o[d0],0,0,0);
    o[d0]=__builtin_amdgcn_mfma_f32_32x32x16_bf16(pa3,PK(3),o[d0],0,0,0);
    #undef PK
  }
}

#ifndef ATTN_STORE16
#define ATTN_STORE16(p,v) (*(u32x4*)(p)=(v))
#endif
template<int THRL> __device__ __forceinline__ void attn_unit(int b,int hq,int hv,int qb,const bf16*Q,const bf16*__restrict__ K,const bf16*__restrict__ V,bf16*O,char*shm,lds_fptr tab,int wid_in){
  int lane; asm volatile("v_mbcnt_lo_u32_b32 %0, -1, 0\n\tv_mbcnt_hi_u32_b32 %0, -1, %0" : "=v"(lane)); const int r32=lane&31,hi=lane>>5; const int wid=wid_in;
  const long rowbase=(long)b*SEQ; const int q0=qb*QB;
  const bf16*Qw=Q+(rowbase+q0+wid*QBLK)*DM+hq*D;
  const bf16*Kh=K+rowbase*DM+hq*D,*Vh=V+rowbase*DM+hv*D;
  const unsigned lds0=(unsigned)(uintptr_t)shm;
  float*wsf=(float*)(shm+LDS_WS)+wid*64;
  const bf16*ksrc=Kh+(long)lane*DM+wid*8;
  const bf16*vsrc=Vh+(long)(16*(wid&3)+(lane>>2))*DM+(wid>>2)*32+(lane&3)*8;
  const unsigned kdst=lds0+LDS_K+wid*1024, vdst=lds0+LDS_V+wid*1024;
  #define DMA_K(t,slot) glds16(ksrc+(long)(t)*KVBLK*DM,(unsigned)__builtin_amdgcn_readfirstlane(kdst+(slot)))
  #define DMA_V(t,slot) glds16(vsrc+(long)(t)*KVBLK*DM,(unsigned)__builtin_amdgcn_readfirstlane(vdst+(slot)))
  const int vb0=(int)(lds0+LDS_V)+((lane>>4)&1)*32+(lane&3)*8+(4*hi+((lane&15)>>2))*64;
  const char*Kbase=shm+LDS_K; bf16x8 kf[8];
  const lds_cptr shm3=(lds_cptr)shm; const lds_cptr kp0=shm3+LDS_K+hi*1024+r32*16; const lds_cptr vp0=shm3+LDS_V+((lane>>4)&1)*32+(lane&3)*8+(4*hi+((lane&15)>>2))*64;
  const int NT=(q0+QB)/KVBLK;
  DMA_K(0,0);DMA_V(0,0);DMA_K(1,SLOTB);
  bf16x8 qr[4];
  #pragma unroll
  for(int d0=0;d0<4;++d0)qr[d0]=*reinterpret_cast<const bf16x8*>(&Qw[(long)r32*DM+d0*16+hi*8]);
  float mhat=0.f,l_reg=0.f;f32x16 o[2],negm; { float z_; asm volatile("v_mov_b32 %0, 0":"=v"(z_)); _Pragma("unroll") for(int r=0;r<16;++r){o[0][r]=z_;o[1][r]=z_;negm[r]=z_;} } asm volatile("":"+v"(negm));
  const int qrel=wid*QBLK+r32;
  #define CMASK(P0,P1,t) do{int jb_=(t)-(NT-4); if(jb_>=-2)bmask(P0,P1,jb_,qrel,hi,tab);}while(0)
  bool resc=false;
  #define START(P0,P1) do{ const float rm=rowmax(P0,P1); resc=false; \
    { const float dl=rm; mhat=fadd_s(mhat,dl); \
      _Pragma("unroll") for(int r=0;r<16;++r){P0[r]=fsub_s(P0[r],dl);P1[r]=fsub_s(P1[r],dl);} \
      _Pragma("unroll") for(int r=0;r<16;++r)negm[r]=-mhat; asm volatile("":"+v"(negm)); } \
    _Pragma("unroll") for(int r=0;r<16;++r)P0[r]=__builtin_amdgcn_exp2f(P0[r]); }while(0)
  #define RESC() do{ if(resc){ asm volatile("s_waitcnt lgkmcnt(0)":::"memory"); \
      _Pragma("unroll") for(int d_=0;d_<2;++d_) _Pragma("unroll") for(int r=0;r<16;++r)o[d_][r]*=wsf[crow(r,hi)]; } }while(0)
  f32x16 pA0,pA1,pB0,pB1;
  int sl_prev=0,sl_cur=0,sl_next=SLOTB;
  #define ROT() do{sl_prev=sl_cur;sl_cur=sl_next;sl_next=(sl_next==(NSLOT-1)*SLOTB)?0:sl_next+SLOTB;}while(0)
  DMA_K(2,2*SLOTB);
  WAIT_BAR(3);
  qkt(pA0,pA1,Kbase,qr,negm,r32,hi);asm volatile("s_nop 15\n\ts_nop 7":"+v"(pA0),"+v"(pA1));CMASK(pA0,pA1,0);
  START(pA0,pA1);
  _Pragma("unroll") for(int r=0;r<16;++r)pA1[r]=__builtin_amdgcn_exp2f(pA1[r]);
  WAIT_BAR(0);
  DMA_K(3,0);DMA_V(1,SLOTB);
  ROT();
  kload8(kf,kp0+sl_cur);
  WAIT_BAR(2);
  s16x4 vlo[8],vhi[8]; u32x4 pw0,pw1,pw2,pw3;
  #define PKW(P,B) cvtpk_s(P[B],P[B+1])
  #define PAF(k) __builtin_bit_cast(bf16x8,pw##k)
  #define VFR(i) (bf16x8){vlo[i][0],vlo[i][1],vlo[i][2],vlo[i][3],vhi[i][0],vhi[i][1],vhi[i][2],vhi[i][3]}
  #define PIN(x) asm volatile("":"+v"(x))
  #define MX3(a,b,c) __builtin_fmaxf(__builtin_fmaxf((a),(b)),(c))
  #define GAPA(MF,A0,A1,A2,A3,W0,W1,PW) do{ MF; sacc+=A0; sacc+=A1; sacc+=A2; sacc+=A3; PIN(sacc); W0; W1; PIN(PW); SBAR(); }while(0)
  #define EX(v) __builtin_amdgcn_exp2f(v)
  #define GAPB(MF,X,B) do{ MF; X[B]=EX(X[B]); X[B+1]=EX(X[B+1]); X[B+2]=EX(X[B+2]); X[B+3]=EX(X[B+3]); PIN(X); SBAR(); }while(0)
  #define VRD(i) do{ vlo[i]=vtr(vp_+(((i)>>2)*4096+((i)&3)*1024)); vhi[i]=vtr(vp_+(((i)>>2)*4096+((i)&3)*1024+512)); }while(0)
  #define KRD(G,j) do{ if(G){ kload2(kf,kp0+sl_next,j); SBAR(); } }while(0)
  #define STEP(C0,C1,P0,P1,t,GK,GV,GL) do{ SBAR(); \
    const lds_cptr vp_=vp0+sl_prev; \
    VRD(0); SBAR(); float sacc=(P0[0]+P0[1]); \
    GAPA(C0=__builtin_amdgcn_mfma_f32_32x32x16_bf16(kf[0],qr[0],negm,0,0,0), P0[2],P0[3],P0[4],P0[5],     pw0[0]=PKW(P0,0), pw0[1]=PKW(P0,2), pw0); \
    VRD(4); SBAR(); GAPA(C1=__builtin_amdgcn_mfma_f32_32x32x16_bf16(kf[1],qr[0],negm,0,0,0), P0[6],P0[7],P0[8],P0[9],     pw0[2]=PKW(P0,4), pw0[3]=PKW(P0,6), pw0); \
    VRD(1); SBAR(); GAPA(C0=__builtin_amdgcn_mfma_f32_32x32x16_bf16(kf[2],qr[1],C0,0,0,0),   P0[10],P0[11],P0[12],P0[13], pw1[0]=PKW(P0,8), pw1[1]=PKW(P0,10), pw1); \
    VRD(5); SBAR(); GAPA(C1=__builtin_amdgcn_mfma_f32_32x32x16_bf16(kf[3],qr[1],C1,0,0,0),   P0[14],P0[15],P1[0],P1[1],   pw1[2]=PKW(P0,12),pw1[3]=PKW(P0,14), pw1); \
    VRD(2); SBAR(); GAPA(C0=__builtin_amdgcn_mfma_f32_32x32x16_bf16(kf[4],qr[2],C0,0,0,0),   P1[2],P1[3],P1[4],P1[5],     pw2[0]=PKW(P1,0), pw2[1]=PKW(P1,2), pw2); \
    VRD(6); SBAR(); GAPA(C1=__builtin_amdgcn_mfma_f32_32x32x16_bf16(kf[5],qr[2],C1,0,0,0),   P1[6],P1[7],P1[8],P1[9],     pw2[2]=PKW(P1,4), pw2[3]=PKW(P1,6), pw2); \
    VRD(3); SBAR(); GAPA(C0=__builtin_amdgcn_mfma_f32_32x32x16_bf16(kf[6],qr[3],C0,0,0,0),   P1[10],P1[11],P1[12],P1[13], pw3[0]=PKW(P1,8), pw3[1]=PKW(P1,10), pw3); \
    VRD(7); SBAR(); GAPA(C1=__builtin_amdgcn_mfma_f32_32x32x16_bf16(kf[7],qr[3],C1,0,0,0),   P1[14],P1[15],0.f,0.f,       pw3[2]=PKW(P1,12),pw3[3]=PKW(P1,14), pw3); \
    l_reg+=sacc; \
    if(GK){DMA_K((t)+3,sl_cur);} if(GV){DMA_V((t)+1,sl_next);} \
    CMASK(C0,C1,t); \
    { float a=MX3(C0[0],C0[1],C1[0]),b=MX3(C0[2],C0[3],C1[1]); a=MX3(a,C1[2],C1[3]); \
      _Pragma("unroll") for(int r=4;r<16;r+=4){a=MX3(a,C0[r],C0[r+1]);b=MX3(b,C0[r+2],C0[r+3]);a=MX3(a,C1[r],C1[r+1]);b=MX3(b,C1[r+2],C1[r+3]);} \
      float rm=__builtin_fmaxf(a,b); { auto rr=__builtin_amdgcn_permlane32_swap(__float_as_uint(rm),__float_as_uint(rm),false,false); rm=__builtin_fmaxf(__uint_as_float(rr[0]),__uint_as_float(rr[1])); } \
      resc=false; \
      if(__builtin_expect(__any(rm>(float)THRL),0)){ const float dl=__builtin_fmaxf(rm,0.f); mhat+=dl; \
        _Pragma("unroll") for(int r=0;r<16;++r){C0[r]-=dl;C1[r]-=dl;} \
        _Pragma("unroll") for(int r=0;r<16;++r)negm[r]=-mhat; asm volatile("":"+v"(negm)); \
        const float f=__builtin_amdgcn_exp2f(-dl); l_reg*=f; if(hi==0)wsf[r32]=f; resc=true; } } \
    SBAR(); \
    GAPB(o[0]=__builtin_amdgcn_mfma_f32_32x32x16_bf16(PAF(0),VFR(0),o[0],0,0,0), C0,0); \
    GAPB(o[1]=__builtin_amdgcn_mfma_f32_32x32x16_bf16(PAF(0),VFR(4),o[1],0,0,0), C0,4); \
    KRD(GL,0); GAPB(o[0]=__builtin_amdgcn_mfma_f32_32x32x16_bf16(PAF(1),VFR(1),o[0],0,0,0), C0,8); \
    KRD(GL,1); GAPB(o[1]=__builtin_amdgcn_mfma_f32_32x32x16_bf16(PAF(1),VFR(5),o[1],0,0,0), C0,12); \
    KRD(GL,2); GAPB(o[0]=__builtin_amdgcn_mfma_f32_32x32x16_bf16(PAF(2),VFR(2),o[0],0,0,0), C1,0); \
    KRD(GL,3); GAPB(o[1]=__builtin_amdgcn_mfma_f32_32x32x16_bf16(PAF(2),VFR(6),o[1],0,0,0), C1,4); \
    GAPB(o[0]=__builtin_amdgcn_mfma_f32_32x32x16_bf16(PAF(3),VFR(3),o[0],0,0,0), C1,8); \
    GAPB(o[1]=__builtin_amdgcn_mfma_f32_32x32x16_bf16(PAF(3),VFR(7),o[1],0,0,0), C1,12); \
    }while(0)
  int t=1;
  #undef CMASK
  #define CMASK(P0,P1,t) do{}while(0)
  for(;t+7<NT;t+=2){
    STEP(pB0,pB1,pA0,pA1,t,true,true,true);     WAIT_BAR(2); RESC(); ROT();
    STEP(pA0,pA1,pB0,pB1,t+1,true,true,true);   WAIT_BAR(2); RESC(); ROT();
  }
  #undef CMASK
  #define CMASK(P0,P1,t) do{int jb_=(t)-(NT-4); if(jb_>=-2)bmask(P0,P1,jb_,qrel,hi,tab);}while(0)
  #define ENDW(tt) do{ if((tt)+3<NT){WAIT_BAR(2);} else if((tt)+2<NT){WAIT_BAR(1);} else {WAIT_BAR(0);} }while(0)
  for(;t+1<NT;t+=2){
    STEP(pB0,pB1,pA0,pA1,t,(t+3<NT),(t+1<NT),(t+1<NT));       ENDW(t);   RESC(); ROT();
    STEP(pA0,pA1,pB0,pB1,t+1,(t+4<NT),(t+2<NT),(t+2<NT));     ENDW(t+1); RESC(); ROT();
  }
  STEP(pB0,pB1,pA0,pA1,NT-1,false,false,false); RESC();
  { float sacc=pB0[0]+pB0[1]; _Pragma("unroll") for(int r=2;r<16;++r)sacc+=pB0[r]; _Pragma("unroll") for(int r=0;r<16;++r)sacc+=pB1[r]; l_reg+=sacc;
    pw0=(u32x4){PKW(pB0,0),PKW(pB0,2),PKW(pB0,4),PKW(pB0,6)};pw1=(u32x4){PKW(pB0,8),PKW(pB0,10),PKW(pB0,12),PKW(pB0,14)};pw2=(u32x4){PKW(pB1,0),PKW(pB1,2),PKW(pB1,4),PKW(pB1,6)};pw3=(u32x4){PKW(pB1,8),PKW(pB1,10),PKW(pB1,12),PKW(pB1,14)};
    SBAR(); pv(o,vb0+sl_cur,PAF(0),PAF(1),PAF(2),PAF(3)); }
  #undef PKW
  #undef PAF
  #undef VFR
  #undef PIN
  #undef MX3
  #undef GAPA
  #undef GAPB
  #undef EX
  #undef VRD
  #undef KRD
  #undef STEP
  #undef ENDW
  {auto rr=__builtin_amdgcn_permlane32_swap(__float_as_uint(l_reg),__float_as_uint(l_reg),false,false);l_reg=__uint_as_float(rr[0])+__uint_as_float(rr[1]);}
  if(hi==0)wsf[32+r32]=l_reg;asm volatile("s_waitcnt lgkmcnt(0)":::"memory");
  float rli[16];
  #pragma unroll
  for(int r=0;r<16;++r)rli[r]=__builtin_amdgcn_rcpf(wsf[32+crow(r,hi)]);
  bf16*Ow=O+(rowbase+q0+wid*QBLK)*DM+hv*D;
  { bf16*stg=(bf16*)(shm+LDS_OST)+wid*2048;
    #pragma unroll
    for(int r=0;r<16;++r){const int orow=crow(r,hi);
      #pragma unroll
      for(int d0=0;d0<2;++d0)stg[orow*64+d0*32+r32]=__float2bfloat16(o[d0][r]*rli[r]);}
    asm volatile("s_waitcnt lgkmcnt(0)":::"memory");
    #pragma unroll
    for(int i=0;i<4;++i){const int row=i*8+(lane>>3),ch=lane&7; const u32x4 v=*(const u32x4*)(stg+row*64+ch*8); ATTN_STORE16(Ow+(long)row*DM+ch*8,v);} }
  asm volatile("s_waitcnt lgkmcnt(0)\n\ts_barrier":::"memory");
  #undef DMA_K
  #undef DMA_V
  #undef CMASK
  #undef START
  #undef RESC
  #undef ROT
}
constexpr int ATTN_LDS_BYTES=LDS_BYTES;
#undef SBAR
#undef WAIT_BAR
}


namespace attn_body {
#define SBAR() __builtin_amdgcn_sched_barrier(0)
#define WAIT_BAR(N) asm volatile("s_waitcnt vmcnt(" #N ") lgkmcnt(0)\n\ts_barrier":::"memory")
constexpr int SLOTK=8192, SLOTV=16384, L2_K=0, L2_V=NSLOT*SLOTK, L2_WS=L2_V+NSLOT*SLOTV, L2_OST=L2_WS+NW*64*4, L2_BYTES=L2_OST+NW*4096;
__device__ __forceinline__ void pv4(f32x16*o,int vb,bf16x8 pa0,bf16x8 pa1,bf16x8 pa2,bf16x8 pa3){
  #pragma unroll
  for(int d0=0;d0<4;++d0){s16x4 lo[4],hi[4];
    #pragma unroll
    for(int ks=0;ks<4;++ks){
      asm volatile("ds_read_b64_tr_b16 %0,%1 offset:%c2":"=&v"(lo[ks]):"v"(vb),"i"(d0*4096+ks*1024):"memory");
      asm volatile("ds_read_b64_tr_b16 %0,%1 offset:%c2":"=&v"(hi[ks]):"v"(vb),"i"(d0*4096+ks*1024+512):"memory");}
    asm volatile("s_waitcnt lgkmcnt(0)":::"memory");SBAR();
    #define PK(k) (bf16x8){lo[k][0],lo[k][1],lo[k][2],lo[k][3],hi[k][0],hi[k][1],hi[k][2],hi[k][3]}
    o[d0]=__builtin_amdgcn_mfma_f32_32x32x16_bf16(pa0,PK(0),o[d0],0,0,0);
    o[d0]=__builtin_amdgcn_mfma_f32_32x32x16_bf16(pa1,PK(1),o[d0],0,0,0);
    o[d0]=__builtin_amdgcn_mfma_f32_32x32x16_bf16(pa2,PK(2),o[d0],0,0,0);
    o[d0]=__builtin_amdgcn_mfma_f32_32x32x16_bf16(pa3,PK(3),o[d0],0,0,0);
    #undef PK
  }
}
#define ZERO16 (f32x16){0.f,0.f,0.f,0.f,0.f,0.f,0.f,0.f,0.f,0.f,0.f,0.f,0.f,0.f,0.f,0.f}
#define MFMA32(a,b,c) __builtin_amdgcn_mfma_f32_32x32x16_bf16(a,b,c,0,0,0)
template<int THRL> __device__ __forceinline__ void attn_unit2(int b,int hq,int hvb,int qb,const bf16*Q,const bf16*__restrict__ K,const bf16*__restrict__ V,bf16*O,char*shm,lds_fptr tab,int wid_in){
  int lane; asm volatile("v_mbcnt_lo_u32_b32 %0, -1, 0\n\tv_mbcnt_hi_u32_b32 %0, -1, %0" : "=v"(lane)); const int r32=lane&31,hi=lane>>5; const int wid=wid_in;
  const long rowbase=(long)b*SEQ; const int q0=qb*QB;
  const bf16*Qw=Q+(rowbase+q0+wid*QBLK)*DM+hq*D;
  const bf16*Kh=K+rowbase*DM+hq*D,*Vh=V+rowbase*DM+hvb*D;
  const unsigned lds0=(unsigned)(uintptr_t)shm;
  float*wsf=(float*)(shm+L2_WS)+wid*64;
  const bf16*ksrc=Kh+(long)lane*DM+wid*8;
  const bf16*vsrc=Vh+(long)(16*(wid&3)+(lane>>2))*DM+(wid>>2)*32+(lane&3)*8;
  const unsigned kdst=lds0+L2_K+wid*1024, vdst=lds0+L2_V+wid*1024;
  #define DMA_K(t,slot) glds16(ksrc+(long)(t)*KVBLK*DM,(unsigned)__builtin_amdgcn_readfirstlane(kdst+(slot)))
  #define DMA_V(t,slot) do{ glds16(vsrc+(long)(t)*KVBLK*DM,(unsigned)__builtin_amdgcn_readfirstlane(vdst+2*(slot))); glds16(vsrc+(long)(t)*KVBLK*DM+64,(unsigned)__builtin_amdgcn_readfirstlane(vdst+2*(slot)+8192)); }while(0)
  const int vb0=(int)(lds0+L2_V)+((lane>>4)&1)*32+(lane&3)*8+(4*hi+((lane&15)>>2))*64;
  const char*Kbase=shm+L2_K; bf16x8 kf[8];
  const lds_cptr shm3=(lds_cptr)shm; const lds_cptr kp0=shm3+L2_K+hi*1024+r32*16; const lds_cptr vp0=shm3+L2_V+((lane>>4)&1)*32+(lane&3)*8+(4*hi+((lane&15)>>2))*64;
  const int NT=(q0+QB)/KVBLK;
  DMA_K(0,0);DMA_V(0,0);DMA_K(1,SLOTK);
  bf16x8 qr[4];
  #pragma unroll
  for(int d0=0;d0<4;++d0)qr[d0]=*reinterpret_cast<const bf16x8*>(&Qw[(long)r32*DM+d0*16+hi*8]);
  float mh=0.f,l_reg=0.f;f32x16 o[4]; { float z_; asm volatile("v_mov_b32 %0, 0":"=v"(z_)); _Pragma("unroll") for(int r=0;r<16;++r){o[0][r]=z_;o[1][r]=z_;o[2][r]=z_;o[3][r]=z_;} }
  const int qrel=wid*QBLK+r32;
  #define CMASK(P0,P1,t) do{int jb_=(t)-(NT-4); if(jb_>=-2)bmask(P0,P1,jb_,qrel,hi,tab);}while(0)
  bool resc=false;
  #define RESC() do{ if(resc){ asm volatile("s_waitcnt lgkmcnt(0)":::"memory"); \
      _Pragma("unroll") for(int d_=0;d_<4;++d_) _Pragma("unroll") for(int r=0;r<16;++r)o[d_][r]*=wsf[crow(r,hi)]; } }while(0)
  f32x16 pA0,pA1,pB0,pB1;
  int sl_prev=0,sl_cur=0,sl_next=SLOTK;
  #define ROT() do{sl_prev=sl_cur;sl_cur=sl_next;sl_next=(sl_next==(NSLOT-1)*SLOTK)?0:sl_next+SLOTK;}while(0)
  DMA_K(2,2*SLOTK);
  WAIT_BAR(4);
  { const char*kb=Kbase+hi*1024+r32*16;
    #pragma unroll
    for(int d0=0;d0<4;++d0){ const bf16x8 b0=*reinterpret_cast<const bf16x8*>(kb+d0*2048); const bf16x8 b1=*reinterpret_cast<const bf16x8*>(kb+d0*2048+512);
      if(d0==0){pA0=MFMA32(b0,qr[0],ZERO16);pA1=MFMA32(b1,qr[0],ZERO16);} else{pA0=MFMA32(b0,qr[d0],pA0);pA1=MFMA32(b1,qr[d0],pA1);} } }
  CMASK(pA0,pA1,0);
  { float a=__builtin_fmaxf(__builtin_fmaxf(pA0[0],pA0[1]),pA1[0]),b_=__builtin_fmaxf(__builtin_fmaxf(pA0[2],pA0[3]),pA1[1]); a=__builtin_fmaxf(__builtin_fmaxf(a,pA1[2]),pA1[3]);
    _Pragma("unroll") for(int r=4;r<16;r+=4){a=__builtin_fmaxf(__builtin_fmaxf(a,pA0[r]),pA0[r+1]);b_=__builtin_fmaxf(__builtin_fmaxf(b_,pA0[r+2]),pA0[r+3]);a=__builtin_fmaxf(__builtin_fmaxf(a,pA1[r]),pA1[r+1]);b_=__builtin_fmaxf(__builtin_fmaxf(b_,pA1[r+2]),pA1[r+3]);}
    float rm=__builtin_fmaxf(a,b_); { auto rr=__builtin_amdgcn_permlane32_swap(__float_as_uint(rm),__float_as_uint(rm),false,false); rm=__builtin_fmaxf(__uint_as_float(rr[0]),__uint_as_float(rr[1])); }
    mh=rm;
    _Pragma("unroll") for(int r=0;r<16;++r){pA0[r]=__builtin_amdgcn_exp2f(pA0[r]-mh);pA1[r]=__builtin_amdgcn_exp2f(pA1[r]-mh);} }
  WAIT_BAR(0);
  DMA_K(3,0);DMA_V(1,SLOTK);
  ROT();
  kload8(kf,kp0+sl_cur);
  WAIT_BAR(3);
  s16x4 vlo[8],vhi[8]; u32x4 pw0,pw1,pw2,pw3;
  #define PKW(P,B) cvtpk_s(P[B],P[B+1])
  #define PAF(k) __builtin_bit_cast(bf16x8,pw##k)
  #define VFR(i) (bf16x8){vlo[i][0],vlo[i][1],vlo[i][2],vlo[i][3],vhi[i][0],vhi[i][1],vhi[i][2],vhi[i][3]}
  #define PIN(x) asm volatile("":"+v"(x))
  #define MX3(a,b,c) __builtin_fmaxf(__builtin_fmaxf((a),(b)),(c))
  #define GAPA(MF,A0,A1,A2,A3,W0,W1,PW) do{ MF; sacc+=A0; sacc+=A1; sacc+=A2; sacc+=A3; PIN(sacc); W0; W1; PIN(PW); SBAR(); }while(0)
  #define EX(v) __builtin_amdgcn_exp2f((v)-mh)
  #define GAPB(MF,X,B) do{ MF; X[B]=EX(X[B]); X[B+1]=EX(X[B+1]); PIN(X); SBAR(); }while(0)
  #define VRDX(i,j) do{ vlo[i]=vtr(vp_+(((j)>>2)*4096+((j)&3)*1024)); vhi[i]=vtr(vp_+(((j)>>2)*4096+((j)&3)*1024+512)); }while(0)
  #define KRD(G,j) do{ if(G){ kload2(kf,kp0+sl_next,j); SBAR(); } }while(0)
  #define STEP(C0,C1,P0,P1,t,GK,GV,GL) do{ SBAR(); \
    const lds_cptr vp_=vp0+2*sl_prev; \
    VRDX(0,0); SBAR(); float sacc=(P0[0]+P0[1]); \
    GAPA(C0=MFMA32(kf[0],qr[0],ZERO16), P0[2],P0[3],P0[4],P0[5],     pw0[0]=PKW(P0,0), pw0[1]=PKW(P0,2), pw0); \
    VRDX(4,4); SBAR(); GAPA(C1=MFMA32(kf[1],qr[0],ZERO16), P0[6],P0[7],P0[8],P0[9],     pw0[2]=PKW(P0,4), pw0[3]=PKW(P0,6), pw0); \
    VRDX(1,1); SBAR(); GAPA(C0=MFMA32(kf[2],qr[1],C0),   P0[10],P0[11],P0[12],P0[13], pw1[0]=PKW(P0,8), pw1[1]=PKW(P0,10), pw1); \
    VRDX(5,5); SBAR(); GAPA(C1=MFMA32(kf[3],qr[1],C1),   P0[14],P0[15],P1[0],P1[1],   pw1[2]=PKW(P0,12),pw1[3]=PKW(P0,14), pw1); \
    VRDX(2,2); SBAR(); GAPA(C0=MFMA32(kf[4],qr[2],C0),   P1[2],P1[3],P1[4],P1[5],     pw2[0]=PKW(P1,0), pw2[1]=PKW(P1,2), pw2); \
    VRDX(6,6); SBAR(); GAPA(C1=MFMA32(kf[5],qr[2],C1),   P1[6],P1[7],P1[8],P1[9],     pw2[2]=PKW(P1,4), pw2[3]=PKW(P1,6), pw2); \
    VRDX(3,3); SBAR(); GAPA(C0=MFMA32(kf[6],qr[3],C0),   P1[10],P1[11],P1[12],P1[13], pw3[0]=PKW(P1,8), pw3[1]=PKW(P1,10), pw3); \
    VRDX(7,7); SBAR(); GAPA(C1=MFMA32(kf[7],qr[3],C1),   P1[14],P1[15],0.f,0.f,       pw3[2]=PKW(P1,12),pw3[3]=PKW(P1,14), pw3); \
    l_reg+=sacc; \
    if(GK){DMA_K((t)+3,sl_cur);} if(GV){DMA_V((t)+1,sl_next);} \
    CMASK(C0,C1,t); \
    { float a=MX3(C0[0],C0[1],C1[0]),b_=MX3(C0[2],C0[3],C1[1]); a=MX3(a,C1[2],C1[3]); \
      _Pragma("unroll") for(int r=4;r<16;r+=4){a=MX3(a,C0[r],C0[r+1]);b_=MX3(b_,C0[r+2],C0[r+3]);a=MX3(a,C1[r],C1[r+1]);b_=MX3(b_,C1[r+2],C1[r+3]);} \
      float rm=__builtin_fmaxf(a,b_); { auto rr=__builtin_amdgcn_permlane32_swap(__float_as_uint(rm),__float_as_uint(rm),false,false); rm=__builtin_fmaxf(__uint_as_float(rr[0]),__uint_as_float(rr[1])); } \
      resc=false; \
      if(__builtin_expect(__any(rm-mh>(float)THRL),0)){ const float dl=__builtin_fmaxf(rm-mh,0.f); mh+=dl; \
        const float f=__builtin_amdgcn_exp2f(-dl); l_reg*=f; if(hi==0)wsf[r32]=f; resc=true; } } \
    SBAR(); \
    GAPB(o[0]=MFMA32(PAF(0),VFR(0),o[0]), C0,0);  VRDX(0,8);  SBAR(); \
    GAPB(o[1]=MFMA32(PAF(0),VFR(4),o[1]), C0,2);  VRDX(4,12); SBAR(); \
    GAPB(o[0]=MFMA32(PAF(1),VFR(1),o[0]), C0,4);  VRDX(1,9);  SBAR(); \
    GAPB(o[1]=MFMA32(PAF(1),VFR(5),o[1]), C0,6);  VRDX(5,13); SBAR(); \
    GAPB(o[0]=MFMA32(PAF(2),VFR(2),o[0]), C0,8);  VRDX(2,10); SBAR(); \
    GAPB(o[1]=MFMA32(PAF(2),VFR(6),o[1]), C0,10); VRDX(6,14); SBAR(); \
    GAPB(o[0]=MFMA32(PAF(3),VFR(3),o[0]), C0,12); VRDX(3,11); SBAR(); \
    GAPB(o[1]=MFMA32(PAF(3),VFR(7),o[1]), C0,14); VRDX(7,15); SBAR(); \
    GAPB(o[2]=MFMA32(PAF(0),VFR(0),o[2]), C1,0); \
    GAPB(o[3]=MFMA32(PAF(0),VFR(4),o[3]), C1,2); \
    KRD(GL,0); GAPB(o[2]=MFMA32(PAF(1),VFR(1),o[2]), C1,4); \
    KRD(GL,1); GAPB(o[3]=MFMA32(PAF(1),VFR(5),o[3]), C1,6); \
    KRD(GL,2); GAPB(o[2]=MFMA32(PAF(2),VFR(2),o[2]), C1,8); \
    KRD(GL,3); GAPB(o[3]=MFMA32(PAF(2),VFR(6),o[3]), C1,10); \
    GAPB(o[2]=MFMA32(PAF(3),VFR(3),o[2]), C1,12); \
    GAPB(o[3]=MFMA32(PAF(3),VFR(7),o[3]), C1,14); \
    }while(0)
  int t=1;
  #undef CMASK
  #define CMASK(P0,P1,t) do{}while(0)
  for(;t+7<NT;t+=2){
    STEP(pB0,pB1,pA0,pA1,t,true,true,true);     WAIT_BAR(3); RESC(); ROT();
    STEP(pA0,pA1,pB0,pB1,t+1,true,true,true);   WAIT_BAR(3); RESC(); ROT();
  }
  #undef CMASK
  #define CMASK(P0,P1,t) do{int jb_=(t)-(NT-4); if(jb_>=-2)bmask(P0,P1,jb_,qrel,hi,tab);}while(0)
  #define ENDW(tt) do{ if((tt)+3<NT){WAIT_BAR(3);} else if((tt)+2<NT){WAIT_BAR(2);} else {WAIT_BAR(0);} }while(0)
  for(;t+1<NT;t+=2){
    STEP(pB0,pB1,pA0,pA1,t,(t+3<NT),(t+1<NT),(t+1<NT));       ENDW(t);   RESC(); ROT();
    STEP(pA0,pA1,pB0,pB1,t+1,(t+4<NT),(t+2<NT),(t+2<NT));     ENDW(t+1); RESC(); ROT();
  }
  STEP(pB0,pB1,pA0,pA1,NT-1,false,false,false); RESC();
  { float sacc=pB0[0]+pB0[1]; _Pragma("unroll") for(int r=2;r<16;++r)sacc+=pB0[r]; _Pragma("unroll") for(int r=0;r<16;++r)sacc+=pB1[r]; l_reg+=sacc;
    pw0=(u32x4){PKW(pB0,0),PKW(pB0,2),PKW(pB0,4),PKW(pB0,6)};pw1=(u32x4){PKW(pB0,8),PKW(pB0,10),PKW(pB0,12),PKW(pB0,14)};pw2=(u32x4){PKW(pB1,0),PKW(pB1,2),PKW(pB1,4),PKW(pB1,6)};pw3=(u32x4){PKW(pB1,8),PKW(pB1,10),PKW(pB1,12),PKW(pB1,14)};
    SBAR(); pv4(o,vb0+2*sl_cur,PAF(0),PAF(1),PAF(2),PAF(3)); }
  {auto rr=__builtin_amdgcn_permlane32_swap(__float_as_uint(l_reg),__float_as_uint(l_reg),false,false);l_reg=__uint_as_float(rr[0])+__uint_as_float(rr[1]);}
  if(hi==0)wsf[32+r32]=l_reg;asm volatile("s_waitcnt lgkmcnt(0)":::"memory");
  float rli[16];
  #pragma unroll
  for(int r=0;r<16;++r)rli[r]=__builtin_amdgcn_rcpf(wsf[32+crow(r,hi)]);
  bf16*Ow=O+(rowbase+q0+wid*QBLK)*DM+hvb*D;
  { bf16*stg=(bf16*)(shm+L2_OST)+wid*2048;
    #pragma unroll
    for(int hf=0;hf<2;++hf){
      #pragma unroll
      for(int r=0;r<16;++r){const int orow=crow(r,hi);
        #pragma unroll
        for(int d0=0;d0<2;++d0)stg[orow*64+d0*32+r32]=__float2bfloat16(o[2*hf+d0][r]*rli[r]);}
      asm volatile("s_waitcnt lgkmcnt(0)":::"memory");
      #pragma unroll
      for(int i=0;i<4;++i){const int row=i*8+(lane>>3),ch=lane&7; const u32x4 v=*(const u32x4*)(stg+row*64+ch*8); ATTN_STORE16(Ow+(long)row*DM+hf*64+ch*8,v);}
      asm volatile("s_waitcnt lgkmcnt(0)":::"memory");
    } }
  asm volatile("s_waitcnt lgkmcnt(0)\n\ts_barrier":::"memory");
  #undef DMA_K
  #undef DMA_V
  #undef CMASK
  #undef RESC
  #undef ROT
  #undef PKW
  #undef PAF
  #undef VFR
  #undef PIN
  #undef MX3
  #undef GAPA
  #undef GAPB
  #undef EX
  #undef VRDX
  #undef KRD
  #undef STEP
  #undef ENDW
}
constexpr int ATTN2_LDS_BYTES=L2_BYTES;
#undef ZERO16
#undef MFMA32
#undef SBAR
#undef WAIT_BAR
}

#define GAS __attribute__((address_space(1)))
#define LAS __attribute__((address_space(3)))
typedef unsigned short bf16;
typedef unsigned v4u __attribute__((ext_vector_type(4)));
typedef float f32x4 __attribute__((ext_vector_type(4)));
typedef short bf16x8 __attribute__((ext_vector_type(8)));
typedef GAS unsigned gu32;
typedef GAS unsigned long long gu64;
#define RLX_AGENT __ATOMIC_RELAXED, __HIP_MEMORY_SCOPE_AGENT
#define LDS_WAIT() asm volatile("s_waitcnt lgkmcnt(0)" ::: "memory")
#define VM_WAIT() asm volatile("s_waitcnt vmcnt(0)" ::: "memory")
__device__ __forceinline__ unsigned long long rt() { return __builtin_amdgcn_s_memrealtime(); }
__device__ __forceinline__ unsigned f2bf(float f) { unsigned u = __builtin_bit_cast(unsigned, f); return (u + 0x7fffu + ((u >> 16) & 1u)) >> 16; }
__device__ __forceinline__ unsigned pk2(float lo, float hi) { return f2bf(lo) | (f2bf(hi) << 16); }

#define XB_TMO      128
#define XB_XCNT(j)  (256  + 64 * (j))
#define XB_XSUB(j)  (1280 + 64 * (j))
#define XB_XGEN(j)  (2304 + 64 * (j))
#define XB_TOP      3328
#define XB_TOPGEN   3392
#define XCD_BAR_WORDS 3456
#define XB_SPIN_CAP (1u << 18)

__device__ __forceinline__ unsigned xb_ld(unsigned* p)              { return __hip_atomic_load(p, __ATOMIC_RELAXED, __HIP_MEMORY_SCOPE_AGENT); }
__device__ __forceinline__ unsigned xb_add(unsigned* p, unsigned v) { return __hip_atomic_fetch_add(p, v, __ATOMIC_RELAXED, __HIP_MEMORY_SCOPE_AGENT); }
__device__ __forceinline__ unsigned xb_xcc_id() { return (unsigned)__builtin_amdgcn_s_getreg((3 << 11) | 20) & 0xFu; }
#define XB_SPIN(cond, bar) do { unsigned _sp = 0; while (cond) { __builtin_amdgcn_s_sleep(1); \
    if ((++_sp & 255u) == 0u) { if (xb_ld(&(bar)[XB_TMO])) break; if (_sp > XB_SPIN_CAP) { atomicAdd(&(bar)[XB_TMO], 1u); break; } } } } while (0)

struct XcdBarrier {
    unsigned* bar; unsigned x;
    volatile LAS unsigned* st;
};

__device__ __forceinline__ XcdBarrier xcd_barrier_post(unsigned* bar, volatile LAS unsigned* st) {
    XcdBarrier b; b.bar = bar; b.x = xb_xcc_id(); b.st = st;
    if (threadIdx.x == 0) (void)xb_add(&bar[XB_XCNT(b.x)], 1u);
    return b;
}
__device__ __forceinline__ void xcd_barrier_complete(unsigned* bar, unsigned x, unsigned& nloc, unsigned& nx) {
    const unsigned G = gridDim.x * gridDim.y * gridDim.z;
    unsigned sum, cnt, mine, sp = 0u;
    for (;;) {
        sum = 0u; cnt = 0u; mine = 0u;
#pragma unroll
        for (unsigned j = 0; j < 16; ++j) { const unsigned c = xb_ld(&bar[XB_XCNT(j)]); sum += c; cnt += (c > 0u) ? 1u : 0u; mine = (j == x) ? c : mine; }
        if (sum == G) break;
        __builtin_amdgcn_s_sleep(1);
        if ((++sp & 255u) == 0u) { if (xb_ld(&bar[XB_TMO])) break; if (sp > XB_SPIN_CAP) { atomicAdd(&bar[XB_TMO], 1u); break; } }
    }
    nloc = mine > 0u ? mine : 1u; nx = cnt > 0u ? cnt : 1u;
}

__device__ __forceinline__ void xcd_barrier(const XcdBarrier& b, const bool leader) {
    asm volatile("s_waitcnt vmcnt(0)" ::: "memory");
    __syncthreads();
    if (leader) {
        unsigned* bar = b.bar;
        __builtin_amdgcn_s_waitcnt(0);
        unsigned nloc = b.st[0], nx = b.st[1];
        if (nloc == 0u) { xcd_barrier_complete(bar, b.x, nloc, nx); b.st[0] = nloc; b.st[1] = nx; }
        const unsigned old = xb_add(&bar[XB_XSUB(b.x)], 1u);
        const unsigned gen = old / nloc;
        if (old + 1u == (gen + 1u) * nloc) {
            __builtin_amdgcn_fence(__ATOMIC_RELEASE, "agent");
            asm volatile("s_waitcnt vmcnt(0)" ::: "memory");
            const unsigned og = xb_add(&bar[XB_TOP], 1u);
            const unsigned tg = og / nx;
            if (og + 1u == (tg + 1u) * nx) xb_add(&bar[XB_TOPGEN], 1u);
            else XB_SPIN(xb_ld(&bar[XB_TOPGEN]) == tg, bar);
            __builtin_amdgcn_fence(__ATOMIC_ACQUIRE, "agent");
            xb_add(&bar[XB_XGEN(b.x)], 1u);
            asm volatile("s_waitcnt vmcnt(0)" ::: "memory");
        } else {
            XB_SPIN(xb_ld(&bar[XB_XGEN(b.x)]) == gen, bar);
            __builtin_amdgcn_fence(__ATOMIC_ACQUIRE, "agent");
            asm volatile("s_waitcnt vmcnt(0)" ::: "memory");
        }
    }
    __syncthreads();
}


constexpr int NWAVES = 8;
constexpr int RING_OFF = 0, RING_BYTES = 131072;
constexpr int LDS_BYTES = 163840;
constexpr int LDSCTL_OFF = LDS_BYTES - 1024, MISC_OFF = LDSCTL_OFF + 320;
constexpr int ATT_TAB_OFF = 110592;
static_assert(attn_body::ATTN_LDS_BYTES <= ATT_TAB_OFF && attn_body::ATTN2_LDS_BYTES <= ATT_TAB_OFF && ATT_TAB_OFF + 8 * 384 * 4 <= RING_BYTES, "attention LDS map");
constexpr int CW_TMO = 0, CW_CODE = 1, CW_BAR = 4096;
static_assert((CW_BAR + XCD_BAR_WORDS) * 4 <= (int)CTL_ZERO_BYTES, "control words inside the memset region");
constexpr int N_PHASES = 9;
static_assert(RING_BYTES <= LDSCTL_OFF, "LDS map");
#ifndef MK_DUP23
#define MK_DUP23 0
#endif
#ifndef MK_DUP_ATTN
#define MK_DUP_ATTN 1
#endif
#ifndef MK_ATTN2
#define MK_ATTN2 1
#endif
#ifndef MK_ALIGN
#define MK_ALIGN true
#endif
#ifndef MK_SP2
#define MK_SP2 true
#endif

__device__ __forceinline__ float wave_sum(float v) {
#pragma unroll
    for (int o = 1; o < 64; o <<= 1) v += __shfl_xor(v, o);
    return v;
}
__device__ __forceinline__ float sigm(float x) { return __builtin_amdgcn_rcpf(1.0f + __builtin_amdgcn_exp2f(-1.4426950408889634f * x)); }

__device__ __forceinline__ void p0_transpose_item(const float* W, int N, bf16* WT, int ldt, int koff, LAS float* scr, int item, int lane, int rot = 0) {
    const int nblk = N / 32, kb = item / nblk, nb = item % nblk, k0 = 64 * kb, n0 = 32 * nb;
#pragma unroll 8
    for (int i = 0; i < 32; ++i) { const int kk = 2 * i + (lane >> 5); scr[kk * 33 + (lane & 31)] = W[(size_t)(k0 + kk) * N + n0 + (lane & 31)]; }
    LDS_WAIT(); asm volatile("" ::: "memory");
    const int c = lane & 7;
#pragma unroll
    for (int j = 0; j < 4; ++j) { const int n = (lane >> 3) + 8 * j; const LAS float* s = scr + (8 * c) * 33 + n;
        v4u o; o.x = pk2(s[0 * 33], s[1 * 33]); o.y = pk2(s[2 * 33], s[3 * 33]); o.z = pk2(s[4 * 33], s[5 * 33]); o.w = pk2(s[6 * 33], s[7 * 33]);
        *(GAS v4u*)(WT + (size_t)((n0 + n + rot) & (N - 1)) * ldt + koff + k0 + 8 * c) = o; }
    LDS_WAIT(); asm volatile("" ::: "memory");
}

constexpr int RNN_ROWS = 520, RNN_BUF = RNN_ROWS * 128, RNN_RG = 2 * RNN_BUF, RNN_TOT = RNN_RG + 8 * 2048, RNN_LDS = RNN_TOT + 2048;
__device__ __forceinline__ void rnn_phase(LAS unsigned char* lds, int vcu, int lane, int wave, const bf16* RX, bf16* YA, const float* conv_w, const float* conv_b,
                                          const float* w_a, const float* b_a, const float* w_x, const float* b_x, const float* lam, const bf16* zrow) {
    const int b = vcu >> 6, hb = (vcu >> 2) & 15, qd = vcu & 3, fr = lane & 15, fq = lane >> 4;
    const int cin0 = hb * 64, jo = qd * 16 + fr, co = hb * 64 + jo;
    bf16x8 Ba[4][2], Bx[4][2], Bs[4][2];
    float bav = b_a[co], bxv = b_x[co];
#pragma unroll
    for (int ks = 0; ks < 2; ++ks)
#pragma unroll
        for (int j = 0; j < 8; ++j) { const int i = 32 * ks + 8 * fq + j; const float wa = w_a[(size_t)hb * 4096 + i * 64 + jo], wx = w_x[(size_t)hb * 4096 + i * 64 + jo];
#pragma unroll
            for (int tp = 0; tp < 4; ++tp) { const float cwv = conv_w[tp * 1024 + cin0 + i];
                Ba[tp][ks][j] = (short)f2bf(cwv * wa); Bx[tp][ks][j] = (short)f2bf(cwv * wx); Bs[tp][ks][j] = (i == jo) ? (short)f2bf(cwv) : (short)0; } }
    for (int i = 0; i < 64; ++i) { const float cbi = conv_b[cin0 + i]; bav += cbi * w_a[(size_t)hb * 4096 + i * 64 + jo]; bxv += cbi * w_x[(size_t)hb * 4096 + i * 64 + jo]; }
    const float cbv = conv_b[co];
    const float logu = -8.0f * log1pf(expf(-lam[co])); const float logu2 = logu * 1.4426950408889634f, logu_2 = 2.0f * logu;
    float hsc = 0.f;
    const unsigned lds0 = (unsigned)(uintptr_t)lds;
    LAS float* tot = (LAS float*)(lds + RNN_TOT);
    const bf16* RXd = RX + (size_t)b * SEQ * 1024 + cin0 + (((lane & 7) - (lane >> 3)) & 7) * 8;
    const bf16* RGd = YA + (size_t)b * SEQ * 2048 + hb * 64 + qd * 16 + (lane & 1) * 8;
    const unsigned rgreg = lds0 + RNN_RG + wave * 2048;
#define RNN_DMA_RX(s_) do { const int T0_ = (s_) * 512; const unsigned bufb_ = lds0 + ((s_) & 1) * RNN_BUF; \
        for (int p_ = wave; p_ < RNN_ROWS / 8; p_ += 8) { const int tok_ = T0_ - 8 + 8 * p_ + (lane >> 3); \
            const bf16* src_ = (tok_ >= 0) ? RXd + (size_t)tok_ * 1024 : zrow; \
            attn_body::glds16(src_, (unsigned)__builtin_amdgcn_readfirstlane(bufb_ + p_ * 1024)); } } while (0)
#define RNN_DMA_RG(s_) do { const int t0_ = (s_) * 512 + wave * 64; \
        attn_body::glds16(RGd + (size_t)(t0_ + (lane >> 1)) * 2048, (unsigned)__builtin_amdgcn_readfirstlane(rgreg)); \
        attn_body::glds16(RGd + (size_t)(t0_ + 32 + (lane >> 1)) * 2048, (unsigned)__builtin_amdgcn_readfirstlane(rgreg + 1024)); } while (0)
    unsigned la[8];
#pragma unroll
    for (int j = 0; j < 8; ++j) la[j] = (unsigned)(fr * 128 + (((fq + fr + 5 + j) & 7) * 16));
    bf16* YAb = YA + (size_t)b * SEQ * 2048 + co;
    RNN_DMA_RX(0);
    asm volatile("s_waitcnt vmcnt(0) lgkmcnt(0)\n\ts_barrier" ::: "memory");
    for (int sc = 0; sc < SEQ / 512; ++sc) {
        const int t0 = sc * 512 + wave * 64;
        if (sc + 1 < SEQ / 512) RNN_DMA_RX(sc + 1);
        RNN_DMA_RG(sc);
        const LAS unsigned char* bufp = lds + (sc & 1) * RNN_BUF + (wave * 64 + 5) * 128;
        float hl[4][4], ac[4][4]; float Ach = 1.f, Hch = 0.f;
#pragma unroll
        for (int m = 0; m < 4; ++m) {
            f32x4 Dr = (f32x4){0.f, 0.f, 0.f, 0.f}, Di = Dr, Dx = Dr;
#pragma unroll
            for (int tp = 0; tp < 4; ++tp) {
                const bf16x8 a0 = *(const LAS bf16x8*)(bufp + (16 * m + tp) * 128 + la[tp & 7]);
                const bf16x8 a1 = *(const LAS bf16x8*)(bufp + (16 * m + tp) * 128 + la[(4 + tp) & 7]);
                Dr = __builtin_amdgcn_mfma_f32_16x16x32_bf16(a0, Ba[tp][0], Dr, 0, 0, 0); Di = __builtin_amdgcn_mfma_f32_16x16x32_bf16(a0, Bx[tp][0], Di, 0, 0, 0); Dx = __builtin_amdgcn_mfma_f32_16x16x32_bf16(a0, Bs[tp][0], Dx, 0, 0, 0);
                Dr = __builtin_amdgcn_mfma_f32_16x16x32_bf16(a1, Ba[tp][1], Dr, 0, 0, 0); Di = __builtin_amdgcn_mfma_f32_16x16x32_bf16(a1, Bx[tp][1], Di, 0, 0, 0); Dx = __builtin_amdgcn_mfma_f32_16x16x32_bf16(a1, Bs[tp][1], Dx, 0, 0, 0); }
            float al[4], hh[4];
#pragma unroll
            for (int r = 0; r < 4; ++r) { const float rr = sigm(Dr[r] + bav), ii = sigm(Di[r] + bxv); const float a = __builtin_amdgcn_exp2f(rr * logu2);
                const float e = rr * logu_2;
                const float pl = -e * (1.0f + e * 0.5f * (1.0f + e * (1.0f / 3.0f) * (1.0f + e * 0.25f * (1.0f + e * 0.2f))));
                const float om = (e > -0.3f) ? pl : (1.0f - a * a);
                const float bin = __builtin_amdgcn_sqrtf(om) * (ii * (Dx[r] + cbv));
                if (r == 0) { al[0] = a; hh[0] = bin; } else { al[r] = a * al[r - 1]; hh[r] = a * hh[r - 1] + bin; } }
            float Ai = al[3], Hi = hh[3];
            { const float Ap = __shfl_up(Ai, 16), Hp = __shfl_up(Hi, 16); if (fq >= 1) { Hi = Ai * Hp + Hi; Ai = Ai * Ap; } }
            { const float Ap = __shfl_up(Ai, 32), Hp = __shfl_up(Hi, 32); if (fq >= 2) { Hi = Ai * Hp + Hi; Ai = Ai * Ap; } }
            float Ae = __shfl_up(Ai, 16), He = __shfl_up(Hi, 16); if (fq == 0) { Ae = 1.f; He = 0.f; }
            const float hin = Ae * Hch + He, Ain = Ae * Ach;
#pragma unroll
            for (int r = 0; r < 4; ++r) { hl[m][r] = hh[r] + al[r] * hin; ac[m][r] = al[r] * Ain; }
            const float Am = __shfl(Ai, 48 + fr), Hm = __shfl(Hi, 48 + fr);
            Hch = Am * Hch + Hm; Ach = Am * Ach;
        }
        LAS float* tw = tot + ((sc & 1) * 8 + wave) * 32;
        if (fq == 0) { tw[fr * 2] = Ach; tw[fr * 2 + 1] = Hch; }
        asm volatile("s_waitcnt vmcnt(0) lgkmcnt(0)\n\ts_barrier" ::: "memory");
        float cin = 0.f, c = hsc;
#pragma unroll
        for (int w2 = 0; w2 < 8; ++w2) { const LAS float* tr = tot + ((sc & 1) * 8 + w2) * 32 + fr * 2; const float A = tr[0], H = tr[1]; if (w2 == wave) cin = c; c = A * c + H; }
        hsc = c;
        const LAS unsigned short* rgp = (const LAS unsigned short*)(lds + RNN_RG + wave * 2048) + fr;
#pragma unroll
        for (int m = 0; m < 4; ++m)
#pragma unroll
            for (int r = 0; r < 4; ++r) { const float h = hl[m][r] + ac[m][r] * cin; const unsigned short g = rgp[(16 * m + 4 * fq + r) * 16];
                YAb[(size_t)(t0 + 16 * m + 4 * fq + r) * 2048] = (bf16)f2bf(h * __uint_as_float(((unsigned)g) << 16)); }
        asm volatile("s_waitcnt lgkmcnt(0)" ::: "memory");
    }
#undef RNN_DMA_RX
#undef RNN_DMA_RG
    asm volatile("s_waitcnt vmcnt(0) lgkmcnt(0)\n\ts_barrier" ::: "memory");
}

static_assert(RNN_LDS <= LDSCTL_OFF, "rnn LDS map");
__device__ __forceinline__ void attn_phase_diff(unsigned char* lds_generic, LAS unsigned char* lds, int vcu, int tid, int wave, const bf16* Q, const bf16* K, const bf16* V, bf16* O0, bf16* O1, const float* rel_bias) {
    LAS float* tab = (LAS float*)(lds + ATT_TAB_OFF);
    for (int e = tid; e < 8 * 384; e += NWAVES * 64) { const int h = e / 384, n = e % 384 - 256; float val = -INFINITY;
        if (n >= 0) { int bk; if (n < 16) bk = n; else { bk = 16 + (int)(logf((float)n / 16.0f) / 2.0794415416798357f * 16.0f); bk = bk < 31 ? bk : 31; }
            val = (rel_bias[bk * 8 + h] - rel_bias[31 * 8 + h]) * 1.4426950408889634f; }
        tab[e] = val; }
    asm volatile("s_waitcnt lgkmcnt(0)\n\ts_barrier" ::: "memory");
    const int g = vcu >> 3, s = vcu & 7, b = g >> 3, h = g & 7;
#if MK_ATTN2
    for (int i = 0; i < 8; ++i) {
        const int c = i >> 2, j = i & 3;
        const int qb = (j == 0) ? s : (j == 1) ? 15 - s : (j == 2) ? 16 + s : 31 - s;
        attn_body::attn_unit2<8>(b, h * 2 + c, h * 2, qb, (const attn_body::bf16*)Q, (const attn_body::bf16*)K, (const attn_body::bf16*)V, (attn_body::bf16*)(c == 0 ? O0 : O1), (char*)lds_generic,
                                 (attn_body::lds_fptr)(tab + h * 384), wave);
    }
#else
    for (int i = 0; i < 16; ++i) {
        const int sub = i >> 2, c = sub >> 1, vh = sub & 1, j = i & 3;
        const int qb = (j == 0) ? s : (j == 1) ? 15 - s : (j == 2) ? 16 + s : 31 - s;
        attn_body::attn_unit<8>(b, h * 2 + c, h * 2 + vh, qb, (const attn_body::bf16*)Q, (const attn_body::bf16*)K, (const attn_body::bf16*)V, (attn_body::bf16*)(c == 0 ? O0 : O1), (char*)lds_generic,
                                (attn_body::lds_fptr)(tab + h * 384), wave);
    }
#endif
}

struct Args { const float* in[23]; float* out; unsigned char* ws; int ph_lo, ph_hi; };
typedef const __attribute__((address_space(4))) Args* KArgs;
__device__ __forceinline__ KArgs kargs() { auto p = __builtin_amdgcn_kernarg_segment_ptr(); asm volatile("" : "+s"(p)); return (KArgs)p; }
__device__ __forceinline__ int lane_id() { int l; asm volatile("v_mbcnt_lo_u32_b32 %0, -1, 0\n\tv_mbcnt_hi_u32_b32 %0, -1, %0" : "=v"(l)); return l; }
__global__ void __launch_bounds__(NWAVES * 64, 2) mk_fwd(Args args) {
    extern __shared__ __attribute__((aligned(16))) unsigned char lds_[];
    LAS unsigned char* lds = (LAS unsigned char*)lds_;
    volatile LAS unsigned* MISC = (volatile LAS unsigned*)(lds + MISC_OFF);
    const int wave = __builtin_amdgcn_readfirstlane((int)threadIdx.x >> 6);
    const int G = gridDim.x; const int vcu = (G % 8 == 0) ? ((int)blockIdx.x % 8) * (G / 8) + (int)blockIdx.x / 8 : (int)blockIdx.x;
    const int gw = vcu * NWAVES + wave, NGW = G * NWAVES;
    gu32* ctl = (gu32*)(args.ws + WS_CTL);
    for (int u = threadIdx.x; u < (LDS_BYTES - LDSCTL_OFF) / 4; u += NWAVES * 64) ((LAS unsigned*)(lds + LDSCTL_OFF))[u] = 0u;
    __syncthreads();
    const int lo = args.ph_lo, hi = args.ph_hi;
    const bool use_bar = (hi - lo) > 1;
    XcdBarrier bar; bar.bar = (unsigned*)(ctl + CW_BAR); bar.x = 0; bar.st = nullptr;
    if (use_bar) bar = xcd_barrier_post((unsigned*)(ctl + CW_BAR), MISC + 8);
#define IN(k) (lo <= (k) && (k) < hi)
#define SEAM(k) do { if (IN(k) && IN((k) + 1)) xcd_barrier(bar, wave == 0 && lane_id() == 0); } while (0)

    if (IN(0)) {
        KArgs A = kargs(); const int lane = lane_id(), tid = wave * 64 + lane; (void)tid;
        const float* cvec = A->in[1];
        const float* w_ada = A->in[2];
        const float* b_ada = A->in[3];
        const float* w_in = A->in[4];
        const float* w_rnn_out = A->in[18];
        const float* w_attn_out = A->in[19];
        const float* w_out = A->in[20];
        float* modf = (float*)(A->ws + WS_MODF);
        bf16* win_t = (bf16*)(A->ws + WS_WIN);
        bf16* wcat_t = (bf16*)(A->ws + WS_WCAT);
        bf16* wout_t = (bf16*)(A->ws + WS_WOUT);

        if (vcu < 192) {
            LAS float* scv = (LAS float*)lds;
            LAS float* red = (LAS float*)(lds + 16384);
#pragma unroll
            for (int i = 0; i < 8; ++i) { const int e = tid * 8 + i; const float cv = cvec[e]; scv[e] = cv * sigm(cv); }
            __syncthreads();
            const int e0 = vcu * 16, col = lane & 15, kg = lane >> 4;
            float a0 = 0.f, a1 = 0.f, a2 = 0.f, a3 = 0.f;
#pragma unroll 8
            for (int i = 0; i < 32; ++i) { const int k = wave * 128 + kg * 32 + i; const float w = w_ada[(size_t)k * 3072 + e0 + col];
                a0 += scv[k] * w; a1 += scv[1024 + k] * w; a2 += scv[2048 + k] * w; a3 += scv[3072 + k] * w; }
            a0 += __shfl_xor(a0, 16); a0 += __shfl_xor(a0, 32); a1 += __shfl_xor(a1, 16); a1 += __shfl_xor(a1, 32);
            a2 += __shfl_xor(a2, 16); a2 += __shfl_xor(a2, 32); a3 += __shfl_xor(a3, 16); a3 += __shfl_xor(a3, 32);
            if (kg == 0) { red[(wave * 4 + 0) * 16 + col] = a0; red[(wave * 4 + 1) * 16 + col] = a1; red[(wave * 4 + 2) * 16 + col] = a2; red[(wave * 4 + 3) * 16 + col] = a3; }
            __syncthreads();
            if (tid < 64) { const int bb = tid >> 4, cc = tid & 15; float sacc = b_ada[e0 + cc];
#pragma unroll
                for (int w2 = 0; w2 < 8; ++w2) sacc += red[(w2 * 4 + bb) * 16 + cc];
                modf[bb * 3072 + e0 + cc] = sacc; }
            __syncthreads();
        }
        LAS float* scr = (LAS float*)(lds + RING_OFF + wave * 16384);
        constexpr int I_IN = (DM / 64) * (NIN / 32), I_SQ = (DM / 64) * (DM / 32), NITEMS = I_IN + 3 * I_SQ;
        for (int it = gw; it < NITEMS; it += NGW) {
            int r = it;
            if (r < I_IN) { p0_transpose_item(w_in, NIN, win_t, DM, 0, scr, r, lane); continue; } r -= I_IN;
            if (r < I_SQ) { p0_transpose_item(w_rnn_out, DM, wcat_t, 2048, 0, scr, r, lane); continue; } r -= I_SQ;
            if (r < I_SQ) { p0_transpose_item(w_attn_out, DM, wcat_t, 2048, 1024, scr, r, lane); continue; } r -= I_SQ;
            p0_transpose_item(w_out, DM, wout_t, DM, 0, scr, r, lane);
        }
    }
    SEAM(0);
    if (IN(1)) {
        KArgs A = kargs(); const int lane = lane_id(), tid = wave * 64 + lane; (void)tid;
        const float* x = A->in[0];
        float* modf = (float*)(A->ws + WS_MODF);
        bf16* ubuf = (bf16*)((unsigned char*)A->out + DO_U);

        for (int blk = gw; blk < MTOK / 16; blk += NGW) {
            const int bb = (blk * 16) / SEQ; f32x4 sc4[4], sh4[4];
#pragma unroll
            for (int j = 0; j < 4; ++j) { sh4[j] = *(const GAS f32x4*)(modf + bb * 3072 + 256 * j + 4 * lane); sc4[j] = *(const GAS f32x4*)(modf + bb * 3072 + 1024 + 256 * j + 4 * lane) + 1.0f; }
            for (int rr = 0; rr < 16; ++rr) { const size_t row = (size_t)blk * 16 + rr;
                const GAS f32x4* xr = (const GAS f32x4*)(x + row * DM) + lane; GAS unsigned long long* o8 = (GAS unsigned long long*)(ubuf + row * DM) + lane;
#pragma unroll
                for (int j = 0; j < 4; ++j) { const f32x4 v = xr[64 * j] * sc4[j] + sh4[j]; o8[64 * j] = (unsigned long long)pk2(v.x, v.y) | ((unsigned long long)pk2(v.z, v.w) << 32); } }
        }
    }
    SEAM(1);
#if MK_DUP23
    for (int rep_ = 0; rep_ < 2; ++rep_) {
#endif
    if (IN(2)) {
        KArgs A = kargs(); const int lane = lane_id(), tid = wave * 64 + lane; (void)tid;
        bf16* ubuf = (bf16*)((unsigned char*)A->out + DO_U);
        bf16* win_t = (bf16*)(A->ws + WS_WIN);
        bf16* rxb = (bf16*)((unsigned char*)A->out + DO_RX);
        bf16* ya = (bf16*)(A->ws + WS_YA);
        bf16* qbuf = (bf16*)(A->ws + WS_Q);
        bf16* kbuf = (bf16*)(A->ws + WS_K);
        bf16* vbuf = (bf16*)(A->ws + WS_V);
        bf16* mgb = (bf16*)(A->ws + WS_MG);

        pg8::Gemm g{ubuf, win_t, MTOK, NIN, DM}; pg8::StaticOrder S; S.init(MTOK, NIN, G, (int)blockIdx.x);
        pg8::EpiProjV E{A->ws, (unsigned char*)A->out};
        pg8::gemm_phase<pg8::EpiProjV, pg8::StaticOrder, MK_ALIGN, MK_SP2>(lds + RING_OFF, g, S, E, tid);
    }
#if MK_DUP23 == 2
    }
#endif
    SEAM(2);
    if (IN(3)) {
        KArgs A = kargs(); const int lane = lane_id(), tid = wave * 64 + lane; (void)tid;
        bf16* rxb = (bf16*)((unsigned char*)A->out + DO_RX);
        bf16* ya = (bf16*)(A->ws + WS_YA);
        const float* conv_w = A->in[5];
        const float* conv_b = A->in[6];
        const float* w_rg_a = A->in[7];
        const float* b_rg_a = A->in[8];
        const float* w_rg_x = A->in[9];
        const float* b_rg_x = A->in[10];
        const float* lru_lambda = A->in[11];
 if (G == 256) rnn_phase(lds, vcu, lane, wave, rxb, ya, conv_w, conv_b, w_rg_a, b_rg_a, w_rg_x, b_rg_x, lru_lambda, (const bf16*)(A->ws + WS_ZERO)); }
#if MK_DUP23 == 1
    if (rep_ == 0) xcd_barrier(bar, wave == 0 && lane_id() == 0);
    }
#endif
    SEAM(3);
    if (IN(4)) {
        KArgs A = kargs(); const int lane = lane_id(), tid = wave * 64 + lane; (void)tid;
        bf16* qbuf = (bf16*)(A->ws + WS_Q);
        bf16* kbuf = (bf16*)(A->ws + WS_K);
        bf16* vbuf = (bf16*)(A->ws + WS_V);
        bf16* o0 = (bf16*)((unsigned char*)A->out + DO_O0);
        bf16* o1 = (bf16*)((unsigned char*)A->out + DO_O1);
        const float* rel_bias = A->in[17];
 if (G == 256) { for (int rep_ = 0; rep_ < MK_DUP_ATTN; ++rep_) attn_phase_diff(lds_, lds, vcu, tid, wave, qbuf, kbuf, vbuf, o0, o1, rel_bias); } }
    SEAM(4);
    if (IN(5)) {
        KArgs A = kargs(); const int lane = lane_id(), tid = wave * 64 + lane; (void)tid;
        const float* lq1 = A->in[12];
        const float* lk1 = A->in[13];
        const float* lq2 = A->in[14];
        const float* lk2 = A->in[15];
        const float* subln_w = A->in[16];
        bf16* o0 = (bf16*)((unsigned char*)A->out + DO_O0);
        bf16* o1 = (bf16*)((unsigned char*)A->out + DO_O1);
        bf16* ya = (bf16*)(A->ws + WS_YA);

        float s1 = lq1[lane] * lk1[lane], s2 = lq2[lane] * lk2[lane]; s1 = wave_sum(s1); s2 = wave_sum(s2);
        const float lamv = __expf(s1) - __expf(s2) + 0.2f;
        float sw[16];
#pragma unroll
        for (int i = 0; i < 16; ++i) sw[i] = subln_w[(lane * 16 + i) & 127] * 0.8f;
        for (int row = gw; row < MTOK; row += NGW) {
            const GAS v4u* p0 = (const GAS v4u*)(o0 + (size_t)row * 1024 + lane * 16); const GAS v4u* p1 = (const GAS v4u*)(o1 + (size_t)row * 1024 + lane * 16);
            GAS v4u* pa = (GAS v4u*)(ya + (size_t)row * 2048 + 1024 + lane * 16);
            float v[16]; float ss = 0.f; v4u agv[2];
#pragma unroll
            for (int hh = 0; hh < 2; ++hh) { const v4u a = p0[hh], bq = p1[hh]; agv[hh] = pa[hh];
                const unsigned aw[4] = {a.x, a.y, a.z, a.w}, bw[4] = {bq.x, bq.y, bq.z, bq.w};
#pragma unroll
                for (int e = 0; e < 4; ++e) { v[hh * 8 + 2 * e] = __uint_as_float(aw[e] << 16) - lamv * __uint_as_float(bw[e] << 16); v[hh * 8 + 2 * e + 1] = __uint_as_float(aw[e] & 0xffff0000u) - lamv * __uint_as_float(bw[e] & 0xffff0000u); } }
#pragma unroll
            for (int i = 0; i < 16; ++i) ss += v[i] * v[i];
            ss += __shfl_xor(ss, 1); ss += __shfl_xor(ss, 2); ss += __shfl_xor(ss, 4);
            const float rs = rsqrtf(ss * (1.f / 128.f) + LN_EPS);
#pragma unroll
            for (int hh = 0; hh < 2; ++hh) { const unsigned gwd[4] = {agv[hh].x, agv[hh].y, agv[hh].z, agv[hh].w}; v4u o;
                unsigned ow[4];
#pragma unroll
                for (int e = 0; e < 4; ++e) { const int i = hh * 8 + 2 * e; ow[e] = pk2(v[i] * rs * sw[i] * __uint_as_float(gwd[e] << 16), v[i + 1] * rs * sw[i + 1] * __uint_as_float(gwd[e] & 0xffff0000u)); }
                o.x = ow[0]; o.y = ow[1]; o.z = ow[2]; o.w = ow[3]; pa[hh] = o; }
        }
    }
    SEAM(5);
    if (IN(6)) {
        KArgs A = kargs(); const int lane = lane_id(), tid = wave * 64 + lane; (void)tid;
        bf16* ya = (bf16*)(A->ws + WS_YA);
        bf16* wcat_t = (bf16*)(A->ws + WS_WCAT);
        bf16* mgb = (bf16*)(A->ws + WS_MG);
        bf16* merged = (bf16*)(A->ws + WS_Q);

        pg8::Gemm g{ya, wcat_t, MTOK, DM, 2048}; pg8::StaticOrder S; S.init(MTOK, DM, G, (int)blockIdx.x);
        pg8::EpiMergeV E{mgb, merged};
        pg8::gemm_phase<pg8::EpiMergeV, pg8::StaticOrder, MK_ALIGN, MK_SP2>(lds + RING_OFF, g, S, E, tid);
    }
    SEAM(6);
    if (IN(7)) {
        KArgs A = kargs(); const int lane = lane_id(), tid = wave * 64 + lane; (void)tid;
        bf16* merged = (bf16*)(A->ws + WS_Q);
        bf16* wout_t = (bf16*)(A->ws + WS_WOUT);
        const float* x = A->in[0];
        float* modf = (float*)(A->ws + WS_MODF);
        float* outp = A->out;

        pg8::Gemm g{merged, wout_t, MTOK, DM, DM}; pg8::StaticOrder S; S.init(MTOK, DM, G, (int)blockIdx.x);
        pg8::EpiOutV E{x, modf, outp};
        pg8::gemm_phase<pg8::EpiOutV, pg8::StaticOrder, MK_ALIGN, MK_SP2>(lds + RING_OFF, g, S, E, tid);
    }
    SEAM(7);
    if (IN(8)) {
        KArgs A = kargs(); const int lane = lane_id(), tid = wave * 64 + lane; (void)tid;
        const float* ln_g = A->in[21];
        const float* ln_b = A->in[22];
        float* outp = A->out;

        f32x4 gg[4], bb[4];
#pragma unroll
        for (int j = 0; j < 4; ++j) { gg[j] = *(const GAS f32x4*)(ln_g + 256 * j + 4 * lane); bb[j] = *(const GAS f32x4*)(ln_b + 256 * j + 4 * lane); }
        for (int row = gw; row < MTOK; row += NGW) {
            GAS f32x4* p = (GAS f32x4*)(outp + (size_t)row * DM) + lane; f32x4 v[4]; float s = 0.f;
#pragma unroll
            for (int j = 0; j < 4; ++j) { v[j] = p[64 * j]; s += (v[j].x + v[j].y) + (v[j].z + v[j].w); }
            const float mean = wave_sum(s) * (1.f / DM); float s2 = 0.f;
#pragma unroll
            for (int j = 0; j < 4; ++j) { v[j] = v[j] - mean; s2 += (v[j].x * v[j].x + v[j].y * v[j].y) + (v[j].z * v[j].z + v[j].w * v[j].w); }
            const float rstd = rsqrtf(wave_sum(s2) * (1.f / DM) + LN_EPS);
#pragma unroll
            for (int j = 0; j < 4; ++j) p[64 * j] = v[j] * rstd * gg[j] + bb[j];
        }
    }
#undef IN
#undef SEAM
}

#ifndef MK_STEP
#define MK_STEP 4
#define MK_C0 6144
#define MK_C1 7168
#endif
extern "C" void kernel_launch(void* const* d_in, const int* in_sizes, int n_in, void* d_out, int out_size, void* d_ws, size_t ws_size, hipStream_t stream) {
    static int grid = 0;
    if (grid == 0) {
        if (n_in != 23 || out_size != MTOK * DM || ws_size < WS_END) { fprintf(stderr, "kernel_launch: unexpected shapes (n_in %d out %d ws %zu)\n", n_in, out_size, ws_size); grid = -1; return; }
        int dev = 0, cus = 0;
        if (hipGetDevice(&dev) != hipSuccess || hipDeviceGetAttribute(&cus, hipDeviceAttributeMultiprocessorCount, dev) != hipSuccess) { grid = -1; return; }
        if (hipFuncSetAttribute((const void*)mk_fwd, hipFuncAttributeMaxDynamicSharedMemorySize, LDS_BYTES) != hipSuccess) { fprintf(stderr, "kernel_launch: hipFuncSetAttribute failed\n"); grid = -1; return; }
        (void)hipGetLastError();
        grid = cus;
        if (grid != 256) { fprintf(stderr, "kernel_launch: built for 256 CUs, found %d\n", grid); }
    }
    if (grid < 0) return;
    (void)hipMemsetAsync((char*)d_ws + WS_CTL, 0, CTL_ZERO_BYTES, stream);
    Args a{};
    for (int i = 0; i < 23; ++i) a.in[i] = (const float*)d_in[i];
    a.out = (float*)d_out; a.ws = (unsigned char*)d_ws;
#define MK_RUN(lo_, hi_) do { a.ph_lo = (lo_); a.ph_hi = (hi_); hipLaunchKernelGGL(mk_fwd, dim3(grid), dim3(NWAVES * 64), LDS_BYTES, stream, a); } while (0)
    unsigned char* ws = (unsigned char*)d_ws; unsigned char* dob = (unsigned char*)d_out;
    bf16_t* ya = (bf16_t*)(ws + WS_YA); bf16_t* qb = (bf16_t*)(ws + WS_Q); bf16_t* kb = (bf16_t*)(ws + WS_K); bf16_t* vb = (bf16_t*)(ws + WS_V);
    bf16_t* rx = (bf16_t*)(dob + DO_RX); bf16_t* o0 = (bf16_t*)(dob + DO_O0); bf16_t* o1 = (bf16_t*)(dob + DO_O1);
    const float* conv_w = (const float*)d_in[5]; const float* conv_b = (const float*)d_in[6];
    const float* w_rg_a = (const float*)d_in[7]; const float* b_rg_a = (const float*)d_in[8]; const float* w_rg_x = (const float*)d_in[9]; const float* b_rg_x = (const float*)d_in[10];
    const float* lru_lambda = (const float*)d_in[11]; const float* lq1 = (const float*)d_in[12]; const float* lk1 = (const float*)d_in[13]; const float* lq2 = (const float*)d_in[14]; const float* lk2 = (const float*)d_in[15];
    const float* subln_w = (const float*)d_in[16]; const float* rel_bias = (const float*)d_in[17]; const float* ln_g = (const float*)d_in[21]; const float* ln_b = (const float*)d_in[22];
#if MK_STEP == 1
    MK_RUN(0, 1); MK_RUN(1, 2); MK_RUN(2, 3);
    k_rnn_simple<<<NB * 16, 64, 0, stream>>>(rx, ya, conv_w, conv_b, w_rg_a, b_rg_a, w_rg_x, b_rg_x, lru_lambda);
    k_attn_simple<<<NB * 8 * 2 * 32, 256, 0, stream>>>(qb, kb, vb, o0, o1, rel_bias);
    k_combine<<<MTOK / 4, 256, 0, stream>>>(o0, o1, ya, lq1, lk1, lq2, lk2, subln_w);
    MK_RUN(6, 7); MK_RUN(7, 8);
    k_ln<<<MTOK / 4, 256, 0, stream>>>((float*)d_out, ln_g, ln_b);
#elif MK_STEP == 11
    MK_RUN(0, 1); MK_RUN(1, 2); MK_RUN(2, 3);
    k_rnn_simple<<<NB * 16, 64, 0, stream>>>(rx, ya, conv_w, conv_b, w_rg_a, b_rg_a, w_rg_x, b_rg_x, lru_lambda);
    k_attn_simple<<<NB * 8 * 2 * 32, 256, 0, stream>>>(qb, kb, vb, o0, o1, rel_bias);
    k_combine<<<MTOK / 4, 256, 0, stream>>>(o0, o1, ya, lq1, lk1, lq2, lk2, subln_w);
    { EpiMerge e{(bf16_t*)(ws + WS_MG), qb}; k_gemm_simple<EpiMerge, true><<<dim3(DM / 64, MTOK / 64), 256, 0, stream>>>(ya, (bf16_t*)(ws + WS_WCAT), MTOK, DM, 2048, e); }
    { EpiOut e{(const float*)d_in[0], (const float*)(ws + WS_MODF), (float*)d_out}; k_gemm_simple<EpiOut, false><<<dim3(DM / 64, MTOK / 64), 256, 0, stream>>>(qb, (bf16_t*)(ws + WS_WOUT), MTOK, DM, DM, e); }
    k_ln<<<MTOK / 4, 256, 0, stream>>>((float*)d_out, ln_g, ln_b);
#elif MK_STEP == 12 || MK_STEP == 13
    MK_RUN(0, 1);
#if MK_STEP == 13
    MK_RUN(1, 2);
#else
    k_u<<<(unsigned)(((size_t)MTOK * DM + 255) / 256), 256, 0, stream>>>((const float*)d_in[0], (const float*)(ws + WS_MODF), (bf16_t*)(dob + DO_U));
#endif
    { EpiProj e{rx, ya, qb, kb, vb, (bf16_t*)(ws + WS_MG)}; k_gemm_simple<EpiProj, false><<<dim3(NIN / 64, MTOK / 64), 256, 0, stream>>>((bf16_t*)(dob + DO_U), (bf16_t*)(ws + WS_WIN), MTOK, NIN, DM, e); }
    k_rnn_simple<<<NB * 16, 64, 0, stream>>>(rx, ya, conv_w, conv_b, w_rg_a, b_rg_a, w_rg_x, b_rg_x, lru_lambda);
    k_attn_simple<<<NB * 8 * 2 * 32, 256, 0, stream>>>(qb, kb, vb, o0, o1, rel_bias);
    k_combine<<<MTOK / 4, 256, 0, stream>>>(o0, o1, ya, lq1, lk1, lq2, lk2, subln_w);
    { EpiMerge e{(bf16_t*)(ws + WS_MG), qb}; k_gemm_simple<EpiMerge, true><<<dim3(DM / 64, MTOK / 64), 256, 0, stream>>>(ya, (bf16_t*)(ws + WS_WCAT), MTOK, DM, 2048, e); }
    { EpiOut e{(const float*)d_in[0], (const float*)(ws + WS_MODF), (float*)d_out}; k_gemm_simple<EpiOut, false><<<dim3(DM / 64, MTOK / 64), 256, 0, stream>>>(qb, (bf16_t*)(ws + WS_WOUT), MTOK, DM, DM, e); }
    k_ln<<<MTOK / 4, 256, 0, stream>>>((float*)d_out, ln_g, ln_b);
#elif MK_STEP == 14
    MK_RUN(0, 1); MK_RUN(1, 2);
    { EpiProj e{rx, ya, qb, kb, vb, (bf16_t*)(ws + WS_MG)}; k_gemm_simple<EpiProj, false><<<dim3(NIN / 64, MTOK / 64), 256, 0, stream>>>((bf16_t*)(dob + DO_U), (bf16_t*)(ws + WS_WIN), MTOK, NIN, DM, e); }
    k_rnn_simple<<<NB * 16, 64, 0, stream>>>(rx, ya, conv_w, conv_b, w_rg_a, b_rg_a, w_rg_x, b_rg_x, lru_lambda);
    k_attn_simple<<<NB * 8 * 2 * 32, 256, 0, stream>>>(qb, kb, vb, o0, o1, rel_bias);
    k_combine<<<MTOK / 4, 256, 0, stream>>>(o0, o1, ya, lq1, lk1, lq2, lk2, subln_w);
    MK_RUN(6, 7); MK_RUN(7, 8);
    k_ln<<<MTOK / 4, 256, 0, stream>>>((float*)d_out, ln_g, ln_b);
#elif MK_STEP == 15
    MK_RUN(0, 1); MK_RUN(1, 2); MK_RUN(2, 3);
    { EpiProj e{rx, ya, qb, kb, vb, (bf16_t*)(ws + WS_MG)}; k_gemm_simple<EpiProj, false><<<dim3((MK_C1 - MK_C0) / 64, MTOK / 64), 256, 0, stream>>>((bf16_t*)(dob + DO_U), (bf16_t*)(ws + WS_WIN), MTOK, NIN, DM, e, MK_C0 / 64); }
    k_rnn_simple<<<NB * 16, 64, 0, stream>>>(rx, ya, conv_w, conv_b, w_rg_a, b_rg_a, w_rg_x, b_rg_x, lru_lambda);
    k_attn_simple<<<NB * 8 * 2 * 32, 256, 0, stream>>>(qb, kb, vb, o0, o1, rel_bias);
    k_combine<<<MTOK / 4, 256, 0, stream>>>(o0, o1, ya, lq1, lk1, lq2, lk2, subln_w);
    MK_RUN(6, 7); MK_RUN(7, 8);
    k_ln<<<MTOK / 4, 256, 0, stream>>>((float*)d_out, ln_g, ln_b);
#elif MK_STEP == 2
    MK_RUN(0, 1); MK_RUN(1, 2); MK_RUN(2, 3);
    k_rnn_simple<<<NB * 16, 64, 0, stream>>>(rx, ya, conv_w, conv_b, w_rg_a, b_rg_a, w_rg_x, b_rg_x, lru_lambda);
    MK_RUN(4, 5); MK_RUN(5, 6); MK_RUN(6, 7); MK_RUN(7, 8); MK_RUN(8, 9);
#elif MK_STEP == 3
    for (int p = 0; p < N_PHASES; ++p) MK_RUN(p, p + 1);
#else
    MK_RUN(0, N_PHASES);
#endif
}
```

```cpp
#include <hip/hip_runtime.h>
#include <cstdio>
#include <cstdint>
#include <cmath>

typedef unsigned short bf16_t;
#ifndef MK_ROT
#define MK_ROT 8
#endif
constexpr int NB = 4, SEQ = 8192, DM = 1024, MTOK = NB * SEQ, NIN = 8192;
constexpr float LN_EPS = 1e-5f;
constexpr float ALPHA = 1.189207115002721f;
constexpr float LOG2E = 1.4426950408889634f;
constexpr float C2 = 0.125f * LOG2E;

__device__ __forceinline__ float bf2f_(bf16_t v) { return __uint_as_float(((unsigned)v) << 16); }
__device__ __forceinline__ bf16_t f2bf_(float f) { unsigned u = __float_as_uint(f); return (bf16_t)((u + 0x7fffu + ((u >> 16) & 1u)) >> 16); }
__device__ __forceinline__ float sigmoidf_(float x) { return 1.f / (1.f + __expf(-x)); }
__device__ __forceinline__ float siluf_(float x) { return x / (1.f + __expf(-x)); }

constexpr size_t MiB = 1u << 20;
constexpr size_t WS_CTL = 0;
constexpr size_t WS_MODF = 1 * MiB + 512 * 1024;
constexpr size_t CTL_ZERO_BYTES = 512 * 1024;
constexpr size_t WS_ZERO = 1024;
constexpr size_t WS_WIN = 2 * MiB;
constexpr size_t WS_WCAT = 18 * MiB;
constexpr size_t WS_WOUT = 22 * MiB;
constexpr size_t WS_YA = 24 * MiB;
constexpr size_t WS_Q = 152 * MiB;
constexpr size_t WS_K = 216 * MiB;
constexpr size_t WS_V = 280 * MiB;
constexpr size_t WS_MG = 344 * MiB;
constexpr size_t WS_END = 472 * MiB;
constexpr size_t DO_U = 0, DO_RX = 64 * MiB, DO_O0 = 0, DO_O1 = 64 * MiB;

__global__ void k_mod(const float* __restrict__ c, const float* __restrict__ w_ada, const float* __restrict__ b_ada, float* __restrict__ modf) {
    const int idx = blockIdx.x * blockDim.x + threadIdx.x; if (idx >= NB * 3072) return;
    const int b = idx / 3072, e = idx % 3072; float acc = 0.f;
    for (int k = 0; k < DM; ++k) acc += siluf_(c[b * DM + k]) * w_ada[(size_t)k * 3072 + e];
    modf[idx] = acc + b_ada[e];
}
__global__ void k_u(const float* __restrict__ x, const float* __restrict__ modf, bf16_t* __restrict__ u) {
    const size_t idx = (size_t)blockIdx.x * blockDim.x + threadIdx.x; if (idx >= (size_t)MTOK * DM) return;
    const int d = (int)(idx % DM); const int b = (int)(idx / ((size_t)SEQ * DM));
    u[idx] = f2bf_(x[idx] * (1.f + modf[b * 3072 + 1024 + d]) + modf[b * 3072 + d]);
}
__global__ void k_transpose(const float* __restrict__ W, int K, int N, bf16_t* __restrict__ WT, int ldt, int koff) {
    const size_t idx = (size_t)blockIdx.x * blockDim.x + threadIdx.x; if (idx >= (size_t)K * N) return;
    const int k = (int)(idx / N), n = (int)(idx % N);
    WT[(size_t)n * ldt + koff + k] = f2bf_(W[idx]);
}

struct EpiProj {
    bf16_t *rx, *ya, *q, *k, *v, *mg;
    __device__ __forceinline__ void mid(int, int, float&) const {}
    __device__ __forceinline__ void operator()(int m, int n, float a) const {
        const int g = n >> 10, c = n & 1023;
        if (g == 0) rx[(size_t)m * 1024 + c] = f2bf_(a);
        else if (g == 1) ya[(size_t)m * 2048 + c] = f2bf_(siluf_(a));
        else if (g == 2) q[(size_t)m * 1024 + c] = f2bf_(a * C2);
        else if (g == 3) k[(size_t)m * 1024 + c] = f2bf_(a);
        else if (g == 4) v[(size_t)m * 1024 + c] = f2bf_(a);
        else if (g == 5) ya[(size_t)m * 2048 + 1024 + c] = f2bf_(siluf_(a));
        else mg[(size_t)m * 2048 + (n - 6144)] = f2bf_(sigmoidf_(a));
    }
};
struct EpiMerge {
    const bf16_t* mg; bf16_t* merged;
    __device__ __forceinline__ void mid(int m, int n, float& a) const { a *= bf2f_(mg[(size_t)m * 2048 + n]) / bf2f_(mg[(size_t)m * 2048 + 1024 + n]); }
    __device__ __forceinline__ void operator()(int m, int n, float a) const { merged[(size_t)m * 1024 + n] = f2bf_(a * bf2f_(mg[(size_t)m * 2048 + 1024 + n])); }
};
struct EpiOut {
    const float* x; const float* modf; float* z;
    __device__ __forceinline__ void mid(int, int, float&) const {}
    __device__ __forceinline__ void operator()(int m, int n, float a) const { const int b = m / SEQ; z[(size_t)m * 1024 + n] = ALPHA * x[(size_t)m * 1024 + n] + modf[b * 3072 + 2048 + n] * a; }
};

template <class Epi, bool MID>
__global__ void __launch_bounds__(256) k_gemm_simple(const bf16_t* __restrict__ A, const bf16_t* __restrict__ Bt, int M, int N, int K, Epi epi, int nblk0 = 0) {
    __shared__ float As[16][68], Bs[16][68];
    const int tid = threadIdx.x, tx = tid & 15, ty = tid >> 4;
    const int m0 = blockIdx.y * 64, n0 = (blockIdx.x + nblk0) * 64;
    float acc[4][4];
#pragma unroll
    for (int i = 0; i < 4; ++i)
#pragma unroll
        for (int j = 0; j < 4; ++j) acc[i][j] = 0.f;
    for (int k0 = 0; k0 < K; k0 += 16) {
        if (MID && k0 == K / 2) {
#pragma unroll
            for (int i = 0; i < 4; ++i)
#pragma unroll
                for (int j = 0; j < 4; ++j) epi.mid(m0 + ty * 4 + i, n0 + tx * 4 + j, acc[i][j]);
        }
#pragma unroll
        for (int e = 0; e < 4; ++e) {
            const int idx = tid + e * 256, r = idx >> 4, kk = idx & 15;
            As[kk][r] = bf2f_(A[(size_t)(m0 + r) * K + k0 + kk]);
            Bs[kk][r] = bf2f_(Bt[(size_t)(n0 + r) * K + k0 + kk]);
        }
        __syncthreads();
#pragma unroll
        for (int kk = 0; kk < 16; ++kk) {
            float a[4], b[4];
#pragma unroll
            for (int i = 0; i < 4; ++i) { a[i] = As[kk][ty * 4 + i]; b[i] = Bs[kk][tx * 4 + i]; }
#pragma unroll
            for (int i = 0; i < 4; ++i)
#pragma unroll
                for (int j = 0; j < 4; ++j) acc[i][j] += a[i] * b[j];
        }
        __syncthreads();
    }
#pragma unroll
    for (int i = 0; i < 4; ++i)
#pragma unroll
        for (int j = 0; j < 4; ++j) epi(m0 + ty * 4 + i, n0 + tx * 4 + j, acc[i][j]);
}

__global__ void __launch_bounds__(64) k_rnn_simple(const bf16_t* __restrict__ rx, bf16_t* __restrict__ ya, const float* __restrict__ conv_w, const float* __restrict__ conv_b,
                                                   const float* __restrict__ w_a, const float* __restrict__ b_a, const float* __restrict__ w_x, const float* __restrict__ b_x, const float* __restrict__ lam) {
    __shared__ float xs[64];
    const int b = blockIdx.x / 16, hb = blockIdx.x % 16, j = threadIdx.x, ch = hb * 64 + j;
    float wa[64], wx[64];
#pragma unroll
    for (int i = 0; i < 64; ++i) { wa[i] = w_a[(size_t)hb * 4096 + i * 64 + j]; wx[i] = w_x[(size_t)hb * 4096 + i * 64 + j]; }
    const float cw0 = conv_w[ch], cw1 = conv_w[1024 + ch], cw2 = conv_w[2048 + ch], cw3 = conv_w[3072 + ch], cb = conv_b[ch];
    const float ba = b_a[ch], bx = b_x[ch];
    const float L = lam[ch]; const float sp = log1pf(expf(-L));
    const float logu = -8.0f * sp;
    float x1 = 0.f, x2 = 0.f, x3 = 0.f, h = 0.f;
    for (int t = 0; t < SEQ; ++t) {
        const size_t row = (size_t)b * SEQ + t;
        const float x0 = bf2f_(rx[row * 1024 + ch]);
        const float xc = cw0 * x3 + cw1 * x2 + cw2 * x1 + cw3 * x0 + cb;
        x3 = x2; x2 = x1; x1 = x0;
        __syncthreads(); xs[j] = xc; __syncthreads();
        float ra = ba, ri = bx;
#pragma unroll
        for (int i = 0; i < 64; ++i) { const float xv = xs[i]; ra += xv * wa[i]; ri += xv * wx[i]; }
        const float r = sigmoidf_(ra), ig = sigmoidf_(ri);
        const float la = r * logu; const float a = expf(la); const float bin = sqrtf(-expm1f(2.f * la)) * (ig * xc);
        h = a * h + bin;
        const size_t o = row * 2048 + ch;
        ya[o] = f2bf_(h * bf2f_(ya[o]));
    }
}

__device__ __forceinline__ int t5_bucket(int n) {
    if (n < 16) return n;
    int l = 16 + (int)(logf((float)n / 16.0f) / 2.0794415416798357f * 16.0f);
    return l < 31 ? l : 31;
}
__global__ void __launch_bounds__(256) k_attn_simple(const bf16_t* __restrict__ Q, const bf16_t* __restrict__ K, const bf16_t* __restrict__ V, bf16_t* __restrict__ O0, bf16_t* __restrict__ O1, const float* __restrict__ rel_bias) {
    __shared__ float tab[128];
    const int qb = blockIdx.x % 32, c = (blockIdx.x / 32) % 2, h = (blockIdx.x / 64) % 8, b = blockIdx.x / 512;
    if (threadIdx.x < 128) tab[threadIdx.x] = rel_bias[t5_bucket(threadIdx.x) * 8 + h] * LOG2E;
    __syncthreads();
    const float far = rel_bias[31 * 8 + h] * LOG2E;
    const int qi = qb * 256 + threadIdx.x; const size_t rowq = (size_t)b * SEQ + qi;
    float q[64], o[128];
#pragma unroll
    for (int d = 0; d < 64; ++d) q[d] = bf2f_(Q[rowq * 1024 + h * 128 + c * 64 + d]);
#pragma unroll
    for (int e = 0; e < 128; ++e) o[e] = 0.f;
    float m = -INFINITY, l = 0.f;
    const int kend = qb * 256 + 255;
    for (int kk = 0; kk <= kend; ++kk) {
        const size_t rowk = (size_t)b * SEQ + kk;
        const bf16_t* kp = K + rowk * 1024 + h * 128 + c * 64;
        float s = 0.f;
#pragma unroll
        for (int d = 0; d < 64; ++d) s += q[d] * bf2f_(kp[d]);
        const int n = qi - kk;
        if (n >= 0) {
            s += (n < 128) ? tab[n] : far;
            if (s > m) { const float f = exp2f(m - s); l *= f;
#pragma unroll
                for (int e = 0; e < 128; ++e) o[e] *= f;
                m = s; }
            const float p = exp2f(s - m); l += p;
            const bf16_t* vp = V + rowk * 1024 + h * 128;
#pragma unroll
            for (int e = 0; e < 128; ++e) o[e] += p * bf2f_(vp[e]);
        }
    }
    bf16_t* Op = (c == 0 ? O0 : O1) + rowq * 1024 + h * 128; const float il = 1.f / l;
#pragma unroll
    for (int e = 0; e < 128; ++e) Op[e] = f2bf_(o[e] * il);
}

__global__ void __launch_bounds__(256) k_combine(const bf16_t* __restrict__ O0, const bf16_t* __restrict__ O1, bf16_t* __restrict__ ya, const float* __restrict__ lq1, const float* __restrict__ lk1,
                                                 const float* __restrict__ lq2, const float* __restrict__ lk2, const float* __restrict__ subw) {
    const int lane = threadIdx.x & 63, row = blockIdx.x * 4 + (threadIdx.x >> 6);
    float s1 = lq1[lane] * lk1[lane], s2 = lq2[lane] * lk2[lane];
#pragma unroll
    for (int o = 1; o < 64; o <<= 1) { s1 += __shfl_xor(s1, o); s2 += __shfl_xor(s2, o); }
    const float lam = expf(s1) - expf(s2) + 0.2f;
    const int col = lane * 16;
    float v[16]; float ss = 0.f;
#pragma unroll
    for (int i = 0; i < 16; ++i) { v[i] = bf2f_(O0[(size_t)row * 1024 + col + i]) - lam * bf2f_(O1[(size_t)row * 1024 + col + i]); ss += v[i] * v[i]; }
    ss += __shfl_xor(ss, 1); ss += __shfl_xor(ss, 2); ss += __shfl_xor(ss, 4);
    const float rs = rsqrtf(ss * (1.f / 128.f) + LN_EPS) * 0.8f;
#pragma unroll
    for (int i = 0; i < 16; ++i) { const size_t o = (size_t)row * 2048 + 1024 + col + i; ya[o] = f2bf_(v[i] * rs * subw[(col + i) & 127] * bf2f_(ya[o])); }
}

__global__ void __launch_bounds__(256) k_ln(float* __restrict__ z, const float* __restrict__ g, const float* __restrict__ bta) {
    const int lane = threadIdx.x & 63, row = blockIdx.x * 4 + (threadIdx.x >> 6);
    float4* p = (float4*)(z + (size_t)row * 1024) + lane; float4 v[4]; float s = 0.f;
#pragma unroll
    for (int j = 0; j < 4; ++j) { v[j] = p[64 * j]; s += (v[j].x + v[j].y) + (v[j].z + v[j].w); }
#pragma unroll
    for (int o = 1; o < 64; o <<= 1) s += __shfl_xor(s, o);
    const float mean = s * (1.f / 1024.f); float q = 0.f;
#pragma unroll
    for (int j = 0; j < 4; ++j) { v[j].x -= mean; v[j].y -= mean; v[j].z -= mean; v[j].w -= mean; q += (v[j].x * v[j].x + v[j].y * v[j].y) + (v[j].z * v[j].z + v[j].w * v[j].w); }
#pragma unroll
    for (int o = 1; o < 64; o <<= 1) q += __shfl_xor(q, o);
    const float rstd = rsqrtf(q * (1.f / 1024.f) + LN_EPS);
#pragma unroll
    for (int j = 0; j < 4; ++j) { const float4 gg = ((const float4*)g)[lane + 64 * j], bb = ((const float4*)bta)[lane + 64 * j];
        float4 o; o.x = v[j].x * rstd * gg.x + bb.x; o.y = v[j].y * rstd * gg.y + bb.y; o.z = v[j].z * rstd * gg.z + bb.z; o.w = v[j].w * rstd * gg.w + bb.w; p[64 * j] = o; }
}

namespace pg8 {
#define PG8_LAS __attribute__((address_space(3)))
typedef unsigned short bf16_t;
typedef short bf16x8 __attribute__((ext_vector_type(8)));
typedef float f32x4 __attribute__((ext_vector_type(4)));
typedef unsigned u32x4 __attribute__((ext_vector_type(4)));
constexpr int BM = 256, BK = 64, HALF = 128, HTB = HALF * BK * 2  , STAGE_BYTES = 8 * HTB, NXCD = 8, WGM = 8;

__host__ __device__ __forceinline__ int lds_byte(int r, int c) { const int st = (r >> 4) * 2 + (c >> 5), rr = r & 15, cc = c & 31, ob = rr * 64 + cc * 2; return st * 1024 + (ob ^ (((ob >> 9) & 1) << 5)); }
__host__ __device__ __forceinline__ void stage_rc(int b, int& R, int& C) { const int st = b / 1024, sb = b % 1024, swz = sb ^ (((sb >> 9) & 1) << 5); R = (st >> 1) * 16 + swz / 64; C = (st & 1) * 32 + (swz % 64) / 2; }
__host__ __device__ __forceinline__ int perm32(int rho) { const int n = rho >> 4, i = rho & 15; return 8 * (i >> 2) + 4 * n + (i & 3); }

struct Unit { int pm, pn; };
struct Gemm { const bf16_t* A; const bf16_t* Bt; int M, N, K; };

struct StaticOrder {
    int nM, nN, nwg, G, c;
    __host__ __device__ void init(int M, int N, int G_, int c_) { nM = M / BM; nN = N / BM; nwg = nM * nN; G = G_; c = c_; }
    __host__ __device__ bool next(int i, Unit& u) const {
        const long L = (long)i * G + c; if (L >= nwg) return false;
        int wgid = (int)L; { const int q = nwg / NXCD, r = nwg % NXCD, xcd = wgid % NXCD, off = wgid / NXCD; wgid = (xcd < r ? xcd * (q + 1) : r * (q + 1) + (xcd - r) * q) + off; }
        const int nig = WGM * nN, gid = wgid / nig, fm = gid * WGM, gsz = (nM - fm) < WGM ? (nM - fm) : WGM;
        u.pm = fm + ((wgid % nig) % gsz); u.pn = (wgid % nig) / gsz; return true;
    }
    __device__ __forceinline__ void a_ready(const Unit&) const {}
    __device__ __forceinline__ void done(const Unit&) const {}
};


typedef float f32x2_cv __attribute__((ext_vector_type(2))); typedef __bf16 bf16x2_cv __attribute__((ext_vector_type(2)));
__device__ __forceinline__ unsigned cvt_pk_bf16(float lo, float hi) { f32x2_cv v = {lo, hi}; bf16x2_cv b = __builtin_convertvector(v, bf16x2_cv); return __builtin_bit_cast(unsigned, b); }
__device__ __forceinline__ float fast_sigmoid(float x) { return __builtin_amdgcn_rcpf(1.0f + __builtin_amdgcn_exp2f(-1.4426950408889634f * x)); }
__device__ __forceinline__ float bflo(unsigned w) { return __uint_as_float(w << 16); }
__device__ __forceinline__ float bfhi(unsigned w) { return __uint_as_float(w & 0xffff0000u); }

struct EpiProjV {
    static constexpr bool PERM = true, AFTER_DRAIN = false, HAS_MID = false;
    unsigned char* ws; unsigned char* dob;
    template <int ACT> __device__ __forceinline__ void run(const f32x4 (&acc)[2][2][4][2], bf16_t* base, int ldc, int row0, float sc) const {
#pragma unroll
        for (int ai = 0; ai < 2; ++ai)
#pragma unroll
            for (int m = 0; m < 4; ++m) { bf16_t* rowp = base + (size_t)(row0 + ai * HALF + m * 16) * ldc;
#pragma unroll
                for (int bj = 0; bj < 2; ++bj) { f32x4 v0 = acc[ai][bj][m][0], v1 = acc[ai][bj][m][1];
                    if (ACT == 0) { v0 = v0 * sc; v1 = v1 * sc; }
                    if (ACT == 1) {
#pragma unroll
                        for (int e = 0; e < 4; ++e) { v0[e] = v0[e] * fast_sigmoid(v0[e]); v1[e] = v1[e] * fast_sigmoid(v1[e]); } }
                    if (ACT == 2) {
#pragma unroll
                        for (int e = 0; e < 4; ++e) { v0[e] = fast_sigmoid(v0[e]); v1[e] = fast_sigmoid(v1[e]); } }
                    u32x4 w; w.x = cvt_pk_bf16(v0[0], v0[1]); w.y = cvt_pk_bf16(v0[2], v0[3]); w.z = cvt_pk_bf16(v1[0], v1[1]); w.w = cvt_pk_bf16(v1[2], v1[3]);
                    *(u32x4*)(rowp + bj * HALF) = w; } }
    }
    __device__ __forceinline__ void operator()(const f32x4 (&acc)[2][2][4][2], const Unit& u, int wr, int wc, int fr, int fq) const {
        const int g = u.pn >> 2, colt = (u.pn & 3) * BM + wc * 32 + 8 * fq; int row0 = u.pm * BM + wr * 64 + fr; asm volatile("" : "+v"(row0));
        const size_t goff = (g == 0) ? DO_RX : (g == 1) ? WS_YA : (g == 2) ? WS_Q : (g == 3) ? WS_K : (g == 4) ? WS_V : (g == 5) ? WS_YA + 2048 : (g == 6) ? WS_MG : WS_MG + 2048;
        bf16_t* base = (bf16_t*)((g == 0 ? dob : ws) + goff) + colt;
        const int ldc = (g == 1 || g >= 5) ? 2048 : 1024;
        if (g == 1 || g == 5) run<1>(acc, base, ldc, row0, 1.0f);
        else if (g >= 6) run<2>(acc, base, ldc, row0, 1.0f);
        else run<0>(acc, base, ldc, row0, g == 2 ? C2 : 1.0f);
    }
};

struct EpiMergeV {
    static constexpr bool PERM = true, AFTER_DRAIN = false, HAS_MID = true;
    const bf16_t* mg; bf16_t* merged;
    __device__ __forceinline__ void mid(f32x4 (&acc)[2][2][4][2], const Unit& u, int wr, int wc, int fr, int fq) const {
        const int col0 = u.pn * BM + wc * 32 + 8 * fq; int row0 = u.pm * BM + wr * 64 + fr; asm volatile("" : "+v"(row0));
#pragma unroll
        for (int ai = 0; ai < 2; ++ai)
#pragma unroll
            for (int m = 0; m < 4; ++m) { const bf16_t* rowp = mg + (size_t)(row0 + ai * HALF + m * 16) * 2048 + col0;
#pragma unroll
                for (int bj = 0; bj < 2; ++bj) { const u32x4 a = *(const u32x4*)(rowp + bj * HALF), b = *(const u32x4*)(rowp + 1024 + bj * HALF);
                    f32x4 r0, r1;
                    r0[0] = bflo(a.x) * __builtin_amdgcn_rcpf(bflo(b.x)); r0[1] = bfhi(a.x) * __builtin_amdgcn_rcpf(bfhi(b.x)); r0[2] = bflo(a.y) * __builtin_amdgcn_rcpf(bflo(b.y)); r0[3] = bfhi(a.y) * __builtin_amdgcn_rcpf(bfhi(b.y));
                    r1[0] = bflo(a.z) * __builtin_amdgcn_rcpf(bflo(b.z)); r1[1] = bfhi(a.z) * __builtin_amdgcn_rcpf(bfhi(b.z)); r1[2] = bflo(a.w) * __builtin_amdgcn_rcpf(bflo(b.w)); r1[3] = bfhi(a.w) * __builtin_amdgcn_rcpf(bfhi(b.w));
                    acc[ai][bj][m][0] = acc[ai][bj][m][0] * r0; acc[ai][bj][m][1] = acc[ai][bj][m][1] * r1; } }
    }
    __device__ __forceinline__ void operator()(const f32x4 (&acc)[2][2][4][2], const Unit& u, int wr, int wc, int fr, int fq) const {
        const int col0 = u.pn * BM + wc * 32 + 8 * fq; int row0 = u.pm * BM + wr * 64 + fr; asm volatile("" : "+v"(row0));
#pragma unroll
        for (int ai = 0; ai < 2; ++ai)
#pragma unroll
            for (int m = 0; m < 4; ++m) { const size_t r = (size_t)(row0 + ai * HALF + m * 16);
#pragma unroll
                for (int bj = 0; bj < 2; ++bj) { const u32x4 b = *(const u32x4*)(mg + r * 2048 + 1024 + col0 + bj * HALF);
                    f32x4 v0 = acc[ai][bj][m][0], v1 = acc[ai][bj][m][1];
                    v0[0] *= bflo(b.x); v0[1] *= bfhi(b.x); v0[2] *= bflo(b.y); v0[3] *= bfhi(b.y); v1[0] *= bflo(b.z); v1[1] *= bfhi(b.z); v1[2] *= bflo(b.w); v1[3] *= bfhi(b.w);
                    u32x4 w; w.x = cvt_pk_bf16(v0[0], v0[1]); w.y = cvt_pk_bf16(v0[2], v0[3]); w.z = cvt_pk_bf16(v1[0], v1[1]); w.w = cvt_pk_bf16(v1[2], v1[3]);
                    *(u32x4*)(merged + r * 1024 + col0 + bj * HALF) = w; } }
    }
};

struct EpiOutV {
    static constexpr bool PERM = false, AFTER_DRAIN = false, HAS_MID = false;
    const float* x; const float* modf; float* z;
    __device__ __forceinline__ void operator()(const f32x4 (&acc)[2][2][4][2], const Unit& u, int wr, int wc, int fr, int fq) const {
        const int col0 = u.pn * BM + wc * 32 + 4 * fq, b = (u.pm * BM) / SEQ; int row0 = u.pm * BM + wr * 64 + fr; asm volatile("" : "+v"(row0));
        f32x4 gv[2][2];
#pragma unroll
        for (int bj = 0; bj < 2; ++bj)
#pragma unroll
            for (int n = 0; n < 2; ++n) gv[bj][n] = *(const f32x4*)(modf + b * 3072 + 2048 + col0 + bj * HALF + n * 16);
#pragma unroll
        for (int ai = 0; ai < 2; ++ai)
#pragma unroll
            for (int m = 0; m < 4; ++m) { const size_t off = (size_t)(row0 + ai * HALF + m * 16) * 1024 + col0;
#pragma unroll
                for (int bj = 0; bj < 2; ++bj)
#pragma unroll
                    for (int n = 0; n < 2; ++n) { const f32x4 xv = *(const f32x4*)(x + off + bj * HALF + n * 16);
                        *(f32x4*)(z + off + bj * HALF + n * 16) = xv * ALPHA + gv[bj][n] * acc[ai][bj][m][n]; } }
    }
};

template <class Epi, class Sched, bool ALIGN_EPI = false, bool SP2 = false>
__device__ __forceinline__ void gemm_phase(PG8_LAS unsigned char* lds, const Gemm g, const Sched& S, const Epi& E, const int tid_in) {
    const int tid = tid_in, wid = __builtin_amdgcn_readfirstlane(tid >> 6), lane = tid & 63, wr = wid >> 2, wc = wid & 3, fr = lane & 15, fq = lane >> 4;
    const int K = g.K, nt = K / BK;
    unsigned voffA[2], voffB[2];
#pragma unroll
    for (int i = 0; i < 2; ++i) { int R, C; stage_rc(tid * 16 + i * 8192, R, C); const int Rb = Epi::PERM ? ((R & ~31) + perm32(R & 31)) : R;
        voffA[i] = (unsigned)(R * K + C) * 2u; voffB[i] = (unsigned)(Rb * K + C) * 2u; }
    const size_t kstep = (size_t)(BK * 2);
    const size_t hstep = (size_t)HALF * K * 2;
    const size_t tstep = 2 * hstep;
    const unsigned ldsw = (unsigned)wid * 1024u;
    const int aoff = lds_byte(wr * 64 + fr, fq * 8), boff = lds_byte(wc * 32 + fr, fq * 8);
#define PG8_SA(b, h) (((b) * 2 + (h)) * HTB)
#define PG8_SB(b, h) ((4 + (b) * 2 + (h)) * HTB)
#define PG8_STAGE(bufoff, gbase, voff) do { _Pragma("unroll") for (int _i = 0; _i < 2; ++_i) \
        __builtin_amdgcn_global_load_lds((const unsigned*)((const char*)(gbase) + (voff)[_i]), (PG8_LAS unsigned*)(lds + (bufoff) + ldsw + _i * 8192), 16, 0, 0); } while (0)
#define PG8_LDA(dst, b, h) do { _Pragma("unroll") for (int m = 0; m < 4; ++m) _Pragma("unroll") for (int k = 0; k < 2; ++k) dst[m][k] = *(const PG8_LAS bf16x8*)(lds + PG8_SA(b, h) + aoff + m * 2048 + k * 1024); } while (0)
#define PG8_LDB(dst, b, h) do { _Pragma("unroll") for (int n = 0; n < 2; ++n) _Pragma("unroll") for (int k = 0; k < 2; ++k) dst[n][k] = *(const PG8_LAS bf16x8*)(lds + PG8_SB(b, h) + boff + n * 2048 + k * 1024); } while (0)
#define PG8_MMA(ai, bj, At, Bt) do { __builtin_amdgcn_s_setprio(1); _Pragma("unroll") for (int m = 0; m < 4; ++m) _Pragma("unroll") for (int n = 0; n < 2; ++n) _Pragma("unroll") for (int k = 0; k < 2; ++k) \
        acc[ai][bj][m][n] = __builtin_amdgcn_mfma_f32_16x16x32_bf16(Bt[n][k], At[m][k], acc[ai][bj][m][n], 0, 0, 0); __builtin_amdgcn_s_setprio(0); } while (0)
#define PG8_WAIT_V(n) asm volatile("s_waitcnt vmcnt(" #n ")" ::: "memory")
#define PG8_WAIT_L(n) asm volatile("s_waitcnt lgkmcnt(" #n ")" ::: "memory")
#define PG8_BAR __builtin_amdgcn_s_barrier()
#define PG8_SCHED __builtin_amdgcn_sched_barrier(0)
    Unit cur, nxt; int ui = 0;
    if (!S.next(0, cur)) return;
    f32x4 acc[2][2][4][2];
#pragma unroll
    for (int a = 0; a < 2; ++a)
#pragma unroll
        for (int b = 0; b < 2; ++b)
#pragma unroll
            for (int m = 0; m < 4; ++m)
#pragma unroll
                for (int n = 0; n < 2; ++n) acc[a][b][m][n] = (f32x4){0.f, 0.f, 0.f, 0.f};
    bf16x8 At[4][2], B0[2][2], B1[2][2];
    const char* cA = (const char*)g.A + (size_t)cur.pm * tstep; const char* cB = (const char*)g.Bt + (size_t)cur.pn * tstep;
    S.a_ready(cur);
    if constexpr (SP2) {
        PG8_STAGE(PG8_SB(0, 0), cB, voffB); PG8_STAGE(PG8_SB(0, 1), cB + hstep, voffB); PG8_STAGE(PG8_SA(0, 0), cA, voffA); PG8_STAGE(PG8_SA(0, 1), cA + hstep, voffA);
        if (wr == 1) PG8_BAR;
        PG8_WAIT_V(2); PG8_BAR;
        PG8_STAGE(PG8_SB(1, 0), cB + kstep, voffB); PG8_STAGE(PG8_SA(1, 0), cA + kstep, voffA); PG8_STAGE(PG8_SB(1, 1), cB + hstep + kstep, voffB);
        PG8_WAIT_V(6); PG8_BAR;
    } else {
        PG8_STAGE(PG8_SB(0, 0), cB, voffB); PG8_STAGE(PG8_SA(0, 0), cA, voffA); PG8_STAGE(PG8_SB(0, 1), cB + hstep, voffB); PG8_STAGE(PG8_SA(0, 1), cA + hstep, voffA);
        if (wr == 1) PG8_BAR;
        PG8_WAIT_V(4); PG8_BAR;
        PG8_STAGE(PG8_SB(1, 0), cB + kstep, voffB); PG8_STAGE(PG8_SA(1, 0), cA + kstep, voffA); PG8_STAGE(PG8_SB(1, 1), cB + hstep + kstep, voffB);
        PG8_WAIT_V(6); PG8_BAR;
    }
    for (;;) {
        const bool has_next = S.next(ui + 1, nxt);
        const char* nA = has_next ? (const char*)g.A + (size_t)nxt.pm * tstep : cA; const char* nB = has_next ? (const char*)g.Bt + (size_t)nxt.pn * tstep : cB;
        for (int t = 0; t < nt; t += 2) {
            if constexpr (Epi::HAS_MID) { if (t == (nt >> 1)) { PG8_SCHED; E.mid(acc, cur, wr, wc, fr, fq); PG8_SCHED; } }
            const bool last = (t == nt - 2);
            const char* a1 = cA + (size_t)(t + 1) * kstep;
            const char* a2 = last ? nA : cA + (size_t)(t + 2) * kstep; const char* b2 = last ? nB : cB + (size_t)(t + 2) * kstep;
            const char* a3 = a2 + kstep; const char* b3 = b2 + kstep;
            if (last && has_next) S.a_ready(nxt);
            if constexpr (SP2) {
            PG8_LDB(B0, 0, 0); PG8_LDB(B1, 0, 1); PG8_SCHED; PG8_LDA(At, 0, 0); PG8_STAGE(PG8_SA(1, 1), a1 + hstep, voffA);
            PG8_WAIT_V(8); PG8_WAIT_L(0); PG8_BAR; PG8_MMA(0, 0, At, B0); PG8_MMA(0, 1, At, B1); PG8_BAR; PG8_SCHED;
            PG8_LDA(At, 0, 1); PG8_STAGE(PG8_SB(0, 0), b2, voffB); PG8_STAGE(PG8_SB(0, 1), b2 + hstep, voffB); PG8_STAGE(PG8_SA(0, 0), a2, voffA);
            PG8_WAIT_V(8); PG8_WAIT_L(0); PG8_BAR; PG8_MMA(1, 0, At, B0); PG8_MMA(1, 1, At, B1); PG8_BAR; PG8_SCHED;
            PG8_LDB(B0, 1, 0); PG8_LDB(B1, 1, 1); PG8_SCHED; PG8_LDA(At, 1, 0); PG8_STAGE(PG8_SA(0, 1), a2 + hstep, voffA);
            PG8_WAIT_V(8); PG8_WAIT_L(0); PG8_BAR; PG8_MMA(0, 0, At, B0); PG8_MMA(0, 1, At, B1); PG8_BAR; PG8_SCHED;
            PG8_LDA(At, 1, 1); PG8_STAGE(PG8_SB(1, 0), b3, voffB); PG8_STAGE(PG8_SB(1, 1), b3 + hstep, voffB); PG8_STAGE(PG8_SA(1, 0), a3, voffA);
            PG8_WAIT_V(8); PG8_WAIT_L(0); PG8_BAR; PG8_MMA(1, 0, At, B0); PG8_MMA(1, 1, At, B1); PG8_BAR; PG8_SCHED;
            } else {
            PG8_LDB(B0, 0, 0); PG8_SCHED; PG8_LDA(At, 0, 0); PG8_STAGE(PG8_SA(1, 1), a1 + hstep, voffA);
            PG8_WAIT_L(8); PG8_BAR; PG8_WAIT_L(0); PG8_MMA(0, 0, At, B0); PG8_BAR; PG8_SCHED;
            PG8_LDB(B1, 0, 1); PG8_STAGE(PG8_SB(0, 0), b2, voffB);
            PG8_BAR; PG8_WAIT_L(0); PG8_MMA(0, 1, At, B1); PG8_BAR;
            PG8_LDA(At, 0, 1); PG8_STAGE(PG8_SA(0, 0), a2, voffA);
            PG8_BAR; PG8_WAIT_L(0); PG8_MMA(1, 0, At, B0); PG8_BAR; PG8_SCHED;
            PG8_STAGE(PG8_SB(0, 1), b2 + hstep, voffB);
            PG8_WAIT_V(6); PG8_BAR; PG8_MMA(1, 1, At, B1); PG8_BAR;
            PG8_LDB(B0, 1, 0); PG8_SCHED; PG8_LDA(At, 1, 0); PG8_STAGE(PG8_SA(0, 1), a2 + hstep, voffA);
            PG8_WAIT_L(8); PG8_BAR; PG8_WAIT_L(0); PG8_MMA(0, 0, At, B0); PG8_BAR; PG8_SCHED;
            PG8_LDB(B1, 1, 1); PG8_STAGE(PG8_SB(1, 0), b3, voffB);
            PG8_BAR; PG8_WAIT_L(0); PG8_MMA(0, 1, At, B1); PG8_BAR;
            PG8_LDA(At, 1, 1); PG8_STAGE(PG8_SA(1, 0), a3, voffA);
            PG8_BAR; PG8_WAIT_L(0); PG8_MMA(1, 0, At, B0); PG8_BAR; PG8_SCHED;
            PG8_STAGE(PG8_SB(1, 1), b3 + hstep, voffB);
            PG8_WAIT_V(6); PG8_BAR; PG8_MMA(1, 1, At, B1); PG8_BAR;
            }
        }
        if constexpr (ALIGN_EPI) { if (wr == 0) PG8_BAR; }
        if constexpr (!Epi::AFTER_DRAIN) { E(acc, cur, wr, wc, fr, fq); S.done(cur); }
        if (!has_next) break;
#pragma unroll
        for (int a = 0; a < 2; ++a)
#pragma unroll
            for (int b = 0; b < 2; ++b)
#pragma unroll
                for (int m = 0; m < 4; ++m)
#pragma unroll
                    for (int n = 0; n < 2; ++n) acc[a][b][m][n] = (f32x4){0.f, 0.f, 0.f, 0.f};
        cur = nxt; cA = nA; cB = nB; ++ui;
        if constexpr (ALIGN_EPI) { if (wr == 1) PG8_BAR; }
    }
    PG8_WAIT_V(0);
    if constexpr (!ALIGN_EPI) { if (wr == 0) PG8_BAR; }
    PG8_BAR;
    if constexpr (Epi::AFTER_DRAIN) { E.fused(acc, cur, wr, wc, fr, fq, lds, wid, lane); S.done(cur); }
#undef PG8_SA
#undef PG8_SB
#undef PG8_STAGE
#undef PG8_LDA
#undef PG8_LDB
#undef PG8_MMA
#undef PG8_WAIT_V
#undef PG8_WAIT_L
#undef PG8_BAR
#undef PG8_SCHED
}
}

#include <hip/hip_bf16.h>
#include <cmath>
namespace attn_body {
using bf16=__hip_bfloat16;
using bf16x8=__attribute__((ext_vector_type(8)))short;
using s16x4=__attribute__((ext_vector_type(4)))short;
using f32x16=__attribute__((ext_vector_type(16)))float;
using u32x4=__attribute__((ext_vector_type(4)))unsigned;
constexpr int BATCH=4,NHEAD=16,SEQ=8192,D=64,DM=NHEAD*D;
constexpr int NW=8,QBLK=32,QB=QBLK*NW,KVBLK=64,NQB=SEQ/QB;
constexpr int ATTN_PITCH=DM, ATTN_UNIT_ROWS=QB;
__device__ __forceinline__ int crow(int r,int hi){return (r&3)+8*(r>>2)+4*hi;}
#define SBAR() __builtin_amdgcn_sched_barrier(0)
typedef __attribute__((address_space(3))) const float* lds_fptr;
__device__ __forceinline__ void bmask(f32x16&p0,f32x16&p1,int jb,int qrel,int hi,lds_fptr tab){
  const float NEG=-INFINITY; const int nb=qrel-64*jb-4*hi;
  #pragma unroll
  for(int r=0;r<16;++r){ const int n0=nb-((r&3)+8*(r>>2)), n1=n0-32;
    const int i0=n0<0?0:(n0>127?127:n0), i1=n1<0?0:(n1>127?127:n1);
    const float t0=tab[256+i0], t1=tab[256+i1];
    p0[r]=n0<0?NEG:p0[r]+t0; p1[r]=n1<0?NEG:p1[r]+t1; }
}
constexpr int NSLOT=3, SLOTB=8192;
constexpr int LDS_K=0, LDS_V=NSLOT*SLOTB, LDS_WS=2*NSLOT*SLOTB, LDS_OST=LDS_WS+NW*64*4, LDS_BYTES=LDS_OST+NW*4096;
constexpr float C2=0.125f*1.4426950408889634f;
__device__ __forceinline__ void glds16(const void*gsrc,unsigned lds_dst){unsigned keep;
  asm volatile("s_mov_b32 %0, m0\n\ts_mov_b32 m0, %2\n\ts_nop 0\n\tglobal_load_lds_dwordx4 %1, off\n\ts_mov_b32 m0, %0":"=&s"(keep):"v"(gsrc),"s"(lds_dst):"memory");}
__device__ __forceinline__ float max3f(float a,float b,float c){float r;asm("v_max3_f32 %0, %1, %2, %3":"=v"(r):"v"(a),"v"(b),"v"(c));return r;}
__device__ __forceinline__ float max2f(float a,float b){float r;asm("v_max_f32_e32 %0, %1, %2":"=v"(r):"v"(a),"v"(b));return r;}
__device__ __forceinline__ float fadd_s(float a,float b){float r;asm("v_add_f32_e32 %0, %1, %2":"=v"(r):"v"(a),"v"(b));return r;}
__device__ __forceinline__ float fsub_s(float a,float b){float r;asm("v_sub_f32_e32 %0, %1, %2":"=v"(r):"v"(a),"v"(b));return r;}
typedef float f32x2_t __attribute__((ext_vector_type(2))); typedef __bf16 bf16x2_t __attribute__((ext_vector_type(2)));
__device__ __forceinline__ unsigned cvtpk_s(float lo,float hi){f32x2_t v={lo,hi};bf16x2_t b=__builtin_convertvector(v,bf16x2_t);return __builtin_bit_cast(unsigned,b);}
#define WAIT_BAR(N) asm volatile("s_waitcnt vmcnt(" #N ") lgkmcnt(0)\n\ts_barrier":::"memory")

__device__ __forceinline__ void qkt(f32x16&p0,f32x16&p1,const char*Kslot,const bf16x8*qr,const f32x16&negm,int r32,int hi){
  const char*kb=Kslot+hi*1024+r32*16;
  #pragma unroll
  for(int d0=0;d0<4;++d0){
    const bf16x8 b0=*reinterpret_cast<const bf16x8*>(kb+d0*2048);
    const bf16x8 b1=*reinterpret_cast<const bf16x8*>(kb+d0*2048+512);
    if(d0==0){p0=__builtin_amdgcn_mfma_f32_32x32x16_bf16(b0,qr[0],negm,0,0,0);p1=__builtin_amdgcn_mfma_f32_32x32x16_bf16(b1,qr[0],negm,0,0,0);}
    else{p0=__builtin_amdgcn_mfma_f32_32x32x16_bf16(b0,qr[d0],p0,0,0,0);p1=__builtin_amdgcn_mfma_f32_32x32x16_bf16(b1,qr[d0],p1,0,0,0);}}
}
typedef __attribute__((address_space(3))) const char* lds_cptr;
typedef short v4i16_t __attribute__((ext_vector_type(4)));
__device__ __forceinline__ void kload8(bf16x8*kf,lds_cptr kp){
  kf[0]=*(const __attribute__((address_space(3))) bf16x8*)(kp);      kf[1]=*(const __attribute__((address_space(3))) bf16x8*)(kp+512);
  kf[2]=*(const __attribute__((address_space(3))) bf16x8*)(kp+2048); kf[3]=*(const __attribute__((address_space(3))) bf16x8*)(kp+2560);
  kf[4]=*(const __attribute__((address_space(3))) bf16x8*)(kp+4096); kf[5]=*(const __attribute__((address_space(3))) bf16x8*)(kp+4608);
  kf[6]=*(const __attribute__((address_space(3))) bf16x8*)(kp+6144); kf[7]=*(const __attribute__((address_space(3))) bf16x8*)(kp+6656);
}
__device__ __forceinline__ void kload2(bf16x8*kf,lds_cptr kp,int j){ kf[2*j]=*(const __attribute__((address_space(3))) bf16x8*)(kp+j*2048); kf[2*j+1]=*(const __attribute__((address_space(3))) bf16x8*)(kp+j*2048+512); }
__device__ __forceinline__ s16x4 vtr(lds_cptr p){ return __builtin_bit_cast(s16x4,__builtin_amdgcn_ds_read_tr16_b64_v4i16((__attribute__((address_space(3))) v4i16_t*)p)); }
__device__ __forceinline__ float rowmax(const f32x16&p0,const f32x16&p1){
  float a=max3f(p0[0],p0[1],p1[0]),b=max3f(p0[2],p0[3],p1[1]);a=max3f(a,p1[2],p1[3]);
  #pragma unroll
  for(int r=4;r<16;r+=4){a=max3f(a,p0[r],p0[r+1]);b=max3f(b,p0[r+2],p0[r+3]);a=max3f(a,p1[r],p1[r+1]);b=max3f(b,p1[r+2],p1[r+3]);}
  const float m=max2f(a,b);
  auto rr=__builtin_amdgcn_permlane32_swap(__float_as_uint(m),__float_as_uint(m),false,false);
  return max2f(__uint_as_float(rr[0]),__uint_as_float(rr[1]));
}
__device__ __forceinline__ void pv(f32x16*o,int vb,bf16x8 pa0,bf16x8 pa1,bf16x8 pa2,bf16x8 pa3){
  #pragma unroll
  for(int d0=0;d0<2;++d0){s16x4 lo[4],hi[4];
    #pragma unroll
    for(int ks=0;ks<4;++ks){
      asm volatile("ds_read_b64_tr_b16 %0,%1 offset:%c2":"=&v"(lo[ks]):"v"(vb),"i"(d0*4096+ks*1024):"memory");
      asm volatile("ds_read_b64_tr_b16 %0,%1 offset:%c2":"=&v"(hi[ks]):"v"(vb),"i"(d0*4096+ks*1024+512):"memory");}
    asm volatile("s_waitcnt lgkmcnt(0)":::"memory");SBAR();
    #define PK(k) (bf16x8){lo[k][0],lo[k][1],lo[k][2],lo[k][3],hi[k][0],hi[k][1],hi[k][2],hi[k][3]}
    o[d0]=__builtin_amdgcn_mfma_f32_32x32x16_bf16(pa0,PK(0),o[d0],0,0,0);
    o[d0]=__builtin_amdgcn_mfma_f32_32x32x16_bf16(pa1,PK(1),o[d0],0,0,0);
    o[d0]=__builtin_amdgcn_mfma_f32_32x32x16_bf16(pa2,PK(2),o[d0],0,0,0);
    o[d0]=__builtin_amdgcn_mfma_f32_32x32x16_bf16(pa3,PK(3),o[d0],0,0,0);
    #undef PK
  }
}

#ifndef ATTN_STORE16
#define ATTN_STORE16(p,v) (*(u32x4*)(p)=(v))
#endif
template<int THRL> __device__ __forceinline__ void attn_unit(int b,int hq,int hv,int qb,const bf16*Q,const bf16*__restrict__ K,const bf16*__restrict__ V,bf16*O,char*shm,lds_fptr tab,int wid_in){
  int lane; asm volatile("v_mbcnt_lo_u32_b32 %0, -1, 0\n\tv_mbcnt_hi_u32_b32 %0, -1, %0" : "=v"(lane)); const int r32=lane&31,hi=lane>>5; const int wid=wid_in;
  const long rowbase=(long)b*SEQ; const int q0=qb*QB;
  const bf16*Qw=Q+(rowbase+q0+wid*QBLK)*DM+hq*D;
  const bf16*Kh=K+rowbase*DM+hq*D,*Vh=V+rowbase*DM+hv*D;
  const unsigned lds0=(unsigned)(uintptr_t)shm;
  float*wsf=(float*)(shm+LDS_WS)+wid*64;
  const bf16*ksrc=Kh+(long)lane*DM+wid*8;
  const bf16*vsrc=Vh+(long)(16*(wid&3)+(lane>>2))*DM+(wid>>2)*32+(lane&3)*8;
  const unsigned kdst=lds0+LDS_K+wid*1024, vdst=lds0+LDS_V+wid*1024;
  #define DMA_K(t,slot) glds16(ksrc+(long)(t)*KVBLK*DM,(unsigned)__builtin_amdgcn_readfirstlane(kdst+(slot)))
  #define DMA_V(t,slot) glds16(vsrc+(long)(t)*KVBLK*DM,(unsigned)__builtin_amdgcn_readfirstlane(vdst+(slot)))
  const int vb0=(int)(lds0+LDS_V)+((lane>>4)&1)*32+(lane&3)*8+(4*hi+((lane&15)>>2))*64;
  const char*Kbase=shm+LDS_K; bf16x8 kf[8];
  const lds_cptr shm3=(lds_cptr)shm; const lds_cptr kp0=shm3+LDS_K+hi*1024+r32*16; const lds_cptr vp0=shm3+LDS_V+((lane>>4)&1)*32+(lane&3)*8+(4*hi+((lane&15)>>2))*64;
  const int NT=(q0+QB)/KVBLK;
  DMA_K(0,0);DMA_V(0,0);DMA_K(1,SLOTB);
  bf16x8 qr[4];
  #pragma unroll
  for(int d0=0;d0<4;++d0)qr[d0]=*reinterpret_cast<const bf16x8*>(&Qw[(long)r32*DM+d0*16+hi*8]);
  float mhat=0.f,l_reg=0.f;f32x16 o[2],negm; { float z_; asm volatile("v_mov_b32 %0, 0":"=v"(z_)); _Pragma("unroll") for(int r=0;r<16;++r){o[0][r]=z_;o[1][r]=z_;negm[r]=z_;} } asm volatile("":"+v"(negm));
  const int qrel=wid*QBLK+r32;
  #define CMASK(P0,P1,t) do{int jb_=(t)-(NT-4); if(jb_>=-2)bmask(P0,P1,jb_,qrel,hi,tab);}while(0)
  bool resc=false;
  #define START(P0,P1) do{ const float rm=rowmax(P0,P1); resc=false; \
    { const float dl=rm; mhat=fadd_s(mhat,dl); \
      _Pragma("unroll") for(int r=0;r<16;++r){P0[r]=fsub_s(P0[r],dl);P1[r]=fsub_s(P1[r],dl);} \
      _Pragma("unroll") for(int r=0;r<16;++r)negm[r]=-mhat; asm volatile("":"+v"(negm)); } \
    _Pragma("unroll") for(int r=0;r<16;++r)P0[r]=__builtin_amdgcn_exp2f(P0[r]); }while(0)
  #define RESC() do{ if(resc){ asm volatile("s_waitcnt lgkmcnt(0)":::"memory"); \
      _Pragma("unroll") for(int d_=0;d_<2;++d_) _Pragma("unroll") for(int r=0;r<16;++r)o[d_][r]*=wsf[crow(r,hi)]; } }while(0)
  f32x16 pA0,pA1,pB0,pB1;
  int sl_prev=0,sl_cur=0,sl_next=SLOTB;
  #define ROT() do{sl_prev=sl_cur;sl_cur=sl_next;sl_next=(sl_next==(NSLOT-1)*SLOTB)?0:sl_next+SLOTB;}while(0)
  DMA_K(2,2*SLOTB);
  WAIT_BAR(3);
  qkt(pA0,pA1,Kbase,qr,negm,r32,hi);asm volatile("s_nop 15\n\ts_nop 7":"+v"(pA0),"+v"(pA1));CMASK(pA0,pA1,0);
  START(pA0,pA1);
  _Pragma("unroll") for(int r=0;r<16;++r)pA1[r]=__builtin_amdgcn_exp2f(pA1[r]);
  WAIT_BAR(0);
  DMA_K(3,0);DMA_V(1,SLOTB);
  ROT();
  kload8(kf,kp0+sl_cur);
  WAIT_BAR(2);
  s16x4 vlo[8],vhi[8]; u32x4 pw0,pw1,pw2,pw3;
  #define PKW(P,B) cvtpk_s(P[B],P[B+1])
  #define PAF(k) __builtin_bit_cast(bf16x8,pw##k)
  #define VFR(i) (bf16x8){vlo[i][0],vlo[i][1],vlo[i][2],vlo[i][3],vhi[i][0],vhi[i][1],vhi[i][2],vhi[i][3]}
  #define PIN(x) asm volatile("":"+v"(x))
  #define MX3(a,b,c) __builtin_fmaxf(__builtin_fmaxf((a),(b)),(c))
  #define GAPA(MF,A0,A1,A2,A3,W0,W1,PW) do{ MF; sacc+=A0; sacc+=A1; sacc+=A2; sacc+=A3; PIN(sacc); W0; W1; PIN(PW); SBAR(); }while(0)
  #define EX(v) __builtin_amdgcn_exp2f(v)
  #define GAPB(MF,X,B) do{ MF; X[B]=EX(X[B]); X[B+1]=EX(X[B+1]); X[B+2]=EX(X[B+2]); X[B+3]=EX(X[B+3]); PIN(X); SBAR(); }while(0)
  #define VRD(i) do{ vlo[i]=vtr(vp_+(((i)>>2)*4096+((i)&3)*1024)); vhi[i]=vtr(vp_+(((i)>>2)*4096+((i)&3)*1024+512)); }while(0)
  #define KRD(G,j) do{ if(G){ kload2(kf,kp0+sl_next,j); SBAR(); } }while(0)
  #define STEP(C0,C1,P0,P1,t,GK,GV,GL) do{ SBAR(); \
    const lds_cptr vp_=vp0+sl_prev; \
    VRD(0); SBAR(); float sacc=(P0[0]+P0[1]); \
    GAPA(C0=__builtin_amdgcn_mfma_f32_32x32x16_bf16(kf[0],qr[0],negm,0,0,0), P0[2],P0[3],P0[4],P0[5],     pw0[0]=PKW(P0,0), pw0[1]=PKW(P0,2), pw0); \
    VRD(4); SBAR(); GAPA(C1=__builtin_amdgcn_mfma_f32_32x32x16_bf16(kf[1],qr[0],negm,0,0,0), P0[6],P0[7],P0[8],P0[9],     pw0[2]=PKW(P0,4), pw0[3]=PKW(P0,6), pw0); \
    VRD(1); SBAR(); GAPA(C0=__builtin_amdgcn_mfma_f32_32x32x16_bf16(kf[2],qr[1],C0,0,0,0),   P0[10],P0[11],P0[12],P0[13], pw1[0]=PKW(P0,8), pw1[1]=PKW(P0,10), pw1); \
    VRD(5); SBAR(); GAPA(C1=__builtin_amdgcn_mfma_f32_32x32x16_bf16(kf[3],qr[1],C1,0,0,0),   P0[14],P0[15],P1[0],P1[1],   pw1[2]=PKW(P0,12),pw1[3]=PKW(P0,14), pw1); \
    VRD(2); SBAR(); GAPA(C0=__builtin_amdgcn_mfma_f32_32x32x16_bf16(kf[4],qr[2],C0,0,0,0),   P1[2],P1[3],P1[4],P1[5],     pw2[0]=PKW(P1,0), pw2[1]=PKW(P1,2), pw2); \
    VRD(6); SBAR(); GAPA(C1=__builtin_amdgcn_mfma_f32_32x32x16_bf16(kf[5],qr[2],C1,0,0,0),   P1[6],P1[7],P1[8],P1[9],     pw2[2]=PKW(P1,4), pw2[3]=PKW(P1,6), pw2); \
    VRD(3); SBAR(); GAPA(C0=__builtin_amdgcn_mfma_f32_32x32x16_bf16(kf[6],qr[3],C0,0,0,0),   P1[10],P1[11],P1[12],P1[13], pw3[0]=PKW(P1,8), pw3[1]=PKW(P1,10), pw3); \
    VRD(7); SBAR(); GAPA(C1=__builtin_amdgcn_mfma_f32_32x32x16_bf16(kf[7],qr[3],C1,0,0,0),   P1[14],P1[15],0.f,0.f,       pw3[2]=PKW(P1,12),pw3[3]=PKW(P1,14), pw3); \
    l_reg+=sacc; \
    if(GK){DMA_K((t)+3,sl_cur);} if(GV){DMA_V((t)+1,sl_next);} \
    CMASK(C0,C1,t); \
    { float a=MX3(C0[0],C0[1],C1[0]),b=MX3(C0[2],C0[3],C1[1]); a=MX3(a,C1[2],C1[3]); \
      _Pragma("unroll") for(int r=4;r<16;r+=4){a=MX3(a,C0[r],C0[r+1]);b=MX3(b,C0[r+2],C0[r+3]);a=MX3(a,C1[r],C1[r+1]);b=MX3(b,C1[r+2],C1[r+3]);} \
      float rm=__builtin_fmaxf(a,b); { auto rr=__builtin_amdgcn_permlane32_swap(__float_as_uint(rm),__float_as_uint(rm),false,false); rm=__builtin_fmaxf(__uint_as_float(rr[0]),__uint_as_float(rr[1])); } \
      resc=false; \
      if(__builtin_expect(__any(rm>(float)THRL),0)){ const float dl=__builtin_fmaxf(rm,0.f); mhat+=dl; \
        _Pragma("unroll") for(int r=0;r<16;++r){C0[r]-=dl;C1[r]-=dl;} \
        _Pragma("unroll") for(int r=0;r<16;++r)negm[r]=-mhat; asm volatile("":"+v"(negm)); \
        const float f=__builtin_amdgcn_exp2f(-dl); l_reg*=f; if(hi==0)wsf[r32]=f; resc=true; } } \
    SBAR(); \
    GAPB(o[0]=__builtin_amdgcn_mfma_f32_32x32x16_bf16(PAF(0),VFR(0),o[0],0,0,0), C0,0); \
    GAPB(o[1]=__builtin_amdgcn_mfma_f32_32x32x16_bf16(PAF(0),VFR(4),o[1],0,0,0), C0,4); \
    KRD(GL,0); GAPB(o[0]=__builtin_amdgcn_mfma_f32_32x32x16_bf16(PAF(1),VFR(1),o[0],0,0,0), C0,8); \
    KRD(GL,1); GAPB(o[1]=__builtin_amdgcn_mfma_f32_32x32x16_bf16(PAF(1),VFR(5),o[1],0,0,0), C0,12); \
    KRD(GL,2); GAPB(o[0]=__builtin_amdgcn_mfma_f32_32x32x16_bf16(PAF(2),VFR(2),o[0],0,0,0), C1,0); \
    KRD(GL,3); GAPB(o[1]=__builtin_amdgcn_mfma_f32_32x32x16_bf16(PAF(2),VFR(6),o[1],0,0,0), C1,4); \
    GAPB(o[0]=__builtin_amdgcn_mfma_f32_32x32x16_bf16(PAF(3),VFR(3),o[0],0,0,0), C1,8); \
    GAPB(o[1]=__builtin_amdgcn_mfma_f32_32x32x16_bf16(PAF(3),VFR(7),o[1],0,0,0), C1,12); \
    }while(0)
  int t=1;
  #undef CMASK
  #define CMASK(P0,P1,t) do{}while(0)
  for(;t+7<NT;t+=2){
    STEP(pB0,pB1,pA0,pA1,t,true,true,true);     WAIT_BAR(2); RESC(); ROT();
    STEP(pA0,pA1,pB0,pB1,t+1,true,true,true);   WAIT_BAR(2); RESC(); ROT();
  }
  #undef CMASK
  #define CMASK(P0,P1,t) do{int jb_=(t)-(NT-4); if(jb_>=-2)bmask(P0,P1,jb_,qrel,hi,tab);}while(0)
  #define ENDW(tt) do{ if((tt)+3<NT){WAIT_BAR(2);} else if((tt)+2<NT){WAIT_BAR(1);} else {WAIT_BAR(0);} }while(0)
  for(;t+1<NT;t+=2){
    STEP(pB0,pB1,pA0,pA1,t,(t+3<NT),(t+1<NT),(t+1<NT));       ENDW(t);   RESC(); ROT();
    STEP(pA0,pA1,pB0,pB1,t+1,(t+4<NT),(t+2<NT),(t+2<NT));     ENDW(t+1); RESC(); ROT();
  }
  STEP(pB0,pB1,pA0,pA1,NT-1,false,false,false); RESC();
  { float sacc=pB0[0]+pB0[1]; _Pragma("unroll") for(int r=2;r<16;++r)sacc+=pB0[r]; _Pragma("unroll") for(int r=0;r<16;++r)sacc+=pB1[r]; l_reg+=sacc;
    pw0=(u32x4){PKW(pB0,0),PKW(pB0,2),PKW(pB0,4),PKW(pB0,6)};pw1=(u32x4){PKW(pB0,8),PKW(pB0,10),PKW(pB0,12),PKW(pB0,14)};pw2=(u32x4){PKW(pB1,0),PKW(pB1,2),PKW(pB1,4),PKW(pB1,6)};pw3=(u32x4){PKW(pB1,8),PKW(pB1,10),PKW(pB1,12),PKW(pB1,14)};
    SBAR(); pv(o,vb0+sl_cur,PAF(0),PAF(1),PAF(2),PAF(3)); }
  #undef PKW
  #undef PAF
  #undef VFR
  #undef PIN
  #undef MX3
  #undef GAPA
  #undef GAPB
  #undef EX
  #undef VRD
  #undef KRD
  #undef STEP
  #undef ENDW
  {auto rr=__builtin_amdgcn_permlane32_swap(__float_as_uint(l_reg),__float_as_uint(l_reg),false,false);l_reg=__uint_as_float(rr[0])+__uint_as_float(rr[1]);}
  if(hi==0)wsf[32+r32]=l_reg;asm volatile("s_waitcnt lgkmcnt(0)":::"memory");
  float rli[16];
  #pragma unroll
  for(int r=0;r<16;++r)rli[r]=__builtin_amdgcn_rcpf(wsf[32+crow(r,hi)]);
  bf16*Ow=O+(rowbase+q0+wid*QBLK)*DM+hv*D;
  { bf16*stg=(bf16*)(shm+LDS_OST)+wid*2048;
    #pragma unroll
    for(int r=0;r<16;++r){const int orow=crow(r,hi);
      #pragma unroll
      for(int d0=0;d0<2;++d0)stg[orow*64+d0*32+r32]=__float2bfloat16(o[d0][r]*rli[r]);}
    asm volatile("s_waitcnt lgkmcnt(0)":::"memory");
    #pragma unroll
    for(int i=0;i<4;++i){const int row=i*8+(lane>>3),ch=lane&7; const u32x4 v=*(const u32x4*)(stg+row*64+ch*8); ATTN_STORE16(Ow+(long)row*DM+ch*8,v);} }
  asm volatile("s_waitcnt lgkmcnt(0)\n\ts_barrier":::"memory");
  #undef DMA_K
  #undef DMA_V
  #undef CMASK
  #undef START
  #undef RESC
  #undef ROT
}
constexpr int ATTN_LDS_BYTES=LDS_BYTES;
#undef SBAR
#undef WAIT_BAR
}


namespace attn_body {
#define SBAR() __builtin_amdgcn_sched_barrier(0)
#define WAIT_BAR(N) asm volatile("s_waitcnt vmcnt(" #N ") lgkmcnt(0)\n\ts_barrier":::"memory")
constexpr int SLOTK=8192, SLOTV=16384, L2_K=0, L2_V=NSLOT*SLOTK, L2_WS=L2_V+NSLOT*SLOTV, L2_OST=L2_WS+NW*64*4, L2_FLAG=L2_OST+NW*4096, L2_BYTES=L2_FLAG+64;
__device__ __forceinline__ void pv4(f32x16*o,int vb,bf16x8 pa0,bf16x8 pa1,bf16x8 pa2,bf16x8 pa3){
  #pragma unroll
  for(int d0=0;d0<4;++d0){s16x4 lo[4],hi[4];
    #pragma unroll
    for(int ks=0;ks<4;++ks){
      asm volatile("ds_read_b64_tr_b16 %0,%1 offset:%c2":"=&v"(lo[ks]):"v"(vb),"i"(d0*4096+ks*1024):"memory");
      asm volatile("ds_read_b64_tr_b16 %0,%1 offset:%c2":"=&v"(hi[ks]):"v"(vb),"i"(d0*4096+ks*1024+512):"memory");}
    asm volatile("s_waitcnt lgkmcnt(0)":::"memory");SBAR();
    #define PK(k) (bf16x8){lo[k][0],lo[k][1],lo[k][2],lo[k][3],hi[k][0],hi[k][1],hi[k][2],hi[k][3]}
    o[d0]=__builtin_amdgcn_mfma_f32_32x32x16_bf16(pa0,PK(0),o[d0],0,0,0);
    o[d0]=__builtin_amdgcn_mfma_f32_32x32x16_bf16(pa1,PK(1),o[d0],0,0,0);
    o[d0]=__builtin_amdgcn_mfma_f32_32x32x16_bf16(pa2,PK(2),o[d0],0,0,0);
    o[d0]=__builtin_amdgcn_mfma_f32_32x32x16_bf16(pa3,PK(3),o[d0],0,0,0);
    #undef PK
  }
}
#define ZERO16 (f32x16){0.f,0.f,0.f,0.f,0.f,0.f,0.f,0.f,0.f,0.f,0.f,0.f,0.f,0.f,0.f,0.f}
#define MFMA32(a,b,c) __builtin_amdgcn_mfma_f32_32x32x16_bf16(a,b,c,0,0,0)
template<int THRL,bool FAST> __device__ __forceinline__ bool attn_unit2(int b,int hq,int hvb,int qb,const bf16*Q,const bf16*__restrict__ K,const bf16*__restrict__ V,bf16*O,char*shm,lds_fptr tab,int wid_in){
  int lane; asm volatile("v_mbcnt_lo_u32_b32 %0, -1, 0\n\tv_mbcnt_hi_u32_b32 %0, -1, %0" : "=v"(lane)); const int r32=lane&31,hi=lane>>5; const int wid=wid_in;
  const long rowbase=(long)b*SEQ; const int q0=qb*QB;
  const bf16*Qw=Q+(rowbase+q0+wid*QBLK)*DM+hq*D;
  const bf16*Kh=K+rowbase*DM+hq*D,*Vh=V+rowbase*DM+hvb*D;
  const unsigned lds0=(unsigned)(uintptr_t)shm;
  float*wsf=(float*)(shm+L2_WS)+wid*64;
  const bf16*ksrc=Kh+(long)lane*DM+wid*8;
  const bf16*vsrc=Vh+(long)(16*(wid&3)+(lane>>2))*DM+(wid>>2)*32+(lane&3)*8;
  const unsigned kdst=lds0+L2_K+wid*1024, vdst=lds0+L2_V+wid*1024;
  #define DMA_K(t,slot) glds16(ksrc+(long)(t)*KVBLK*DM,(unsigned)__builtin_amdgcn_readfirstlane(kdst+(slot)))
  #define DMA_V(t,slot) do{ glds16(vsrc+(long)(t)*KVBLK*DM,(unsigned)__builtin_amdgcn_readfirstlane(vdst+2*(slot))); glds16(vsrc+(long)(t)*KVBLK*DM+64,(unsigned)__builtin_amdgcn_readfirstlane(vdst+2*(slot)+8192)); }while(0)
  const int vb0=(int)(lds0+L2_V)+((lane>>4)&1)*32+(lane&3)*8+(4*hi+((lane&15)>>2))*64;
  const char*Kbase=shm+L2_K; bf16x8 kf[8];
  const lds_cptr shm3=(lds_cptr)shm; const lds_cptr kp0=shm3+L2_K+hi*1024+r32*16; const lds_cptr vp0=shm3+L2_V+((lane>>4)&1)*32+(lane&3)*8+(4*hi+((lane&15)>>2))*64;
  const int NT=(q0+QB)/KVBLK;
  DMA_K(0,0);DMA_V(0,0);DMA_K(1,SLOTK);
  bf16x8 qr[4];
  #pragma unroll
  for(int d0=0;d0<4;++d0)qr[d0]=*reinterpret_cast<const bf16x8*>(&Qw[(long)r32*DM+d0*16+hi*8]);
  float mh=0.f,l_reg=0.f,ovf=0.f; bool bad=false; f32x16 o[4]; { float z_; asm volatile("v_mov_b32 %0, 0":"=v"(z_)); _Pragma("unroll") for(int r=0;r<16;++r){o[0][r]=z_;o[1][r]=z_;o[2][r]=z_;o[3][r]=z_;} }
  const int qrel=wid*QBLK+r32;
  #define CMASK(P0,P1,t) do{int jb_=(t)-(NT-4); if(jb_>=-2)bmask(P0,P1,jb_,qrel,hi,tab);}while(0)
  bool resc=false;
  #define RESC() do{ if(!FAST&&resc){ asm volatile("s_waitcnt lgkmcnt(0)":::"memory"); \
      _Pragma("unroll") for(int d_=0;d_<4;++d_) _Pragma("unroll") for(int r=0;r<16;++r)o[d_][r]*=wsf[crow(r,hi)]; } }while(0)
  f32x16 pA0,pA1,pB0,pB1;
  int sl_prev=0,sl_cur=0,sl_next=SLOTK;
  #define ROT() do{sl_prev=sl_cur;sl_cur=sl_next;sl_next=(sl_next==(NSLOT-1)*SLOTK)?0:sl_next+SLOTK;}while(0)
  DMA_K(2,2*SLOTK);
  WAIT_BAR(4);
  { const char*kb=Kbase+hi*1024+r32*16;
    #pragma unroll
    for(int d0=0;d0<4;++d0){ const bf16x8 b0=*reinterpret_cast<const bf16x8*>(kb+d0*2048); const bf16x8 b1=*reinterpret_cast<const bf16x8*>(kb+d0*2048+512);
      if(d0==0){pA0=MFMA32(b0,qr[0],ZERO16);pA1=MFMA32(b1,qr[0],ZERO16);} else{pA0=MFMA32(b0,qr[d0],pA0);pA1=MFMA32(b1,qr[d0],pA1);} } }
  CMASK(pA0,pA1,0);
  { float a=__builtin_fmaxf(__builtin_fmaxf(pA0[0],pA0[1]),pA1[0]),b_=__builtin_fmaxf(__builtin_fmaxf(pA0[2],pA0[3]),pA1[1]); a=__builtin_fmaxf(__builtin_fmaxf(a,pA1[2]),pA1[3]);
    _Pragma("unroll") for(int r=4;r<16;r+=4){a=__builtin_fmaxf(__builtin_fmaxf(a,pA0[r]),pA0[r+1]);b_=__builtin_fmaxf(__builtin_fmaxf(b_,pA0[r+2]),pA0[r+3]);a=__builtin_fmaxf(__builtin_fmaxf(a,pA1[r]),pA1[r+1]);b_=__builtin_fmaxf(__builtin_fmaxf(b_,pA1[r+2]),pA1[r+3]);}
    float rm=__builtin_fmaxf(a,b_); { auto rr=__builtin_amdgcn_permlane32_swap(__float_as_uint(rm),__float_as_uint(rm),false,false); rm=__builtin_fmaxf(__uint_as_float(rr[0]),__uint_as_float(rr[1])); }
    if(FAST){ bad=__any(!(rm>-48.f&&rm<48.f))!=0; } else mh=rm;
    _Pragma("unroll") for(int r=0;r<16;++r){pA0[r]=FAST?__builtin_amdgcn_exp2f(pA0[r]):__builtin_amdgcn_exp2f(pA0[r]-mh);pA1[r]=FAST?__builtin_amdgcn_exp2f(pA1[r]):__builtin_amdgcn_exp2f(pA1[r]-mh);} }
  WAIT_BAR(0);
  DMA_K(3,0);DMA_V(1,SLOTK);
  ROT();
  kload8(kf,kp0+sl_cur);
  WAIT_BAR(3);
  s16x4 vlo[8],vhi[8]; u32x4 pw0,pw1,pw2,pw3;
  #define PKW(P,B) cvtpk_s(P[B],P[B+1])
  #define PAF(k) __builtin_bit_cast(bf16x8,pw##k)
  #define VFR(i) (bf16x8){vlo[i][0],vlo[i][1],vlo[i][2],vlo[i][3],vhi[i][0],vhi[i][1],vhi[i][2],vhi[i][3]}
  #define PIN(x) asm volatile("":"+v"(x))
  #define MX3(a,b,c) __builtin_fmaxf(__builtin_fmaxf((a),(b)),(c))
  #define GAPA(MF,A0,A1,A2,A3,W0,W1,PW) do{ MF; sacc+=A0; sacc+=A1; sacc+=A2; sacc+=A3; PIN(sacc); W0; W1; PIN(PW); SBAR(); }while(0)
  #define EX(v) (FAST?__builtin_amdgcn_exp2f(v):__builtin_amdgcn_exp2f((v)-mh))
  #define GAPB(MF,X,B) do{ MF; X[B]=EX(X[B]); X[B+1]=EX(X[B+1]); PIN(X); SBAR(); }while(0)
  #define VRDX(i,j) do{ vlo[i]=vtr(vp_+(((j)>>2)*4096+((j)&3)*1024)); vhi[i]=vtr(vp_+(((j)>>2)*4096+((j)&3)*1024+512)); }while(0)
  #define KRD(G,j) do{ if(G){ kload2(kf,kp0+sl_next,j); SBAR(); } }while(0)
  #define STEP(C0,C1,P0,P1,t,GK,GV,GL) do{ SBAR(); \
    const lds_cptr vp_=vp0+2*sl_prev; \
    VRDX(0,0); SBAR(); float sacc=(P0[0]+P0[1]); \
    GAPA(C0=MFMA32(kf[0],qr[0],ZERO16), P0[2],P0[3],P0[4],P0[5],     pw0[0]=PKW(P0,0), pw0[1]=PKW(P0,2), pw0); \
    VRDX(4,4); SBAR(); GAPA(C1=MFMA32(kf[1],qr[0],ZERO16), P0[6],P0[7],P0[8],P0[9],     pw0[2]=PKW(P0,4), pw0[3]=PKW(P0,6), pw0); \
    VRDX(1,1); SBAR(); GAPA(C0=MFMA32(kf[2],qr[1],C0),   P0[10],P0[11],P0[12],P0[13], pw1[0]=PKW(P0,8), pw1[1]=PKW(P0,10), pw1); \
    VRDX(5,5); SBAR(); GAPA(C1=MFMA32(kf[3],qr[1],C1),   P0[14],P0[15],P1[0],P1[1],   pw1[2]=PKW(P0,12),pw1[3]=PKW(P0,14), pw1); \
    VRDX(2,2); SBAR(); GAPA(C0=MFMA32(kf[4],qr[2],C0),   P1[2],P1[3],P1[4],P1[5],     pw2[0]=PKW(P1,0), pw2[1]=PKW(P1,2), pw2); \
    VRDX(6,6); SBAR(); GAPA(C1=MFMA32(kf[5],qr[2],C1),   P1[6],P1[7],P1[8],P1[9],     pw2[2]=PKW(P1,4), pw2[3]=PKW(P1,6), pw2); \
    VRDX(3,3); SBAR(); GAPA(C0=MFMA32(kf[6],qr[3],C0),   P1[10],P1[11],P1[12],P1[13], pw3[0]=PKW(P1,8), pw3[1]=PKW(P1,10), pw3); \
    VRDX(7,7); SBAR(); GAPA(C1=MFMA32(kf[7],qr[3],C1),   P1[14],P1[15],0.f,0.f,       pw3[2]=PKW(P1,12),pw3[3]=PKW(P1,14), pw3); \
    l_reg+=sacc; if(FAST)ovf=__builtin_fmaxf(ovf,sacc); \
    if(GK){DMA_K((t)+3,sl_cur);} if(GV){DMA_V((t)+1,sl_next);} \
    CMASK(C0,C1,t); \
    if(!FAST){ float a=MX3(C0[0],C0[1],C1[0]),b_=MX3(C0[2],C0[3],C1[1]); a=MX3(a,C1[2],C1[3]); \
      _Pragma("unroll") for(int r=4;r<16;r+=4){a=MX3(a,C0[r],C0[r+1]);b_=MX3(b_,C0[r+2],C0[r+3]);a=MX3(a,C1[r],C1[r+1]);b_=MX3(b_,C1[r+2],C1[r+3]);} \
      float rm=__builtin_fmaxf(a,b_); { auto rr=__builtin_amdgcn_permlane32_swap(__float_as_uint(rm),__float_as_uint(rm),false,false); rm=__builtin_fmaxf(__uint_as_float(rr[0]),__uint_as_float(rr[1])); } \
      resc=false; \
      if(__builtin_expect(__any(rm-mh>(float)THRL),0)){ const float dl=__builtin_fmaxf(rm-mh,0.f); mh+=dl; \
        const float f=__builtin_amdgcn_exp2f(-dl); l_reg*=f; if(hi==0)wsf[r32]=f; resc=true; } } \
    SBAR(); \
    GAPB(o[0]=MFMA32(PAF(0),VFR(0),o[0]), C0,0);  VRDX(0,8);  SBAR(); \
    GAPB(o[1]=MFMA32(PAF(0),VFR(4),o[1]), C0,2);  VRDX(4,12); SBAR(); \
    GAPB(o[0]=MFMA32(PAF(1),VFR(1),o[0]), C0,4);  VRDX(1,9);  SBAR(); \
    GAPB(o[1]=MFMA32(PAF(1),VFR(5),o[1]), C0,6);  VRDX(5,13); SBAR(); \
    GAPB(o[0]=MFMA32(PAF(2),VFR(2),o[0]), C0,8);  VRDX(2,10); SBAR(); \
    GAPB(o[1]=MFMA32(PAF(2),VFR(6),o[1]), C0,10); VRDX(6,14); SBAR(); \
    GAPB(o[0]=MFMA32(PAF(3),VFR(3),o[0]), C0,12); VRDX(3,11); SBAR(); \
    GAPB(o[1]=MFMA32(PAF(3),VFR(7),o[1]), C0,14); VRDX(7,15); SBAR(); \
    GAPB(o[2]=MFMA32(PAF(0),VFR(0),o[2]), C1,0); \
    GAPB(o[3]=MFMA32(PAF(0),VFR(4),o[3]), C1,2); \
    KRD(GL,0); GAPB(o[2]=MFMA32(PAF(1),VFR(1),o[2]), C1,4); \
    KRD(GL,1); GAPB(o[3]=MFMA32(PAF(1),VFR(5),o[3]), C1,6); \
    KRD(GL,2); GAPB(o[2]=MFMA32(PAF(2),VFR(2),o[2]), C1,8); \
    KRD(GL,3); GAPB(o[3]=MFMA32(PAF(2),VFR(6),o[3]), C1,10); \
    GAPB(o[2]=MFMA32(PAF(3),VFR(3),o[2]), C1,12); \
    GAPB(o[3]=MFMA32(PAF(3),VFR(7),o[3]), C1,14); \
    }while(0)
  int t=1;
  #undef CMASK
  #define CMASK(P0,P1,t) do{}while(0)
  for(;t+7<NT;t+=2){
    STEP(pB0,pB1,pA0,pA1,t,true,true,true);     WAIT_BAR(3); RESC(); ROT();
    STEP(pA0,pA1,pB0,pB1,t+1,true,true,true);   WAIT_BAR(3); RESC(); ROT();
  }
  #undef CMASK
  #define CMASK(P0,P1,t) do{int jb_=(t)-(NT-4); if(jb_>=-2)bmask(P0,P1,jb_,qrel,hi,tab);}while(0)
  #define ENDW(tt) do{ if((tt)+3<NT){WAIT_BAR(3);} else if((tt)+2<NT){WAIT_BAR(2);} else {WAIT_BAR(0);} }while(0)
  for(;t+1<NT;t+=2){
    STEP(pB0,pB1,pA0,pA1,t,(t+3<NT),(t+1<NT),(t+1<NT));       ENDW(t);   RESC(); ROT();
    STEP(pA0,pA1,pB0,pB1,t+1,(t+4<NT),(t+2<NT),(t+2<NT));     ENDW(t+1); RESC(); ROT();
  }
  STEP(pB0,pB1,pA0,pA1,NT-1,false,false,false); RESC();
  { float sacc=pB0[0]+pB0[1]; _Pragma("unroll") for(int r=2;r<16;++r)sacc+=pB0[r]; _Pragma("unroll") for(int r=0;r<16;++r)sacc+=pB1[r]; l_reg+=sacc; if(FAST)ovf=__builtin_fmaxf(ovf,sacc);
    pw0=(u32x4){PKW(pB0,0),PKW(pB0,2),PKW(pB0,4),PKW(pB0,6)};pw1=(u32x4){PKW(pB0,8),PKW(pB0,10),PKW(pB0,12),PKW(pB0,14)};pw2=(u32x4){PKW(pB1,0),PKW(pB1,2),PKW(pB1,4),PKW(pB1,6)};pw3=(u32x4){PKW(pB1,8),PKW(pB1,10),PKW(pB1,12),PKW(pB1,14)};
    SBAR(); pv4(o,vb0+2*sl_cur,PAF(0),PAF(1),PAF(2),PAF(3)); }
  {auto rr=__builtin_amdgcn_permlane32_swap(__float_as_uint(l_reg),__float_as_uint(l_reg),false,false);l_reg=__uint_as_float(rr[0])+__uint_as_float(rr[1]);}
  if(hi==0)wsf[32+r32]=l_reg;asm volatile("s_waitcnt lgkmcnt(0)":::"memory");
  float rli[16];
  #pragma unroll
  for(int r=0;r<16;++r)rli[r]=__builtin_amdgcn_rcpf(wsf[32+crow(r,hi)]);
  bf16*Ow=O+(rowbase+q0+wid*QBLK)*DM+hvb*D;
  { bf16*stg=(bf16*)(shm+L2_OST)+wid*2048;
    #pragma unroll
    for(int hf=0;hf<2;++hf){
      #pragma unroll
      for(int r=0;r<16;++r){const int orow=crow(r,hi);
        #pragma unroll
        for(int d0=0;d0<2;++d0)stg[orow*64+d0*32+r32]=__float2bfloat16(o[2*hf+d0][r]*rli[r]);}
      asm volatile("s_waitcnt lgkmcnt(0)":::"memory");
      #pragma unroll
      for(int i=0;i<4;++i){const int row=i*8+(lane>>3),ch=lane&7; const u32x4 v=*(const u32x4*)(stg+row*64+ch*8); ATTN_STORE16(Ow+(long)row*DM+hf*64+ch*8,v);}
      asm volatile("s_waitcnt lgkmcnt(0)":::"memory");
    } }
  bool redo=false;
  if(FAST){
    volatile __attribute__((address_space(3))) unsigned* flg=(volatile __attribute__((address_space(3))) unsigned*)((lds_cptr)shm+L2_FLAG);
    bad=bad||(__any(!(ovf<1.0e18f))!=0);
    if(bad&&lane==0)flg[0]=1u;
    asm volatile("s_waitcnt lgkmcnt(0)\n\ts_barrier":::"memory");
    redo=flg[0]!=0u;
    asm volatile("s_waitcnt lgkmcnt(0)\n\ts_barrier":::"memory");
    if(wid==0&&lane==0)flg[0]=0u;
  }
  asm volatile("s_waitcnt lgkmcnt(0)\n\ts_barrier":::"memory");
  #undef DMA_K
  #undef DMA_V
  #undef CMASK
  #undef RESC
  #undef ROT
  #undef PKW
  #undef PAF
  #undef VFR
  #undef PIN
  #undef MX3
  #undef GAPA
  #undef GAPB
  #undef EX
  #undef VRDX
  #undef KRD
  #undef STEP
  #undef ENDW
  return redo;
}
constexpr int ATTN2_LDS_BYTES=L2_BYTES;
#undef ZERO16
#undef MFMA32
#undef SBAR
#undef WAIT_BAR
}

#define GAS __attribute__((address_space(1)))
#define LAS __attribute__((address_space(3)))
typedef unsigned short bf16;
typedef unsigned v4u __attribute__((ext_vector_type(4)));
typedef float f32x4 __attribute__((ext_vector_type(4)));
typedef short bf16x8 __attribute__((ext_vector_type(8)));
typedef GAS unsigned gu32;
typedef GAS unsigned long long gu64;
#define RLX_AGENT __ATOMIC_RELAXED, __HIP_MEMORY_SCOPE_AGENT
#define LDS_WAIT() asm volatile("s_waitcnt lgkmcnt(0)" ::: "memory")
#define VM_WAIT() asm volatile("s_waitcnt vmcnt(0)" ::: "memory")
__device__ __forceinline__ unsigned long long rt() { return __builtin_amdgcn_s_memrealtime(); }
__device__ __forceinline__ unsigned f2bf(float f) { unsigned u = __builtin_bit_cast(unsigned, f); return (u + 0x7fffu + ((u >> 16) & 1u)) >> 16; }
__device__ __forceinline__ unsigned pk2(float lo, float hi) { return f2bf(lo) | (f2bf(hi) << 16); }

#define XB_TMO      128
#define XB_XCNT(j)  (256  + 64 * (j))
#define XB_XSUB(j)  (1280 + 64 * (j))
#define XB_XGEN(j)  (2304 + 64 * (j))
#define XB_TOP      3328
#define XB_TOPGEN   3392
#define XCD_BAR_WORDS 3456
#define XB_SPIN_CAP (1u << 18)

__device__ __forceinline__ unsigned xb_ld(unsigned* p)              { return __hip_atomic_load(p, __ATOMIC_RELAXED, __HIP_MEMORY_SCOPE_AGENT); }
__device__ __forceinline__ unsigned xb_add(unsigned* p, unsigned v) { return __hip_atomic_fetch_add(p, v, __ATOMIC_RELAXED, __HIP_MEMORY_SCOPE_AGENT); }
__device__ __forceinline__ unsigned xb_xcc_id() { return (unsigned)__builtin_amdgcn_s_getreg((3 << 11) | 20) & 0xFu; }
#define XB_SPIN(cond, bar) do { unsigned _sp = 0; while (cond) { __builtin_amdgcn_s_sleep(1); \
    if ((++_sp & 255u) == 0u) { if (xb_ld(&(bar)[XB_TMO])) break; if (_sp > XB_SPIN_CAP) { atomicAdd(&(bar)[XB_TMO], 1u); break; } } } } while (0)

struct XcdBarrier {
    unsigned* bar; unsigned x;
    volatile LAS unsigned* st;
};

__device__ __forceinline__ XcdBarrier xcd_barrier_post(unsigned* bar, volatile LAS unsigned* st) {
    XcdBarrier b; b.bar = bar; b.x = xb_xcc_id(); b.st = st;
    if (threadIdx.x == 0) (void)xb_add(&bar[XB_XCNT(b.x)], 1u);
    return b;
}
__device__ __forceinline__ void xcd_barrier_complete(unsigned* bar, unsigned x, unsigned& nloc, unsigned& nx) {
    const unsigned G = gridDim.x * gridDim.y * gridDim.z;
    unsigned sum, cnt, mine, sp = 0u;
    for (;;) {
        sum = 0u; cnt = 0u; mine = 0u;
#pragma unroll
        for (unsigned j = 0; j < 16; ++j) { const unsigned c = xb_ld(&bar[XB_XCNT(j)]); sum += c; cnt += (c > 0u) ? 1u : 0u; mine = (j == x) ? c : mine; }
        if (sum == G) break;
        __builtin_amdgcn_s_sleep(1);
        if ((++sp & 255u) == 0u) { if (xb_ld(&bar[XB_TMO])) break; if (sp > XB_SPIN_CAP) { atomicAdd(&bar[XB_TMO], 1u); break; } }
    }
    nloc = mine > 0u ? mine : 1u; nx = cnt > 0u ? cnt : 1u;
}

__device__ __forceinline__ void xcd_barrier(const XcdBarrier& b, const bool leader) {
    asm volatile("s_waitcnt vmcnt(0)" ::: "memory");
    __syncthreads();
    if (leader) {
        unsigned* bar = b.bar;
        __builtin_amdgcn_s_waitcnt(0);
        unsigned nloc = b.st[0], nx = b.st[1];
        if (nloc == 0u) { xcd_barrier_complete(bar, b.x, nloc, nx); b.st[0] = nloc; b.st[1] = nx; }
        const unsigned old = xb_add(&bar[XB_XSUB(b.x)], 1u);
        const unsigned gen = old / nloc;
        if (old + 1u == (gen + 1u) * nloc) {
            __builtin_amdgcn_fence(__ATOMIC_RELEASE, "agent");
            asm volatile("s_waitcnt vmcnt(0)" ::: "memory");
            const unsigned og = xb_add(&bar[XB_TOP], 1u);
            const unsigned tg = og / nx;
            if (og + 1u == (tg + 1u) * nx) xb_add(&bar[XB_TOPGEN], 1u);
            else XB_SPIN(xb_ld(&bar[XB_TOPGEN]) == tg, bar);
            __builtin_amdgcn_fence(__ATOMIC_ACQUIRE, "agent");
            xb_add(&bar[XB_XGEN(b.x)], 1u);
            asm volatile("s_waitcnt vmcnt(0)" ::: "memory");
        } else {
            XB_SPIN(xb_ld(&bar[XB_XGEN(b.x)]) == gen, bar);
            __builtin_amdgcn_fence(__ATOMIC_ACQUIRE, "agent");
            asm volatile("s_waitcnt vmcnt(0)" ::: "memory");
        }
    }
    __syncthreads();
}


constexpr int NWAVES = 8;
constexpr int RING_OFF = 0, RING_BYTES = 131072;
constexpr int LDS_BYTES = 163840;
constexpr int LDSCTL_OFF = LDS_BYTES - 1024, MISC_OFF = LDSCTL_OFF + 320;
constexpr int ATT_TAB_OFF = 110592;
static_assert(attn_body::ATTN_LDS_BYTES <= ATT_TAB_OFF && attn_body::ATTN2_LDS_BYTES <= ATT_TAB_OFF && ATT_TAB_OFF + 8 * 384 * 4 <= RING_BYTES, "attention LDS map");
constexpr int CW_TMO = 0, CW_CODE = 1, CW_BAR = 4096;
static_assert((CW_BAR + XCD_BAR_WORDS) * 4 <= (int)CTL_ZERO_BYTES, "control words inside the memset region");
constexpr int N_PHASES = 9;
static_assert(RING_BYTES <= LDSCTL_OFF, "LDS map");
#ifndef MK_DUP23
#define MK_DUP23 0
#endif
#ifndef MK_DUP_ATTN
#define MK_DUP_ATTN 1
#endif
#ifndef MK_ATTN2
#define MK_ATTN2 1
#endif
#ifndef MK_ALIGN
#define MK_ALIGN true
#endif
#ifndef MK_SP2
#define MK_SP2 true
#endif

__device__ __forceinline__ float wave_sum(float v) {
#pragma unroll
    for (int o = 1; o < 64; o <<= 1) v += __shfl_xor(v, o);
    return v;
}
__device__ __forceinline__ float sigm(float x) { return __builtin_amdgcn_rcpf(1.0f + __builtin_amdgcn_exp2f(-1.4426950408889634f * x)); }

__device__ __forceinline__ void p0_transpose_item(const float* W, int N, bf16* WT, int ldt, int koff, LAS float* scr, int item, int lane, int rot = 0) {
    const int nblk = N / 32, kb = item / nblk, nb = item % nblk, k0 = 64 * kb, n0 = 32 * nb;
#pragma unroll 8
    for (int i = 0; i < 32; ++i) { const int kk = 2 * i + (lane >> 5); scr[kk * 33 + (lane & 31)] = W[(size_t)(k0 + kk) * N + n0 + (lane & 31)]; }
    LDS_WAIT(); asm volatile("" ::: "memory");
    const int c = lane & 7;
#pragma unroll
    for (int j = 0; j < 4; ++j) { const int n = (lane >> 3) + 8 * j; const LAS float* s = scr + (8 * c) * 33 + n;
        v4u o; o.x = pk2(s[0 * 33], s[1 * 33]); o.y = pk2(s[2 * 33], s[3 * 33]); o.z = pk2(s[4 * 33], s[5 * 33]); o.w = pk2(s[6 * 33], s[7 * 33]);
        *(GAS v4u*)(WT + (size_t)((n0 + n + rot) & (N - 1)) * ldt + koff + k0 + 8 * c) = o; }
    LDS_WAIT(); asm volatile("" ::: "memory");
}

constexpr int RNN_ROWS = 520, RNN_BUF = RNN_ROWS * 128, RNN_RG = 2 * RNN_BUF, RNN_TOT = RNN_RG + 8 * 2048, RNN_LDS = RNN_TOT + 2048;
__device__ __forceinline__ void rnn_phase(LAS unsigned char* lds, int vcu, int lane, int wave, const bf16* RX, bf16* YA, const float* conv_w, const float* conv_b,
                                          const float* w_a, const float* b_a, const float* w_x, const float* b_x, const float* lam, const bf16* zrow) {
    const int b = vcu >> 6, hb = (vcu >> 2) & 15, qd = vcu & 3, fr = lane & 15, fq = lane >> 4;
    const int cin0 = hb * 64, jo = qd * 16 + fr, co = hb * 64 + jo;
    bf16x8 Ba[4][2], Bx[4][2], Bs[4][2];
    float bav = b_a[co], bxv = b_x[co];
#pragma unroll
    for (int ks = 0; ks < 2; ++ks)
#pragma unroll
        for (int j = 0; j < 8; ++j) { const int i = 32 * ks + 8 * fq + j; const float wa = w_a[(size_t)hb * 4096 + i * 64 + jo], wx = w_x[(size_t)hb * 4096 + i * 64 + jo];
#pragma unroll
            for (int tp = 0; tp < 4; ++tp) { const float cwv = conv_w[tp * 1024 + cin0 + i];
                Ba[tp][ks][j] = (short)f2bf(cwv * wa); Bx[tp][ks][j] = (short)f2bf(cwv * wx); Bs[tp][ks][j] = (i == jo) ? (short)f2bf(cwv) : (short)0; } }
    for (int i = 0; i < 64; ++i) { const float cbi = conv_b[cin0 + i]; bav += cbi * w_a[(size_t)hb * 4096 + i * 64 + jo]; bxv += cbi * w_x[(size_t)hb * 4096 + i * 64 + jo]; }
    const float cbv = conv_b[co];
    const float logu = -8.0f * log1pf(expf(-lam[co])); const float logu2 = logu * 1.4426950408889634f, logu_2 = 2.0f * logu;
    float hsc = 0.f;
    const unsigned lds0 = (unsigned)(uintptr_t)lds;
    LAS float* tot = (LAS float*)(lds + RNN_TOT);
    const bf16* RXd = RX + (size_t)b * SEQ * 1024 + cin0 + (((lane & 7) - (lane >> 3)) & 7) * 8;
    const bf16* RGd = YA + (size_t)b * SEQ * 2048 + hb * 64 + qd * 16 + (lane & 1) * 8;
    const unsigned rgreg = lds0 + RNN_RG + wave * 2048;
#define RNN_DMA_RX(s_) do { const int T0_ = (s_) * 512; const unsigned bufb_ = lds0 + ((s_) & 1) * RNN_BUF; \
        for (int p_ = wave; p_ < RNN_ROWS / 8; p_ += 8) { const int tok_ = T0_ - 8 + 8 * p_ + (lane >> 3); \
            const bf16* src_ = (tok_ >= 0) ? RXd + (size_t)tok_ * 1024 : zrow; \
            attn_body::glds16(src_, (unsigned)__builtin_amdgcn_readfirstlane(bufb_ + p_ * 1024)); } } while (0)
#define RNN_DMA_RG(s_) do { const int t0_ = (s_) * 512 + wave * 64; \
        attn_body::glds16(RGd + (size_t)(t0_ + (lane >> 1)) * 2048, (unsigned)__builtin_amdgcn_readfirstlane(rgreg)); \
        attn_body::glds16(RGd + (size_t)(t0_ + 32 + (lane >> 1)) * 2048, (unsigned)__builtin_amdgcn_readfirstlane(rgreg + 1024)); } while (0)
    unsigned la[8];
#pragma unroll
    for (int j = 0; j < 8; ++j) la[j] = (unsigned)(fr * 128 + (((fq + fr + 5 + j) & 7) * 16));
    bf16* YAb = YA + (size_t)b * SEQ * 2048 + co;
    RNN_DMA_RX(0);
    asm volatile("s_waitcnt vmcnt(0) lgkmcnt(0)\n\ts_barrier" ::: "memory");
    for (int sc = 0; sc < SEQ / 512; ++sc) {
        const int t0 = sc * 512 + wave * 64;
        if (sc + 1 < SEQ / 512) RNN_DMA_RX(sc + 1);
        RNN_DMA_RG(sc);
        const LAS unsigned char* bufp = lds + (sc & 1) * RNN_BUF + (wave * 64 + 5) * 128;
        float hl[4][4], ac[4][4]; float Ach = 1.f, Hch = 0.f;
#pragma unroll
        for (int m = 0; m < 4; ++m) {
            f32x4 Dr = (f32x4){0.f, 0.f, 0.f, 0.f}, Di = Dr, Dx = Dr;
#pragma unroll
            for (int tp = 0; tp < 4; ++tp) {
                const bf16x8 a0 = *(const LAS bf16x8*)(bufp + (16 * m + tp) * 128 + la[tp & 7]);
                const bf16x8 a1 = *(const LAS bf16x8*)(bufp + (16 * m + tp) * 128 + la[(4 + tp) & 7]);
                Dr = __builtin_amdgcn_mfma_f32_16x16x32_bf16(a0, Ba[tp][0], Dr, 0, 0, 0); Di = __builtin_amdgcn_mfma_f32_16x16x32_bf16(a0, Bx[tp][0], Di, 0, 0, 0); Dx = __builtin_amdgcn_mfma_f32_16x16x32_bf16(a0, Bs[tp][0], Dx, 0, 0, 0);
                Dr = __builtin_amdgcn_mfma_f32_16x16x32_bf16(a1, Ba[tp][1], Dr, 0, 0, 0); Di = __builtin_amdgcn_mfma_f32_16x16x32_bf16(a1, Bx[tp][1], Di, 0, 0, 0); Dx = __builtin_amdgcn_mfma_f32_16x16x32_bf16(a1, Bs[tp][1], Dx, 0, 0, 0); }
            float al[4], hh[4];
#pragma unroll
            for (int r = 0; r < 4; ++r) { const float rr = sigm(Dr[r] + bav), ii = sigm(Di[r] + bxv); const float a = __builtin_amdgcn_exp2f(rr * logu2);
                const float e = rr * logu_2;
                const float pl = -e * (1.0f + e * 0.5f * (1.0f + e * (1.0f / 3.0f) * (1.0f + e * 0.25f * (1.0f + e * 0.2f))));
                const float om = (e > -0.3f) ? pl : (1.0f - a * a);
                const float bin = __builtin_amdgcn_sqrtf(om) * (ii * (Dx[r] + cbv));
                if (r == 0) { al[0] = a; hh[0] = bin; } else { al[r] = a * al[r - 1]; hh[r] = a * hh[r - 1] + bin; } }
            float Ai = al[3], Hi = hh[3];
            { const float Ap = __shfl_up(Ai, 16), Hp = __shfl_up(Hi, 16); if (fq >= 1) { Hi = Ai * Hp + Hi; Ai = Ai * Ap; } }
            { const float Ap = __shfl_up(Ai, 32), Hp = __shfl_up(Hi, 32); if (fq >= 2) { Hi = Ai * Hp + Hi; Ai = Ai * Ap; } }
            float Ae = __shfl_up(Ai, 16), He = __shfl_up(Hi, 16); if (fq == 0) { Ae = 1.f; He = 0.f; }
            const float hin = Ae * Hch + He, Ain = Ae * Ach;
#pragma unroll
            for (int r = 0; r < 4; ++r) { hl[m][r] = hh[r] + al[r] * hin; ac[m][r] = al[r] * Ain; }
            const float Am = __shfl(Ai, 48 + fr), Hm = __shfl(Hi, 48 + fr);
            Hch = Am * Hch + Hm; Ach = Am * Ach;
        }
        LAS float* tw = tot + ((sc & 1) * 8 + wave) * 32;
        if (fq == 0) { tw[fr * 2] = Ach; tw[fr * 2 + 1] = Hch; }
        asm volatile("s_waitcnt vmcnt(0) lgkmcnt(0)\n\ts_barrier" ::: "memory");
        float cin = 0.f, c = hsc;
#pragma unroll
        for (int w2 = 0; w2 < 8; ++w2) { const LAS float* tr = tot + ((sc & 1) * 8 + w2) * 32 + fr * 2; const float A = tr[0], H = tr[1]; if (w2 == wave) cin = c; c = A * c + H; }
        hsc = c;
        const LAS unsigned short* rgp = (const LAS unsigned short*)(lds + RNN_RG + wave * 2048) + fr;
#pragma unroll
        for (int m = 0; m < 4; ++m)
#pragma unroll
            for (int r = 0; r < 4; ++r) { const float h = hl[m][r] + ac[m][r] * cin; const unsigned short g = rgp[(16 * m + 4 * fq + r) * 16];
                YAb[(size_t)(t0 + 16 * m + 4 * fq + r) * 2048] = (bf16)f2bf(h * __uint_as_float(((unsigned)g) << 16)); }
        asm volatile("s_waitcnt lgkmcnt(0)" ::: "memory");
    }
#undef RNN_DMA_RX
#undef RNN_DMA_RG
    asm volatile("s_waitcnt vmcnt(0) lgkmcnt(0)\n\ts_barrier" ::: "memory");
}

static_assert(RNN_LDS <= LDSCTL_OFF, "rnn LDS map");
__device__ __forceinline__ void attn_phase_diff(unsigned char* lds_generic, LAS unsigned char* lds, int vcu, int tid, int wave, const bf16* Q, const bf16* K, const bf16* V, bf16* O0, bf16* O1, const float* rel_bias) {
    LAS float* tab = (LAS float*)(lds + ATT_TAB_OFF);
    for (int e = tid; e < 8 * 384; e += NWAVES * 64) { const int h = e / 384, n = e % 384 - 256; float val = -INFINITY;
        if (n >= 0) { int bk; if (n < 16) bk = n; else { bk = 16 + (int)(logf((float)n / 16.0f) / 2.0794415416798357f * 16.0f); bk = bk < 31 ? bk : 31; }
            val = (rel_bias[bk * 8 + h] - rel_bias[31 * 8 + h]) * 1.4426950408889634f; }
        tab[e] = val; }
    if (tid == 0) *(LAS unsigned*)(lds + attn_body::L2_FLAG) = 0u;
    asm volatile("s_waitcnt lgkmcnt(0)\n\ts_barrier" ::: "memory");
    const int g = vcu >> 3, s = vcu & 7, b = g >> 3, h = g & 7;
#if MK_ATTN2
    for (int i = 0; i < 8; ++i) {
        const int c = i >> 2, j = i & 3;
        const int qb = (j == 0) ? s : (j == 1) ? 15 - s : (j == 2) ? 16 + s : 31 - s;
        const bool redo = attn_body::attn_unit2<8, true>(b, h * 2 + c, h * 2, qb, (const attn_body::bf16*)Q, (const attn_body::bf16*)K, (const attn_body::bf16*)V, (attn_body::bf16*)(c == 0 ? O0 : O1), (char*)lds_generic,
                                 (attn_body::lds_fptr)(tab + h * 384), wave);
        if (redo) (void)attn_body::attn_unit2<8, false>(b, h * 2 + c, h * 2, qb, (const attn_body::bf16*)Q, (const attn_body::bf16*)K, (const attn_body::bf16*)V, (attn_body::bf16*)(c == 0 ? O0 : O1), (char*)lds_generic,
                                 (attn_body::lds_fptr)(tab + h * 384), wave);
    }
#else
    for (int i = 0; i < 16; ++i) {
        const int sub = i >> 2, c = sub >> 1, vh = sub & 1, j = i & 3;
        const int qb = (j == 0) ? s : (j == 1) ? 15 - s : (j == 2) ? 16 + s : 31 - s;
        attn_body::attn_unit<8>(b, h * 2 + c, h * 2 + vh, qb, (const attn_body::bf16*)Q, (const attn_body::bf16*)K, (const attn_body::bf16*)V, (attn_body::bf16*)(c == 0 ? O0 : O1), (char*)lds_generic,
                                (attn_body::lds_fptr)(tab + h * 384), wave);
    }
#endif
}

struct Args { const float* in[23]; float* out; unsigned char* ws; int ph_lo, ph_hi; };
typedef const __attribute__((address_space(4))) Args* KArgs;
__device__ __forceinline__ KArgs kargs() { auto p = __builtin_amdgcn_kernarg_segment_ptr(); asm volatile("" : "+s"(p)); return (KArgs)p; }
__device__ __forceinline__ int lane_id() { int l; asm volatile("v_mbcnt_lo_u32_b32 %0, -1, 0\n\tv_mbcnt_hi_u32_b32 %0, -1, %0" : "=v"(l)); return l; }
__global__ void __launch_bounds__(NWAVES * 64, 2) mk_fwd(Args args) {
    extern __shared__ __attribute__((aligned(16))) unsigned char lds_[];
    LAS unsigned char* lds = (LAS unsigned char*)lds_;
    volatile LAS unsigned* MISC = (volatile LAS unsigned*)(lds + MISC_OFF);
    const int wave = __builtin_amdgcn_readfirstlane((int)threadIdx.x >> 6);
    const int G = gridDim.x; const int vcu = (G % 8 == 0) ? ((int)blockIdx.x % 8) * (G / 8) + (int)blockIdx.x / 8 : (int)blockIdx.x;
    const int gw = vcu * NWAVES + wave, NGW = G * NWAVES;
    gu32* ctl = (gu32*)(args.ws + WS_CTL);
    for (int u = threadIdx.x; u < (LDS_BYTES - LDSCTL_OFF) / 4; u += NWAVES * 64) ((LAS unsigned*)(lds + LDSCTL_OFF))[u] = 0u;
    __syncthreads();
    const int lo = args.ph_lo, hi = args.ph_hi;
    const bool use_bar = (hi - lo) > 1;
    XcdBarrier bar; bar.bar = (unsigned*)(ctl + CW_BAR); bar.x = 0; bar.st = nullptr;
    if (use_bar) bar = xcd_barrier_post((unsigned*)(ctl + CW_BAR), MISC + 8);
#define IN(k) (lo <= (k) && (k) < hi)
#define SEAM(k) do { if (IN(k) && IN((k) + 1)) xcd_barrier(bar, wave == 0 && lane_id() == 0); } while (0)

    if (IN(0)) {
        KArgs A = kargs(); const int lane = lane_id(), tid = wave * 64 + lane; (void)tid;
        const float* cvec = A->in[1];
        const float* w_ada = A->in[2];
        const float* b_ada = A->in[3];
        const float* w_in = A->in[4];
        const float* w_rnn_out = A->in[18];
        const float* w_attn_out = A->in[19];
        const float* w_out = A->in[20];
        float* modf = (float*)(A->ws + WS_MODF);
        bf16* win_t = (bf16*)(A->ws + WS_WIN);
        bf16* wcat_t = (bf16*)(A->ws + WS_WCAT);
        bf16* wout_t = (bf16*)(A->ws + WS_WOUT);

        if (vcu < 192) {
            LAS float* scv = (LAS float*)lds;
            LAS float* red = (LAS float*)(lds + 16384);
#pragma unroll
            for (int i = 0; i < 8; ++i) { const int e = tid * 8 + i; const float cv = cvec[e]; scv[e] = cv * sigm(cv); }
            __syncthreads();
            const int e0 = vcu * 16, col = lane & 15, kg = lane >> 4;
            float a0 = 0.f, a1 = 0.f, a2 = 0.f, a3 = 0.f;
#pragma unroll 8
            for (int i = 0; i < 32; ++i) { const int k = wave * 128 + kg * 32 + i; const float w = w_ada[(size_t)k * 3072 + e0 + col];
                a0 += scv[k] * w; a1 += scv[1024 + k] * w; a2 += scv[2048 + k] * w; a3 += scv[3072 + k] * w; }
            a0 += __shfl_xor(a0, 16); a0 += __shfl_xor(a0, 32); a1 += __shfl_xor(a1, 16); a1 += __shfl_xor(a1, 32);
            a2 += __shfl_xor(a2, 16); a2 += __shfl_xor(a2, 32); a3 += __shfl_xor(a3, 16); a3 += __shfl_xor(a3, 32);
            if (kg == 0) { red[(wave * 4 + 0) * 16 + col] = a0; red[(wave * 4 + 1) * 16 + col] = a1; red[(wave * 4 + 2) * 16 + col] = a2; red[(wave * 4 + 3) * 16 + col] = a3; }
            __syncthreads();
            if (tid < 64) { const int bb = tid >> 4, cc = tid & 15; float sacc = b_ada[e0 + cc];
#pragma unroll
                for (int w2 = 0; w2 < 8; ++w2) sacc += red[(w2 * 4 + bb) * 16 + cc];
                modf[bb * 3072 + e0 + cc] = sacc; }
            __syncthreads();
        }
        LAS float* scr = (LAS float*)(lds + RING_OFF + wave * 16384);
        constexpr int I_IN = (DM / 64) * (NIN / 32), I_SQ = (DM / 64) * (DM / 32), NITEMS = I_IN + 3 * I_SQ;
        for (int it = gw; it < NITEMS; it += NGW) {
            int r = it;
            if (r < I_IN) { p0_transpose_item(w_in, NIN, win_t, DM, 0, scr, r, lane); continue; } r -= I_IN;
            if (r < I_SQ) { p0_transpose_item(w_rnn_out, DM, wcat_t, 2048, 0, scr, r, lane); continue; } r -= I_SQ;
            if (r < I_SQ) { p0_transpose_item(w_attn_out, DM, wcat_t, 2048, 1024, scr, r, lane); continue; } r -= I_SQ;
            p0_transpose_item(w_out, DM, wout_t, DM, 0, scr, r, lane);
        }
    }
    SEAM(0);
    if (IN(1)) {
        KArgs A = kargs(); const int lane = lane_id(), tid = wave * 64 + lane; (void)tid;
        const float* x = A->in[0];
        float* modf = (float*)(A->ws + WS_MODF);
        bf16* ubuf = (bf16*)((unsigned char*)A->out + DO_U);

        for (int blk = gw; blk < MTOK / 16; blk += NGW) {
            const int bb = (blk * 16) / SEQ; f32x4 sc4[4], sh4[4];
#pragma unroll
            for (int j = 0; j < 4; ++j) { sh4[j] = *(const GAS f32x4*)(modf + bb * 3072 + 256 * j + 4 * lane); sc4[j] = *(const GAS f32x4*)(modf + bb * 3072 + 1024 + 256 * j + 4 * lane) + 1.0f; }
            for (int rr = 0; rr < 16; ++rr) { const size_t row = (size_t)blk * 16 + rr;
                const GAS f32x4* xr = (const GAS f32x4*)(x + row * DM) + lane; GAS unsigned long long* o8 = (GAS unsigned long long*)(ubuf + row * DM) + lane;
#pragma unroll
                for (int j = 0; j < 4; ++j) { const f32x4 v = xr[64 * j] * sc4[j] + sh4[j]; o8[64 * j] = (unsigned long long)pk2(v.x, v.y) | ((unsigned long long)pk2(v.z, v.w) << 32); } }
        }
    }
    SEAM(1);
#if MK_DUP23
    for (int rep_ = 0; rep_ < 2; ++rep_) {
#endif
    if (IN(2)) {
        KArgs A = kargs(); const int lane = lane_id(), tid = wave * 64 + lane; (void)tid;
        bf16* ubuf = (bf16*)((unsigned char*)A->out + DO_U);
        bf16* win_t = (bf16*)(A->ws + WS_WIN);
        bf16* rxb = (bf16*)((unsigned char*)A->out + DO_RX);
        bf16* ya = (bf16*)(A->ws + WS_YA);
        bf16* qbuf = (bf16*)(A->ws + WS_Q);
        bf16* kbuf = (bf16*)(A->ws + WS_K);
        bf16* vbuf = (bf16*)(A->ws + WS_V);
        bf16* mgb = (bf16*)(A->ws + WS_MG);

        pg8::Gemm g{ubuf, win_t, MTOK, NIN, DM}; pg8::StaticOrder S; S.init(MTOK, NIN, G, (int)blockIdx.x);
        pg8::EpiProjV E{A->ws, (unsigned char*)A->out};
        pg8::gemm_phase<pg8::EpiProjV, pg8::StaticOrder, MK_ALIGN, MK_SP2>(lds + RING_OFF, g, S, E, tid);
    }
#if MK_DUP23 == 2
    }
#endif
    SEAM(2);
    if (IN(3)) {
        KArgs A = kargs(); const int lane = lane_id(), tid = wave * 64 + lane; (void)tid;
        bf16* rxb = (bf16*)((unsigned char*)A->out + DO_RX);
        bf16* ya = (bf16*)(A->ws + WS_YA);
        const float* conv_w = A->in[5];
        const float* conv_b = A->in[6];
        const float* w_rg_a = A->in[7];
        const float* b_rg_a = A->in[8];
        const float* w_rg_x = A->in[9];
        const float* b_rg_x = A->in[10];
        const float* lru_lambda = A->in[11];
 if (G == 256) rnn_phase(lds, vcu, lane, wave, rxb, ya, conv_w, conv_b, w_rg_a, b_rg_a, w_rg_x, b_rg_x, lru_lambda, (const bf16*)(A->ws + WS_ZERO)); }
#if MK_DUP23 == 1
    if (rep_ == 0) xcd_barrier(bar, wave == 0 && lane_id() == 0);
    }
#endif
    SEAM(3);
    if (IN(4)) {
        KArgs A = kargs(); const int lane = lane_id(), tid = wave * 64 + lane; (void)tid;
        bf16* qbuf = (bf16*)(A->ws + WS_Q);
        bf16* kbuf = (bf16*)(A->ws + WS_K);
        bf16* vbuf = (bf16*)(A->ws + WS_V);
        bf16* o0 = (bf16*)((unsigned char*)A->out + DO_O0);
        bf16* o1 = (bf16*)((unsigned char*)A->out + DO_O1);
        const float* rel_bias = A->in[17];
 if (G == 256) { for (int rep_ = 0; rep_ < MK_DUP_ATTN; ++rep_) attn_phase_diff(lds_, lds, vcu, tid, wave, qbuf, kbuf, vbuf, o0, o1, rel_bias); } }
    SEAM(4);
    if (IN(5)) {
        KArgs A = kargs(); const int lane = lane_id(), tid = wave * 64 + lane; (void)tid;
        const float* lq1 = A->in[12];
        const float* lk1 = A->in[13];
        const float* lq2 = A->in[14];
        const float* lk2 = A->in[15];
        const float* subln_w = A->in[16];
        bf16* o0 = (bf16*)((unsigned char*)A->out + DO_O0);
        bf16* o1 = (bf16*)((unsigned char*)A->out + DO_O1);
        bf16* ya = (bf16*)(A->ws + WS_YA);

        float s1 = lq1[lane] * lk1[lane], s2 = lq2[lane] * lk2[lane]; s1 = wave_sum(s1); s2 = wave_sum(s2);
        const float lamv = __expf(s1) - __expf(s2) + 0.2f;
        float sw[16];
#pragma unroll
        for (int i = 0; i < 16; ++i) sw[i] = subln_w[(lane * 16 + i) & 127] * 0.8f;
        for (int row = gw; row < MTOK; row += NGW) {
            const GAS v4u* p0 = (const GAS v4u*)(o0 + (size_t)row * 1024 + lane * 16); const GAS v4u* p1 = (const GAS v4u*)(o1 + (size_t)row * 1024 + lane * 16);
            GAS v4u* pa = (GAS v4u*)(ya + (size_t)row * 2048 + 1024 + lane * 16);
            float v[16]; float ss = 0.f; v4u agv[2];
#pragma unroll
            for (int hh = 0; hh < 2; ++hh) { const v4u a = p0[hh], bq = p1[hh]; agv[hh] = pa[hh];
                const unsigned aw[4] = {a.x, a.y, a.z, a.w}, bw[4] = {bq.x, bq.y, bq.z, bq.w};
#pragma unroll
                for (int e = 0; e < 4; ++e) { v[hh * 8 + 2 * e] = __uint_as_float(aw[e] << 16) - lamv * __uint_as_float(bw[e] << 16); v[hh * 8 + 2 * e + 1] = __uint_as_float(aw[e] & 0xffff0000u) - lamv * __uint_as_float(bw[e] & 0xffff0000u); } }
#pragma unroll
            for (int i = 0; i < 16; ++i) ss += v[i] * v[i];
            ss += __shfl_xor(ss, 1); ss += __shfl_xor(ss, 2); ss += __shfl_xor(ss, 4);
            const float rs = rsqrtf(ss * (1.f / 128.f) + LN_EPS);
#pragma unroll
            for (int hh = 0; hh < 2; ++hh) { const unsigned gwd[4] = {agv[hh].x, agv[hh].y, agv[hh].z, agv[hh].w}; v4u o;
                unsigned ow[4];
#pragma unroll
                for (int e = 0; e < 4; ++e) { const int i = hh * 8 + 2 * e; ow[e] = pk2(v[i] * rs * sw[i] * __uint_as_float(gwd[e] << 16), v[i + 1] * rs * sw[i + 1] * __uint_as_float(gwd[e] & 0xffff0000u)); }
                o.x = ow[0]; o.y = ow[1]; o.z = ow[2]; o.w = ow[3]; pa[hh] = o; }
        }
    }
    SEAM(5);
    if (IN(6)) {
        KArgs A = kargs(); const int lane = lane_id(), tid = wave * 64 + lane; (void)tid;
        bf16* ya = (bf16*)(A->ws + WS_YA);
        bf16* wcat_t = (bf16*)(A->ws + WS_WCAT);
        bf16* mgb = (bf16*)(A->ws + WS_MG);
        bf16* merged = (bf16*)(A->ws + WS_Q);

        pg8::Gemm g{ya, wcat_t, MTOK, DM, 2048}; pg8::StaticOrder S; S.init(MTOK, DM, G, (int)blockIdx.x);
        pg8::EpiMergeV E{mgb, merged};
        pg8::gemm_phase<pg8::EpiMergeV, pg8::StaticOrder, MK_ALIGN, MK_SP2>(lds + RING_OFF, g, S, E, tid);
    }
    SEAM(6);
    if (IN(7)) {
        KArgs A = kargs(); const int lane = lane_id(), tid = wave * 64 + lane; (void)tid;
        bf16* merged = (bf16*)(A->ws + WS_Q);
        bf16* wout_t = (bf16*)(A->ws + WS_WOUT);
        const float* x = A->in[0];
        float* modf = (float*)(A->ws + WS_MODF);
        float* outp = A->out;

        pg8::Gemm g{merged, wout_t, MTOK, DM, DM}; pg8::StaticOrder S; S.init(MTOK, DM, G, (int)blockIdx.x);
        pg8::EpiOutV E{x, modf, outp};
        pg8::gemm_phase<pg8::EpiOutV, pg8::StaticOrder, MK_ALIGN, MK_SP2>(lds + RING_OFF, g, S, E, tid);
    }
    SEAM(7);
    if (IN(8)) {
        KArgs A = kargs(); const int lane = lane_id(), tid = wave * 64 + lane; (void)tid;
        const float* ln_g = A->in[21];
        const float* ln_b = A->in[22];
        float* outp = A->out;

        f32x4 gg[4], bb[4];
#pragma unroll
        for (int j = 0; j < 4; ++j) { gg[j] = *(const GAS f32x4*)(ln_g + 256 * j + 4 * lane); bb[j] = *(const GAS f32x4*)(ln_b + 256 * j + 4 * lane); }
        for (int row = gw; row < MTOK; row += NGW) {
            GAS f32x4* p = (GAS f32x4*)(outp + (size_t)row * DM) + lane; f32x4 v[4]; float s = 0.f;
#pragma unroll
            for (int j = 0; j < 4; ++j) { v[j] = p[64 * j]; s += (v[j].x + v[j].y) + (v[j].z + v[j].w); }
            const float mean = wave_sum(s) * (1.f / DM); float s2 = 0.f;
#pragma unroll
            for (int j = 0; j < 4; ++j) { v[j] = v[j] - mean; s2 += (v[j].x * v[j].x + v[j].y * v[j].y) + (v[j].z * v[j].z + v[j].w * v[j].w); }
            const float rstd = rsqrtf(wave_sum(s2) * (1.f / DM) + LN_EPS);
#pragma unroll
            for (int j = 0; j < 4; ++j) p[64 * j] = v[j] * rstd * gg[j] + bb[j];
        }
    }
#undef IN
#undef SEAM
}

#ifndef MK_STEP
#define MK_STEP 4
#define MK_C0 6144
#define MK_C1 7168
#endif
extern "C" void kernel_launch(void* const* d_in, const int* in_sizes, int n_in, void* d_out, int out_size, void* d_ws, size_t ws_size, hipStream_t stream) {
    static int grid = 0;
    if (grid == 0) {
        if (n_in != 23 || out_size != MTOK * DM || ws_size < WS_END) { fprintf(stderr, "kernel_launch: unexpected shapes (n_in %d out %d ws %zu)\n", n_in, out_size, ws_size); grid = -1; return; }
        int dev = 0, cus = 0;
        if (hipGetDevice(&dev) != hipSuccess || hipDeviceGetAttribute(&cus, hipDeviceAttributeMultiprocessorCount, dev) != hipSuccess) { grid = -1; return; }
        if (hipFuncSetAttribute((const void*)mk_fwd, hipFuncAttributeMaxDynamicSharedMemorySize, LDS_BYTES) != hipSuccess) { fprintf(stderr, "kernel_launch: hipFuncSetAttribute failed\n"); grid = -1; return; }
        (void)hipGetLastError();
        grid = cus;
        if (grid != 256) { fprintf(stderr, "kernel_launch: built for 256 CUs, found %d\n", grid); }
    }
    if (grid < 0) return;
    (void)hipMemsetAsync((char*)d_ws + WS_CTL, 0, CTL_ZERO_BYTES, stream);
    Args a{};
    for (int i = 0; i < 23; ++i) a.in[i] = (const float*)d_in[i];
    a.out = (float*)d_out; a.ws = (unsigned char*)d_ws;
#define MK_RUN(lo_, hi_) do { a.ph_lo = (lo_); a.ph_hi = (hi_); hipLaunchKernelGGL(mk_fwd, dim3(grid), dim3(NWAVES * 64), LDS_BYTES, stream, a); } while (0)
    unsigned char* ws = (unsigned char*)d_ws; unsigned char* dob = (unsigned char*)d_out;
    bf16_t* ya = (bf16_t*)(ws + WS_YA); bf16_t* qb = (bf16_t*)(ws + WS_Q); bf16_t* kb = (bf16_t*)(ws + WS_K); bf16_t* vb = (bf16_t*)(ws + WS_V);
    bf16_t* rx = (bf16_t*)(dob + DO_RX); bf16_t* o0 = (bf16_t*)(dob + DO_O0); bf16_t* o1 = (bf16_t*)(dob + DO_O1);
    const float* conv_w = (const float*)d_in[5]; const float* conv_b = (const float*)d_in[6];
    const float* w_rg_a = (const float*)d_in[7]; const float* b_rg_a = (const float*)d_in[8]; const float* w_rg_x = (const float*)d_in[9]; const float* b_rg_x = (const float*)d_in[10];
    const float* lru_lambda = (const float*)d_in[11]; const float* lq1 = (const float*)d_in[12]; const float* lk1 = (const float*)d_in[13]; const float* lq2 = (const float*)d_in[14]; const float* lk2 = (const float*)d_in[15];
    const float* subln_w = (const float*)d_in[16]; const float* rel_bias = (const float*)d_in[17]; const float* ln_g = (const float*)d_in[21]; const float* ln_b = (const float*)d_in[22];
#if MK_STEP == 1
    MK_RUN(0, 1); MK_RUN(1, 2); MK_RUN(2, 3);
    k_rnn_simple<<<NB * 16, 64, 0, stream>>>(rx, ya, conv_w, conv_b, w_rg_a, b_rg_a, w_rg_x, b_rg_x, lru_lambda);
    k_attn_simple<<<NB * 8 * 2 * 32, 256, 0, stream>>>(qb, kb, vb, o0, o1, rel_bias);
    k_combine<<<MTOK / 4, 256, 0, stream>>>(o0, o1, ya, lq1, lk1, lq2, lk2, subln_w);
    MK_RUN(6, 7); MK_RUN(7, 8);
    k_ln<<<MTOK / 4, 256, 0, stream>>>((float*)d_out, ln_g, ln_b);
#elif MK_STEP == 11
    MK_RUN(0, 1); MK_RUN(1, 2); MK_RUN(2, 3);
    k_rnn_simple<<<NB * 16, 64, 0, stream>>>(rx, ya, conv_w, conv_b, w_rg_a, b_rg_a, w_rg_x, b_rg_x, lru_lambda);
    k_attn_simple<<<NB * 8 * 2 * 32, 256, 0, stream>>>(qb, kb, vb, o0, o1, rel_bias);
    k_combine<<<MTOK / 4, 256, 0, stream>>>(o0, o1, ya, lq1, lk1, lq2, lk2, subln_w);
    { EpiMerge e{(bf16_t*)(ws + WS_MG), qb}; k_gemm_simple<EpiMerge, true><<<dim3(DM / 64, MTOK / 64), 256, 0, stream>>>(ya, (bf16_t*)(ws + WS_WCAT), MTOK, DM, 2048, e); }
    { EpiOut e{(const float*)d_in[0], (const float*)(ws + WS_MODF), (float*)d_out}; k_gemm_simple<EpiOut, false><<<dim3(DM / 64, MTOK / 64), 256, 0, stream>>>(qb, (bf16_t*)(ws + WS_WOUT), MTOK, DM, DM, e); }
    k_ln<<<MTOK / 4, 256, 0, stream>>>((float*)d_out, ln_g, ln_b);
#elif MK_STEP == 12 || MK_STEP == 13
    MK_RUN(0, 1);
#if MK_STEP == 13
    MK_RUN(1, 2);
#else
    k_u<<<(unsigned)(((size_t)MTOK * DM + 255) / 256), 256, 0, stream>>>((const float*)d_in[0], (const float*)(ws + WS_MODF), (bf16_t*)(dob + DO_U));
#endif
    { EpiProj e{rx, ya, qb, kb, vb, (bf16_t*)(ws + WS_MG)}; k_gemm_simple<EpiProj, false><<<dim3(NIN / 64, MTOK / 64), 256, 0, stream>>>((bf16_t*)(dob + DO_U), (bf16_t*)(ws + WS_WIN), MTOK, NIN, DM, e); }
    k_rnn_simple<<<NB * 16, 64, 0, stream>>>(rx, ya, conv_w, conv_b, w_rg_a, b_rg_a, w_rg_x, b_rg_x, lru_lambda);
    k_attn_simple<<<NB * 8 * 2 * 32, 256, 0, stream>>>(qb, kb, vb, o0, o1, rel_bias);
    k_combine<<<MTOK / 4, 256, 0, stream>>>(o0, o1, ya, lq1, lk1, lq2, lk2, subln_w);
    { EpiMerge e{(bf16_t*)(ws + WS_MG), qb}; k_gemm_simple<EpiMerge, true><<<dim3(DM / 64, MTOK / 64), 256, 0, stream>>>(ya, (bf16_t*)(ws + WS_WCAT), MTOK, DM, 2048, e); }
    { EpiOut e{(const float*)d_in[0], (const float*)(ws + WS_MODF), (float*)d_out}; k_gemm_simple<EpiOut, false><<<dim3(DM / 64, MTOK / 64), 256, 0, stream>>>(qb, (bf16_t*)(ws + WS_WOUT), MTOK, DM, DM, e); }
    k_ln<<<MTOK / 4, 256, 0, stream>>>((float*)d_out, ln_g, ln_b);
#elif MK_STEP == 14
    MK_RUN(0, 1); MK_RUN(1, 2);
    { EpiProj e{rx, ya, qb, kb, vb, (bf16_t*)(ws + WS_MG)}; k_gemm_simple<EpiProj, false><<<dim3(NIN / 64, MTOK / 64), 256, 0, stream>>>((bf16_t*)(dob + DO_U), (bf16_t*)(ws + WS_WIN), MTOK, NIN, DM, e); }
    k_rnn_simple<<<NB * 16, 64, 0, stream>>>(rx, ya, conv_w, conv_b, w_rg_a, b_rg_a, w_rg_x, b_rg_x, lru_lambda);
    k_attn_simple<<<NB * 8 * 2 * 32, 256, 0, stream>>>(qb, kb, vb, o0, o1, rel_bias);
    k_combine<<<MTOK / 4, 256, 0, stream>>>(o0, o1, ya, lq1, lk1, lq2, lk2, subln_w);
    MK_RUN(6, 7); MK_RUN(7, 8);
    k_ln<<<MTOK / 4, 256, 0, stream>>>((float*)d_out, ln_g, ln_b);
#elif MK_STEP == 15
    MK_RUN(0, 1); MK_RUN(1, 2); MK_RUN(2, 3);
    { EpiProj e{rx, ya, qb, kb, vb, (bf16_t*)(ws + WS_MG)}; k_gemm_simple<EpiProj, false><<<dim3((MK_C1 - MK_C0) / 64, MTOK / 64), 256, 0, stream>>>((bf16_t*)(dob + DO_U), (bf16_t*)(ws + WS_WIN), MTOK, NIN, DM, e, MK_C0 / 64); }
    k_rnn_simple<<<NB * 16, 64, 0, stream>>>(rx, ya, conv_w, conv_b, w_rg_a, b_rg_a, w_rg_x, b_rg_x, lru_lambda);
    k_attn_simple<<<NB * 8 * 2 * 32, 256, 0, stream>>>(qb, kb, vb, o0, o1, rel_bias);
    k_combine<<<MTOK / 4, 256, 0, stream>>>(o0, o1, ya, lq1, lk1, lq2, lk2, subln_w);
    MK_RUN(6, 7); MK_RUN(7, 8);
    k_ln<<<MTOK / 4, 256, 0, stream>>>((float*)d_out, ln_g, ln_b);
#elif MK_STEP == 2
    MK_RUN(0, 1); MK_RUN(1, 2); MK_RUN(2, 3);
    k_rnn_simple<<<NB * 16, 64, 0, stream>>>(rx, ya, conv_w, conv_b, w_rg_a, b_rg_a, w_rg_x, b_rg_x, lru_lambda);
    MK_RUN(4, 5); MK_RUN(5, 6); MK_RUN(6, 7); MK_RUN(7, 8); MK_RUN(8, 9);
#elif MK_STEP == 3
    for (int p = 0; p < N_PHASES; ++p) MK_RUN(p, p + 1);
#else
    MK_RUN(0, N_PHASES);
#endif
}
```

```cpp
#include <hip/hip_runtime.h>
#include <cstdio>
#include <cstdint>
#include <cmath>

typedef unsigned short bf16_t;
#ifndef MK_ROT
#define MK_ROT 8
#endif
constexpr int NB = 4, SEQ = 8192, DM = 1024, MTOK = NB * SEQ, NIN = 8192;
constexpr float LN_EPS = 1e-5f;
constexpr float ALPHA = 1.189207115002721f;
constexpr float LOG2E = 1.4426950408889634f;
constexpr float C2 = 0.125f * LOG2E;

__device__ __forceinline__ float bf2f_(bf16_t v) { return __uint_as_float(((unsigned)v) << 16); }
__device__ __forceinline__ bf16_t f2bf_(float f) { unsigned u = __float_as_uint(f); return (bf16_t)((u + 0x7fffu + ((u >> 16) & 1u)) >> 16); }
__device__ __forceinline__ float sigmoidf_(float x) { return 1.f / (1.f + __expf(-x)); }
__device__ __forceinline__ float siluf_(float x) { return x / (1.f + __expf(-x)); }

constexpr size_t MiB = 1u << 20;
constexpr size_t WS_CTL = 0;
constexpr size_t WS_MODF = 1 * MiB + 512 * 1024;
constexpr size_t CTL_ZERO_BYTES = 512 * 1024;
constexpr size_t WS_ZERO = 1024;
constexpr size_t WS_WIN = 2 * MiB;
constexpr size_t WS_WCAT = 18 * MiB;
constexpr size_t WS_WOUT = 22 * MiB;
constexpr size_t WS_YA = 24 * MiB;
constexpr size_t WS_Q = 152 * MiB;
constexpr size_t WS_K = 216 * MiB;
constexpr size_t WS_V = 280 * MiB;
constexpr size_t WS_MG = 344 * MiB;
constexpr size_t WS_END = 472 * MiB;
constexpr size_t DO_U = 0, DO_RX = 64 * MiB, DO_O0 = 0, DO_O1 = 64 * MiB;

__global__ void k_mod(const float* __restrict__ c, const float* __restrict__ w_ada, const float* __restrict__ b_ada, float* __restrict__ modf) {
    const int idx = blockIdx.x * blockDim.x + threadIdx.x; if (idx >= NB * 3072) return;
    const int b = idx / 3072, e = idx % 3072; float acc = 0.f;
    for (int k = 0; k < DM; ++k) acc += siluf_(c[b * DM + k]) * w_ada[(size_t)k * 3072 + e];
    modf[idx] = acc + b_ada[e];
}
__global__ void k_u(const float* __restrict__ x, const float* __restrict__ modf, bf16_t* __restrict__ u) {
    const size_t idx = (size_t)blockIdx.x * blockDim.x + threadIdx.x; if (idx >= (size_t)MTOK * DM) return;
    const int d = (int)(idx % DM); const int b = (int)(idx / ((size_t)SEQ * DM));
    u[idx] = f2bf_(x[idx] * (1.f + modf[b * 3072 + 1024 + d]) + modf[b * 3072 + d]);
}
__global__ void k_transpose(const float* __restrict__ W, int K, int N, bf16_t* __restrict__ WT, int ldt, int koff) {
    const size_t idx = (size_t)blockIdx.x * blockDim.x + threadIdx.x; if (idx >= (size_t)K * N) return;
    const int k = (int)(idx / N), n = (int)(idx % N);
    WT[(size_t)n * ldt + koff + k] = f2bf_(W[idx]);
}

struct EpiProj {
    bf16_t *rx, *ya, *q, *k, *v, *mg;
    __device__ __forceinline__ void mid(int, int, float&) const {}
    __device__ __forceinline__ void operator()(int m, int n, float a) const {
        const int g = n >> 10, c = n & 1023;
        if (g == 0) rx[(size_t)m * 1024 + c] = f2bf_(a);
        else if (g == 1) ya[(size_t)m * 2048 + c] = f2bf_(siluf_(a));
        else if (g == 2) q[(size_t)m * 1024 + c] = f2bf_(a * C2);
        else if (g == 3) k[(size_t)m * 1024 + c] = f2bf_(a);
        else if (g == 4) v[(size_t)m * 1024 + c] = f2bf_(a);
        else if (g == 5) ya[(size_t)m * 2048 + 1024 + c] = f2bf_(siluf_(a));
        else mg[(size_t)m * 2048 + (n - 6144)] = f2bf_(sigmoidf_(a));
    }
};
struct EpiMerge {
    const bf16_t* mg; bf16_t* merged;
    __device__ __forceinline__ void mid(int m, int n, float& a) const { a *= bf2f_(mg[(size_t)m * 2048 + n]) / bf2f_(mg[(size_t)m * 2048 + 1024 + n]); }
    __device__ __forceinline__ void operator()(int m, int n, float a) const { merged[(size_t)m * 1024 + n] = f2bf_(a * bf2f_(mg[(size_t)m * 2048 + 1024 + n])); }
};
struct EpiOut {
    const float* x; const float* modf; float* z;
    __device__ __forceinline__ void mid(int, int, float&) const {}
    __device__ __forceinline__ void operator()(int m, int n, float a) const { const int b = m / SEQ; z[(size_t)m * 1024 + n] = ALPHA * x[(size_t)m * 1024 + n] + modf[b * 3072 + 2048 + n] * a; }
};

template <class Epi, bool MID>
__global__ void __launch_bounds__(256) k_gemm_simple(const bf16_t* __restrict__ A, const bf16_t* __restrict__ Bt, int M, int N, int K, Epi epi, int nblk0 = 0) {
    __shared__ float As[16][68], Bs[16][68];
    const int tid = threadIdx.x, tx = tid & 15, ty = tid >> 4;
    const int m0 = blockIdx.y * 64, n0 = (blockIdx.x + nblk0) * 64;
    float acc[4][4];
#pragma unroll
    for (int i = 0; i < 4; ++i)
#pragma unroll
        for (int j = 0; j < 4; ++j) acc[i][j] = 0.f;
    for (int k0 = 0; k0 < K; k0 += 16) {
        if (MID && k0 == K / 2) {
#pragma unroll
            for (int i = 0; i < 4; ++i)
#pragma unroll
                for (int j = 0; j < 4; ++j) epi.mid(m0 + ty * 4 + i, n0 + tx * 4 + j, acc[i][j]);
        }
#pragma unroll
        for (int e = 0; e < 4; ++e) {
            const int idx = tid + e * 256, r = idx >> 4, kk = idx & 15;
            As[kk][r] = bf2f_(A[(size_t)(m0 + r) * K + k0 + kk]);
            Bs[kk][r] = bf2f_(Bt[(size_t)(n0 + r) * K + k0 + kk]);
        }
        __syncthreads();
#pragma unroll
        for (int kk = 0; kk < 16; ++kk) {
            float a[4], b[4];
#pragma unroll
            for (int i = 0; i < 4; ++i) { a[i] = As[kk][ty * 4 + i]; b[i] = Bs[kk][tx * 4 + i]; }
#pragma unroll
            for (int i = 0; i < 4; ++i)
#pragma unroll
                for (int j = 0; j < 4; ++j) acc[i][j] += a[i] * b[j];
        }
        __syncthreads();
    }
#pragma unroll
    for (int i = 0; i < 4; ++i)
#pragma unroll
        for (int j = 0; j < 4; ++j) epi(m0 + ty * 4 + i, n0 + tx * 4 + j, acc[i][j]);
}

__global__ void __launch_bounds__(64) k_rnn_simple(const bf16_t* __restrict__ rx, bf16_t* __restrict__ ya, const float* __restrict__ conv_w, const float* __restrict__ conv_b,
                                                   const float* __restrict__ w_a, const float* __restrict__ b_a, const float* __restrict__ w_x, const float* __restrict__ b_x, const float* __restrict__ lam) {
    __shared__ float xs[64];
    const int b = blockIdx.x / 16, hb = blockIdx.x % 16, j = threadIdx.x, ch = hb * 64 + j;
    float wa[64], wx[64];
#pragma unroll
    for (int i = 0; i < 64; ++i) { wa[i] = w_a[(size_t)hb * 4096 + i * 64 + j]; wx[i] = w_x[(size_t)hb * 4096 + i * 64 + j]; }
    const float cw0 = conv_w[ch], cw1 = conv_w[1024 + ch], cw2 = conv_w[2048 + ch], cw3 = conv_w[3072 + ch], cb = conv_b[ch];
    const float ba = b_a[ch], bx = b_x[ch];
    const float L = lam[ch]; const float sp = log1pf(expf(-L));
    const float logu = -8.0f * sp;
    float x1 = 0.f, x2 = 0.f, x3 = 0.f, h = 0.f;
    for (int t = 0; t < SEQ; ++t) {
        const size_t row = (size_t)b * SEQ + t;
        const float x0 = bf2f_(rx[row * 1024 + ch]);
        const float xc = cw0 * x3 + cw1 * x2 + cw2 * x1 + cw3 * x0 + cb;
        x3 = x2; x2 = x1; x1 = x0;
        __syncthreads(); xs[j] = xc; __syncthreads();
        float ra = ba, ri = bx;
#pragma unroll
        for (int i = 0; i < 64; ++i) { const float xv = xs[i]; ra += xv * wa[i]; ri += xv * wx[i]; }
        const float r = sigmoidf_(ra), ig = sigmoidf_(ri);
        const float la = r * logu; const float a = expf(la); const float bin = sqrtf(-expm1f(2.f * la)) * (ig * xc);
        h = a * h + bin;
        const size_t o = row * 2048 + ch;
        ya[o] = f2bf_(h * bf2f_(ya[o]));
    }
}

__device__ __forceinline__ int t5_bucket(int n) {
    if (n < 16) return n;
    int l = 16 + (int)(logf((float)n / 16.0f) / 2.0794415416798357f * 16.0f);
    return l < 31 ? l : 31;
}
__global__ void __launch_bounds__(256) k_attn_simple(const bf16_t* __restrict__ Q, const bf16_t* __restrict__ K, const bf16_t* __restrict__ V, bf16_t* __restrict__ O0, bf16_t* __restrict__ O1, const float* __restrict__ rel_bias) {
    __shared__ float tab[128];
    const int qb = blockIdx.x % 32, c = (blockIdx.x / 32) % 2, h = (blockIdx.x / 64) % 8, b = blockIdx.x / 512;
    if (threadIdx.x < 128) tab[threadIdx.x] = rel_bias[t5_bucket(threadIdx.x) * 8 + h] * LOG2E;
    __syncthreads();
    const float far = rel_bias[31 * 8 + h] * LOG2E;
    const int qi = qb * 256 + threadIdx.x; const size_t rowq = (size_t)b * SEQ + qi;
    float q[64], o[128];
#pragma unroll
    for (int d = 0; d < 64; ++d) q[d] = bf2f_(Q[rowq * 1024 + h * 128 + c * 64 + d]);
#pragma unroll
    for (int e = 0; e < 128; ++e) o[e] = 0.f;
    float m = -INFINITY, l = 0.f;
    const int kend = qb * 256 + 255;
    for (int kk = 0; kk <= kend; ++kk) {
        const size_t rowk = (size_t)b * SEQ + kk;
        const bf16_t* kp = K + rowk * 1024 + h * 128 + c * 64;
        float s = 0.f;
#pragma unroll
        for (int d = 0; d < 64; ++d) s += q[d] * bf2f_(kp[d]);
        const int n = qi - kk;
        if (n >= 0) {
            s += (n < 128) ? tab[n] : far;
            if (s > m) { const float f = exp2f(m - s); l *= f;
#pragma unroll
                for (int e = 0; e < 128; ++e) o[e] *= f;
                m = s; }
            const float p = exp2f(s - m); l += p;
            const bf16_t* vp = V + rowk * 1024 + h * 128;
#pragma unroll
            for (int e = 0; e < 128; ++e) o[e] += p * bf2f_(vp[e]);
        }
    }
    bf16_t* Op = (c == 0 ? O0 : O1) + rowq * 1024 + h * 128; const float il = 1.f / l;
#pragma unroll
    for (int e = 0; e < 128; ++e) Op[e] = f2bf_(o[e] * il);
}

__global__ void __launch_bounds__(256) k_combine(const bf16_t* __restrict__ O0, const bf16_t* __restrict__ O1, bf16_t* __restrict__ ya, const float* __restrict__ lq1, const float* __restrict__ lk1,
                                                 const float* __restrict__ lq2, const float* __restrict__ lk2, const float* __restrict__ subw) {
    const int lane = threadIdx.x & 63, row = blockIdx.x * 4 + (threadIdx.x >> 6);
    float s1 = lq1[lane] * lk1[lane], s2 = lq2[lane] * lk2[lane];
#pragma unroll
    for (int o = 1; o < 64; o <<= 1) { s1 += __shfl_xor(s1, o); s2 += __shfl_xor(s2, o); }
    const float lam = expf(s1) - expf(s2) + 0.2f;
    const int col = lane * 16;
    float v[16]; float ss = 0.f;
#pragma unroll
    for (int i = 0; i < 16; ++i) { v[i] = bf2f_(O0[(size_t)row * 1024 + col + i]) - lam * bf2f_(O1[(size_t)row * 1024 + col + i]); ss += v[i] * v[i]; }
    ss += __shfl_xor(ss, 1); ss += __shfl_xor(ss, 2); ss += __shfl_xor(ss, 4);
    const float rs = rsqrtf(ss * (1.f / 128.f) + LN_EPS) * 0.8f;
#pragma unroll
    for (int i = 0; i < 16; ++i) { const size_t o = (size_t)row * 2048 + 1024 + col + i; ya[o] = f2bf_(v[i] * rs * subw[(col + i) & 127] * bf2f_(ya[o])); }
}

__global__ void __launch_bounds__(256) k_ln(float* __restrict__ z, const float* __restrict__ g, const float* __restrict__ bta) {
    const int lane = threadIdx.x & 63, row = blockIdx.x * 4 + (threadIdx.x >> 6);
    float4* p = (float4*)(z + (size_t)row * 1024) + lane; float4 v[4]; float s = 0.f;
#pragma unroll
    for (int j = 0; j < 4; ++j) { v[j] = p[64 * j]; s += (v[j].x + v[j].y) + (v[j].z + v[j].w); }
#pragma unroll
    for (int o = 1; o < 64; o <<= 1) s += __shfl_xor(s, o);
    const float mean = s * (1.f / 1024.f); float q = 0.f;
#pragma unroll
    for (int j = 0; j < 4; ++j) { v[j].x -= mean; v[j].y -= mean; v[j].z -= mean; v[j].w -= mean; q += (v[j].x * v[j].x + v[j].y * v[j].y) + (v[j].z * v[j].z + v[j].w * v[j].w); }
#pragma unroll
    for (int o = 1; o < 64; o <<= 1) q += __shfl_xor(q, o);
    const float rstd = rsqrtf(q * (1.f / 1024.f) + LN_EPS);
#pragma unroll
    for (int j = 0; j < 4; ++j) { const float4 gg = ((const float4*)g)[lane + 64 * j], bb = ((const float4*)bta)[lane + 64 * j];
        float4 o; o.x = v[j].x * rstd * gg.x + bb.x; o.y = v[j].y * rstd * gg.y + bb.y; o.z = v[j].z * rstd * gg.z + bb.z; o.w = v[j].w * rstd * gg.w + bb.w; p[64 * j] = o; }
}

namespace pg8 {
#define PG8_LAS __attribute__((address_space(3)))
typedef unsigned short bf16_t;
typedef short bf16x8 __attribute__((ext_vector_type(8)));
typedef float f32x4 __attribute__((ext_vector_type(4)));
typedef unsigned u32x4 __attribute__((ext_vector_type(4)));
constexpr int BM = 256, BK = 64, HALF = 128, HTB = HALF * BK * 2  , STAGE_BYTES = 8 * HTB, NXCD = 8, WGM = 8;

__host__ __device__ __forceinline__ int lds_byte(int r, int c) { const int st = (r >> 4) * 2 + (c >> 5), rr = r & 15, cc = c & 31, ob = rr * 64 + cc * 2; return st * 1024 + (ob ^ (((ob >> 9) & 1) << 5)); }
__host__ __device__ __forceinline__ void stage_rc(int b, int& R, int& C) { const int st = b / 1024, sb = b % 1024, swz = sb ^ (((sb >> 9) & 1) << 5); R = (st >> 1) * 16 + swz / 64; C = (st & 1) * 32 + (swz % 64) / 2; }
__host__ __device__ __forceinline__ int perm32(int rho) { const int n = rho >> 4, i = rho & 15; return 8 * (i >> 2) + 4 * n + (i & 3); }

struct Unit { int pm, pn; };
struct Gemm { const bf16_t* A; const bf16_t* Bt; int M, N, K; };

struct StaticOrder {
    int nM, nN, nwg, G, c;
    __host__ __device__ void init(int M, int N, int G_, int c_) { nM = M / BM; nN = N / BM; nwg = nM * nN; G = G_; c = c_; }
    __host__ __device__ bool next(int i, Unit& u) const {
        const long L = (long)i * G + c; if (L >= nwg) return false;
        int wgid = (int)L; { const int q = nwg / NXCD, r = nwg % NXCD, xcd = wgid % NXCD, off = wgid / NXCD; wgid = (xcd < r ? xcd * (q + 1) : r * (q + 1) + (xcd - r) * q) + off; }
        const int nig = WGM * nN, gid = wgid / nig, fm = gid * WGM, gsz = (nM - fm) < WGM ? (nM - fm) : WGM;
        u.pm = fm + ((wgid % nig) % gsz); u.pn = (wgid % nig) / gsz; return true;
    }
    __device__ __forceinline__ void a_ready(const Unit&) const {}
    __device__ __forceinline__ void done(const Unit&) const {}
};


typedef float f32x2_cv __attribute__((ext_vector_type(2))); typedef __bf16 bf16x2_cv __attribute__((ext_vector_type(2)));
__device__ __forceinline__ unsigned cvt_pk_bf16(float lo, float hi) { f32x2_cv v = {lo, hi}; bf16x2_cv b = __builtin_convertvector(v, bf16x2_cv); return __builtin_bit_cast(unsigned, b); }
__device__ __forceinline__ float fast_sigmoid(float x) { return __builtin_amdgcn_rcpf(1.0f + __builtin_amdgcn_exp2f(-1.4426950408889634f * x)); }
__device__ __forceinline__ float bflo(unsigned w) { return __uint_as_float(w << 16); }
__device__ __forceinline__ float bfhi(unsigned w) { return __uint_as_float(w & 0xffff0000u); }

struct EpiProjV {
    static constexpr bool PERM = true, AFTER_DRAIN = false, HAS_MID = false;
    unsigned char* ws; unsigned char* dob;
    template <int ACT> __device__ __forceinline__ void run(const f32x4 (&acc)[2][2][4][2], bf16_t* base, int ldc, int row0, float sc) const {
#pragma unroll
        for (int ai = 0; ai < 2; ++ai)
#pragma unroll
            for (int m = 0; m < 4; ++m) { bf16_t* rowp = base + (size_t)(row0 + ai * HALF + m * 16) * ldc;
#pragma unroll
                for (int bj = 0; bj < 2; ++bj) { f32x4 v0 = acc[ai][bj][m][0], v1 = acc[ai][bj][m][1];
                    if (ACT == 0) { v0 = v0 * sc; v1 = v1 * sc; }
                    if (ACT == 1) {
#pragma unroll
                        for (int e = 0; e < 4; ++e) { v0[e] = v0[e] * fast_sigmoid(v0[e]); v1[e] = v1[e] * fast_sigmoid(v1[e]); } }
                    if (ACT == 2) {
#pragma unroll
                        for (int e = 0; e < 4; ++e) { v0[e] = fast_sigmoid(v0[e]); v1[e] = fast_sigmoid(v1[e]); } }
                    u32x4 w; w.x = cvt_pk_bf16(v0[0], v0[1]); w.y = cvt_pk_bf16(v0[2], v0[3]); w.z = cvt_pk_bf16(v1[0], v1[1]); w.w = cvt_pk_bf16(v1[2], v1[3]);
                    *(u32x4*)(rowp + bj * HALF) = w; } }
    }
    __device__ __forceinline__ void operator()(const f32x4 (&acc)[2][2][4][2], const Unit& u, int wr, int wc, int fr, int fq) const {
        const int g = u.pn >> 2, colt = (u.pn & 3) * BM + wc * 32 + 8 * fq; int row0 = u.pm * BM + wr * 64 + fr; asm volatile("" : "+v"(row0));
        const size_t goff = (g == 0) ? DO_RX : (g == 1) ? WS_YA : (g == 2) ? WS_Q : (g == 3) ? WS_K : (g == 4) ? WS_V : (g == 5) ? WS_YA + 2048 : (g == 6) ? WS_MG : WS_MG + 2048;
        bf16_t* base = (bf16_t*)((g == 0 ? dob : ws) + goff) + colt;
        const int ldc = (g == 1 || g >= 5) ? 2048 : 1024;
        if (g == 1 || g == 5) run<1>(acc, base, ldc, row0, 1.0f);
        else if (g >= 6) run<2>(acc, base, ldc, row0, 1.0f);
        else run<0>(acc, base, ldc, row0, g == 2 ? C2 : 1.0f);
    }
};

struct EpiMergeV {
    static constexpr bool PERM = true, AFTER_DRAIN = false, HAS_MID = true;
    const bf16_t* mg; bf16_t* merged;
    __device__ __forceinline__ void mid(f32x4 (&acc)[2][2][4][2], const Unit& u, int wr, int wc, int fr, int fq) const {
        const int col0 = u.pn * BM + wc * 32 + 8 * fq; int row0 = u.pm * BM + wr * 64 + fr; asm volatile("" : "+v"(row0));
#pragma unroll
        for (int ai = 0; ai < 2; ++ai)
#pragma unroll
            for (int m = 0; m < 4; ++m) { const bf16_t* rowp = mg + (size_t)(row0 + ai * HALF + m * 16) * 2048 + col0;
#pragma unroll
                for (int bj = 0; bj < 2; ++bj) { const u32x4 a = *(const u32x4*)(rowp + bj * HALF), b = *(const u32x4*)(rowp + 1024 + bj * HALF);
                    f32x4 r0, r1;
                    r0[0] = bflo(a.x) * __builtin_amdgcn_rcpf(bflo(b.x)); r0[1] = bfhi(a.x) * __builtin_amdgcn_rcpf(bfhi(b.x)); r0[2] = bflo(a.y) * __builtin_amdgcn_rcpf(bflo(b.y)); r0[3] = bfhi(a.y) * __builtin_amdgcn_rcpf(bfhi(b.y));
                    r1[0] = bflo(a.z) * __builtin_amdgcn_rcpf(bflo(b.z)); r1[1] = bfhi(a.z) * __builtin_amdgcn_rcpf(bfhi(b.z)); r1[2] = bflo(a.w) * __builtin_amdgcn_rcpf(bflo(b.w)); r1[3] = bfhi(a.w) * __builtin_amdgcn_rcpf(bfhi(b.w));
                    acc[ai][bj][m][0] = acc[ai][bj][m][0] * r0; acc[ai][bj][m][1] = acc[ai][bj][m][1] * r1; } }
    }
    __device__ __forceinline__ void operator()(const f32x4 (&acc)[2][2][4][2], const Unit& u, int wr, int wc, int fr, int fq) const {
        const int col0 = u.pn * BM + wc * 32 + 8 * fq; int row0 = u.pm * BM + wr * 64 + fr; asm volatile("" : "+v"(row0));
#pragma unroll
        for (int ai = 0; ai < 2; ++ai)
#pragma unroll
            for (int m = 0; m < 4; ++m) { const size_t r = (size_t)(row0 + ai * HALF + m * 16);
#pragma unroll
                for (int bj = 0; bj < 2; ++bj) { const u32x4 b = *(const u32x4*)(mg + r * 2048 + 1024 + col0 + bj * HALF);
                    f32x4 v0 = acc[ai][bj][m][0], v1 = acc[ai][bj][m][1];
                    v0[0] *= bflo(b.x); v0[1] *= bfhi(b.x); v0[2] *= bflo(b.y); v0[3] *= bfhi(b.y); v1[0] *= bflo(b.z); v1[1] *= bfhi(b.z); v1[2] *= bflo(b.w); v1[3] *= bfhi(b.w);
                    u32x4 w; w.x = cvt_pk_bf16(v0[0], v0[1]); w.y = cvt_pk_bf16(v0[2], v0[3]); w.z = cvt_pk_bf16(v1[0], v1[1]); w.w = cvt_pk_bf16(v1[2], v1[3]);
                    *(u32x4*)(merged + r * 1024 + col0 + bj * HALF) = w; } }
    }
};

struct EpiOutV {
    static constexpr bool PERM = false, AFTER_DRAIN = false, HAS_MID = false;
    const float* x; const float* modf; float* z;
    __device__ __forceinline__ void operator()(const f32x4 (&acc)[2][2][4][2], const Unit& u, int wr, int wc, int fr, int fq) const {
        const int col0 = u.pn * BM + wc * 32 + 4 * fq, b = (u.pm * BM) / SEQ; int row0 = u.pm * BM + wr * 64 + fr; asm volatile("" : "+v"(row0));
        f32x4 gv[2][2];
#pragma unroll
        for (int bj = 0; bj < 2; ++bj)
#pragma unroll
            for (int n = 0; n < 2; ++n) gv[bj][n] = *(const f32x4*)(modf + b * 3072 + 2048 + col0 + bj * HALF + n * 16);
#pragma unroll
        for (int ai = 0; ai < 2; ++ai)
#pragma unroll
            for (int m = 0; m < 4; ++m) { const size_t off = (size_t)(row0 + ai * HALF + m * 16) * 1024 + col0;
#pragma unroll
                for (int bj = 0; bj < 2; ++bj)
#pragma unroll
                    for (int n = 0; n < 2; ++n) { const f32x4 xv = *(const f32x4*)(x + off + bj * HALF + n * 16);
                        *(f32x4*)(z + off + bj * HALF + n * 16) = xv * ALPHA + gv[bj][n] * acc[ai][bj][m][n]; } }
    }
};

template <class Epi, class Sched, bool ALIGN_EPI = false, bool SP2 = false>
__device__ __forceinline__ void gemm_phase(PG8_LAS unsigned char* lds, const Gemm g, const Sched& S, const Epi& E, const int tid_in) {
    const int tid = tid_in, wid = __builtin_amdgcn_readfirstlane(tid >> 6), lane = tid & 63, wr = wid >> 2, wc = wid & 3, fr = lane & 15, fq = lane >> 4;
    const int K = g.K, nt = K / BK;
    unsigned voffA[2], voffB[2];
#pragma unroll
    for (int i = 0; i < 2; ++i) { int R, C; stage_rc(tid * 16 + i * 8192, R, C); const int Rb = Epi::PERM ? ((R & ~31) + perm32(R & 31)) : R;
        voffA[i] = (unsigned)(R * K + C) * 2u; voffB[i] = (unsigned)(Rb * K + C) * 2u; }
    const size_t kstep = (size_t)(BK * 2);
    const size_t hstep = (size_t)HALF * K * 2;
    const size_t tstep = 2 * hstep;
    const unsigned ldsw = (unsigned)wid * 1024u;
    const int aoff = lds_byte(wr * 64 + fr, fq * 8), boff = lds_byte(wc * 32 + fr, fq * 8);
#define PG8_SA(b, h) (((b) * 2 + (h)) * HTB)
#define PG8_SB(b, h) ((4 + (b) * 2 + (h)) * HTB)
#define PG8_STAGE(bufoff, gbase, voff) do { _Pragma("unroll") for (int _i = 0; _i < 2; ++_i) \
        __builtin_amdgcn_global_load_lds((const unsigned*)((const char*)(gbase) + (voff)[_i]), (PG8_LAS unsigned*)(lds + (bufoff) + ldsw + _i * 8192), 16, 0, 0); } while (0)
#define PG8_LDA(dst, b, h) do { _Pragma("unroll") for (int m = 0; m < 4; ++m) _Pragma("unroll") for (int k = 0; k < 2; ++k) dst[m][k] = *(const PG8_LAS bf16x8*)(lds + PG8_SA(b, h) + aoff + m * 2048 + k * 1024); } while (0)
#define PG8_LDB(dst, b, h) do { _Pragma("unroll") for (int n = 0; n < 2; ++n) _Pragma("unroll") for (int k = 0; k < 2; ++k) dst[n][k] = *(const PG8_LAS bf16x8*)(lds + PG8_SB(b, h) + boff + n * 2048 + k * 1024); } while (0)
#define PG8_MMA(ai, bj, At, Bt) do { __builtin_amdgcn_s_setprio(1); _Pragma("unroll") for (int m = 0; m < 4; ++m) _Pragma("unroll") for (int n = 0; n < 2; ++n) _Pragma("unroll") for (int k = 0; k < 2; ++k) \
        acc[ai][bj][m][n] = __builtin_amdgcn_mfma_f32_16x16x32_bf16(Bt[n][k], At[m][k], acc[ai][bj][m][n], 0, 0, 0); __builtin_amdgcn_s_setprio(0); } while (0)
#define PG8_WAIT_V(n) asm volatile("s_waitcnt vmcnt(" #n ")" ::: "memory")
#define PG8_WAIT_L(n) asm volatile("s_waitcnt lgkmcnt(" #n ")" ::: "memory")
#define PG8_BAR __builtin_amdgcn_s_barrier()
#define PG8_SCHED __builtin_amdgcn_sched_barrier(0)
    Unit cur, nxt; int ui = 0;
    if (!S.next(0, cur)) return;
    f32x4 acc[2][2][4][2];
#pragma unroll
    for (int a = 0; a < 2; ++a)
#pragma unroll
        for (int b = 0; b < 2; ++b)
#pragma unroll
            for (int m = 0; m < 4; ++m)
#pragma unroll
                for (int n = 0; n < 2; ++n) acc[a][b][m][n] = (f32x4){0.f, 0.f, 0.f, 0.f};
    bf16x8 At[4][2], B0[2][2], B1[2][2];
    const char* cA = (const char*)g.A + (size_t)cur.pm * tstep; const char* cB = (const char*)g.Bt + (size_t)cur.pn * tstep;
    S.a_ready(cur);
    if constexpr (SP2) {
        PG8_STAGE(PG8_SB(0, 0), cB, voffB); PG8_STAGE(PG8_SB(0, 1), cB + hstep, voffB); PG8_STAGE(PG8_SA(0, 0), cA, voffA); PG8_STAGE(PG8_SA(0, 1), cA + hstep, voffA);
        if (wr == 1) PG8_BAR;
        PG8_WAIT_V(2); PG8_BAR;
        PG8_STAGE(PG8_SB(1, 0), cB + kstep, voffB); PG8_STAGE(PG8_SA(1, 0), cA + kstep, voffA); PG8_STAGE(PG8_SB(1, 1), cB + hstep + kstep, voffB);
        PG8_WAIT_V(6); PG8_BAR;
    } else {
        PG8_STAGE(PG8_SB(0, 0), cB, voffB); PG8_STAGE(PG8_SA(0, 0), cA, voffA); PG8_STAGE(PG8_SB(0, 1), cB + hstep, voffB); PG8_STAGE(PG8_SA(0, 1), cA + hstep, voffA);
        if (wr == 1) PG8_BAR;
        PG8_WAIT_V(4); PG8_BAR;
        PG8_STAGE(PG8_SB(1, 0), cB + kstep, voffB); PG8_STAGE(PG8_SA(1, 0), cA + kstep, voffA); PG8_STAGE(PG8_SB(1, 1), cB + hstep + kstep, voffB);
        PG8_WAIT_V(6); PG8_BAR;
    }
    for (;;) {
        const bool has_next = S.next(ui + 1, nxt);
        const char* nA = has_next ? (const char*)g.A + (size_t)nxt.pm * tstep : cA; const char* nB = has_next ? (const char*)g.Bt + (size_t)nxt.pn * tstep : cB;
        for (int t = 0; t < nt; t += 2) {
            if constexpr (Epi::HAS_MID) { if (t == (nt >> 1)) { PG8_SCHED; E.mid(acc, cur, wr, wc, fr, fq); PG8_SCHED; } }
            const bool last = (t == nt - 2);
            const char* a1 = cA + (size_t)(t + 1) * kstep;
            const char* a2 = last ? nA : cA + (size_t)(t + 2) * kstep; const char* b2 = last ? nB : cB + (size_t)(t + 2) * kstep;
            const char* a3 = a2 + kstep; const char* b3 = b2 + kstep;
            if (last && has_next) S.a_ready(nxt);
            if constexpr (SP2) {
            PG8_LDB(B0, 0, 0); PG8_LDB(B1, 0, 1); PG8_SCHED; PG8_LDA(At, 0, 0); PG8_STAGE(PG8_SA(1, 1), a1 + hstep, voffA);
            PG8_WAIT_V(8); PG8_WAIT_L(0); PG8_BAR; PG8_MMA(0, 0, At, B0); PG8_MMA(0, 1, At, B1); PG8_BAR; PG8_SCHED;
            PG8_LDA(At, 0, 1); PG8_STAGE(PG8_SB(0, 0), b2, voffB); PG8_STAGE(PG8_SB(0, 1), b2 + hstep, voffB); PG8_STAGE(PG8_SA(0, 0), a2, voffA);
            PG8_WAIT_V(8); PG8_WAIT_L(0); PG8_BAR; PG8_MMA(1, 0, At, B0); PG8_MMA(1, 1, At, B1); PG8_BAR; PG8_SCHED;
            PG8_LDB(B0, 1, 0); PG8_LDB(B1, 1, 1); PG8_SCHED; PG8_LDA(At, 1, 0); PG8_STAGE(PG8_SA(0, 1), a2 + hstep, voffA);
            PG8_WAIT_V(8); PG8_WAIT_L(0); PG8_BAR; PG8_MMA(0, 0, At, B0); PG8_MMA(0, 1, At, B1); PG8_BAR; PG8_SCHED;
            PG8_LDA(At, 1, 1); PG8_STAGE(PG8_SB(1, 0), b3, voffB); PG8_STAGE(PG8_SB(1, 1), b3 + hstep, voffB); PG8_STAGE(PG8_SA(1, 0), a3, voffA);
            PG8_WAIT_V(8); PG8_WAIT_L(0); PG8_BAR; PG8_MMA(1, 0, At, B0); PG8_MMA(1, 1, At, B1); PG8_BAR; PG8_SCHED;
            } else {
            PG8_LDB(B0, 0, 0); PG8_SCHED; PG8_LDA(At, 0, 0); PG8_STAGE(PG8_SA(1, 1), a1 + hstep, voffA);
            PG8_WAIT_L(8); PG8_BAR; PG8_WAIT_L(0); PG8_MMA(0, 0, At, B0); PG8_BAR; PG8_SCHED;
            PG8_LDB(B1, 0, 1); PG8_STAGE(PG8_SB(0, 0), b2, voffB);
            PG8_BAR; PG8_WAIT_L(0); PG8_MMA(0, 1, At, B1); PG8_BAR;
            PG8_LDA(At, 0, 1); PG8_STAGE(PG8_SA(0, 0), a2, voffA);
            PG8_BAR; PG8_WAIT_L(0); PG8_MMA(1, 0, At, B0); PG8_BAR; PG8_SCHED;
            PG8_STAGE(PG8_SB(0, 1), b2 + hstep, voffB);
            PG8_WAIT_V(6); PG8_BAR; PG8_MMA(1, 1, At, B1); PG8_BAR;
            PG8_LDB(B0, 1, 0); PG8_SCHED; PG8_LDA(At, 1, 0); PG8_STAGE(PG8_SA(0, 1), a2 + hstep, voffA);
            PG8_WAIT_L(8); PG8_BAR; PG8_WAIT_L(0); PG8_MMA(0, 0, At, B0); PG8_BAR; PG8_SCHED;
            PG8_LDB(B1, 1, 1); PG8_STAGE(PG8_SB(1, 0), b3, voffB);
            PG8_BAR; PG8_WAIT_L(0); PG8_MMA(0, 1, At, B1); PG8_BAR;
            PG8_LDA(At, 1, 1); PG8_STAGE(PG8_SA(1, 0), a3, voffA);
            PG8_BAR; PG8_WAIT_L(0); PG8_MMA(1, 0, At, B0); PG8_BAR; PG8_SCHED;
            PG8_STAGE(PG8_SB(1, 1), b3 + hstep, voffB);
            PG8_WAIT_V(6); PG8_BAR; PG8_MMA(1, 1, At, B1); PG8_BAR;
            }
        }
        if constexpr (ALIGN_EPI) { if (wr == 0) PG8_BAR; }
        if constexpr (!Epi::AFTER_DRAIN) { E(acc, cur, wr, wc, fr, fq); S.done(cur); }
        if (!has_next) break;
#pragma unroll
        for (int a = 0; a < 2; ++a)
#pragma unroll
            for (int b = 0; b < 2; ++b)
#pragma unroll
                for (int m = 0; m < 4; ++m)
#pragma unroll
                    for (int n = 0; n < 2; ++n) acc[a][b][m][n] = (f32x4){0.f, 0.f, 0.f, 0.f};
        cur = nxt; cA = nA; cB = nB; ++ui;
        if constexpr (ALIGN_EPI) { if (wr == 1) PG8_BAR; }
    }
    PG8_WAIT_V(0);
    if constexpr (!ALIGN_EPI) { if (wr == 0) PG8_BAR; }
    PG8_BAR;
    if constexpr (Epi::AFTER_DRAIN) { E.fused(acc, cur, wr, wc, fr, fq, lds, wid, lane); S.done(cur); }
#undef PG8_SA
#undef PG8_SB
#undef PG8_STAGE
#undef PG8_LDA
#undef PG8_LDB
#undef PG8_MMA
#undef PG8_WAIT_V
#undef PG8_WAIT_L
#undef PG8_BAR
#undef PG8_SCHED
}
}

#include <hip/hip_bf16.h>
#include <cmath>
namespace attn_body {
using bf16=__hip_bfloat16;
using bf16x8=__attribute__((ext_vector_type(8)))short;
using s16x4=__attribute__((ext_vector_type(4)))short;
using f32x16=__attribute__((ext_vector_type(16)))float;
using u32x4=__attribute__((ext_vector_type(4)))unsigned;
constexpr int BATCH=4,NHEAD=16,SEQ=8192,D=64,DM=NHEAD*D;
constexpr int NW=8,QBLK=32,QB=QBLK*NW,KVBLK=64,NQB=SEQ/QB;
constexpr int ATTN_PITCH=DM, ATTN_UNIT_ROWS=QB;
__device__ __forceinline__ int crow(int r,int hi){return (r&3)+8*(r>>2)+4*hi;}
#define SBAR() __builtin_amdgcn_sched_barrier(0)
typedef __attribute__((address_space(3))) const float* lds_fptr;
__device__ __forceinline__ void bmask(f32x16&p0,f32x16&p1,int jb,int qrel,int hi,lds_fptr tab){
  const float NEG=-INFINITY; const int nb=qrel-64*jb-4*hi;
  #pragma unroll
  for(int r=0;r<16;++r){ const int n0=nb-((r&3)+8*(r>>2)), n1=n0-32;
    const int i0=n0<0?0:(n0>127?127:n0), i1=n1<0?0:(n1>127?127:n1);
    const float t0=tab[256+i0], t1=tab[256+i1];
    p0[r]=n0<0?NEG:p0[r]+t0; p1[r]=n1<0?NEG:p1[r]+t1; }
}
constexpr int NSLOT=3, SLOTB=8192;
constexpr int LDS_K=0, LDS_V=NSLOT*SLOTB, LDS_WS=2*NSLOT*SLOTB, LDS_OST=LDS_WS+NW*64*4, LDS_BYTES=LDS_OST+NW*4096;
constexpr float C2=0.125f*1.4426950408889634f;
__device__ __forceinline__ void glds16(const void*gsrc,unsigned lds_dst){unsigned keep;
  asm volatile("s_mov_b32 %0, m0\n\ts_mov_b32 m0, %2\n\ts_nop 0\n\tglobal_load_lds_dwordx4 %1, off\n\ts_mov_b32 m0, %0":"=&s"(keep):"v"(gsrc),"s"(lds_dst):"memory");}
__device__ __forceinline__ float max3f(float a,float b,float c){float r;asm("v_max3_f32 %0, %1, %2, %3":"=v"(r):"v"(a),"v"(b),"v"(c));return r;}
__device__ __forceinline__ float max2f(float a,float b){float r;asm("v_max_f32_e32 %0, %1, %2":"=v"(r):"v"(a),"v"(b));return r;}
__device__ __forceinline__ float fadd_s(float a,float b){float r;asm("v_add_f32_e32 %0, %1, %2":"=v"(r):"v"(a),"v"(b));return r;}
__device__ __forceinline__ float fsub_s(float a,float b){float r;asm("v_sub_f32_e32 %0, %1, %2":"=v"(r):"v"(a),"v"(b));return r;}
typedef float f32x2_t __attribute__((ext_vector_type(2))); typedef __bf16 bf16x2_t __attribute__((ext_vector_type(2)));
__device__ __forceinline__ unsigned cvtpk_s(float lo,float hi){f32x2_t v={lo,hi};bf16x2_t b=__builtin_convertvector(v,bf16x2_t);return __builtin_bit_cast(unsigned,b);}
#define WAIT_BAR(N) asm volatile("s_waitcnt vmcnt(" #N ") lgkmcnt(0)\n\ts_barrier":::"memory")

__device__ __forceinline__ void qkt(f32x16&p0,f32x16&p1,const char*Kslot,const bf16x8*qr,const f32x16&negm,int r32,int hi){
  const char*kb=Kslot+hi*1024+r32*16;
  #pragma unroll
  for(int d0=0;d0<4;++d0){
    const bf16x8 b0=*reinterpret_cast<const bf16x8*>(kb+d0*2048);
    const bf16x8 b1=*reinterpret_cast<const bf16x8*>(kb+d0*2048+512);
    if(d0==0){p0=__builtin_amdgcn_mfma_f32_32x32x16_bf16(b0,qr[0],negm,0,0,0);p1=__builtin_amdgcn_mfma_f32_32x32x16_bf16(b1,qr[0],negm,0,0,0);}
    else{p0=__builtin_amdgcn_mfma_f32_32x32x16_bf16(b0,qr[d0],p0,0,0,0);p1=__builtin_amdgcn_mfma_f32_32x32x16_bf16(b1,qr[d0],p1,0,0,0);}}
}
typedef __attribute__((address_space(3))) const char* lds_cptr;
typedef short v4i16_t __attribute__((ext_vector_type(4)));
__device__ __forceinline__ void kload8(bf16x8*kf,lds_cptr kp){
  kf[0]=*(const __attribute__((address_space(3))) bf16x8*)(kp);      kf[1]=*(const __attribute__((address_space(3))) bf16x8*)(kp+512);
  kf[2]=*(const __attribute__((address_space(3))) bf16x8*)(kp+2048); kf[3]=*(const __attribute__((address_space(3))) bf16x8*)(kp+2560);
  kf[4]=*(const __attribute__((address_space(3))) bf16x8*)(kp+4096); kf[5]=*(const __attribute__((address_space(3))) bf16x8*)(kp+4608);
  kf[6]=*(const __attribute__((address_space(3))) bf16x8*)(kp+6144); kf[7]=*(const __attribute__((address_space(3))) bf16x8*)(kp+6656);
}
__device__ __forceinline__ void kload2(bf16x8*kf,lds_cptr kp,int j){ kf[2*j]=*(const __attribute__((address_space(3))) bf16x8*)(kp+j*2048); kf[2*j+1]=*(const __attribute__((address_space(3))) bf16x8*)(kp+j*2048+512); }
__device__ __forceinline__ s16x4 vtr(lds_cptr p){ return __builtin_bit_cast(s16x4,__builtin_amdgcn_ds_read_tr16_b64_v4i16((__attribute__((address_space(3))) v4i16_t*)p)); }
__device__ __forceinline__ float rowmax(const f32x16&p0,const f32x16&p1){
  float a=max3f(p0[0],p0[1],p1[0]),b=max3f(p0[2],p0[3],p1[1]);a=max3f(a,p1[2],p1[3]);
  #pragma unroll
  for(int r=4;r<16;r+=4){a=max3f(a,p0[r],p0[r+1]);b=max3f(b,p0[r+2],p0[r+3]);a=max3f(a,p1[r],p1[r+1]);b=max3f(b,p1[r+2],p1[r+3]);}
  const float m=max2f(a,b);
  auto rr=__builtin_amdgcn_permlane32_swap(__float_as_uint(m),__float_as_uint(m),false,false);
  return max2f(__uint_as_float(rr[0]),__uint_as_float(rr[1]));
}
__device__ __forceinline__ void pv(f32x16*o,int vb,bf16x8 pa0,bf16x8 pa1,bf16x8 pa2,bf16x8 pa3){
  #pragma unroll
  for(int d0=0;d0<2;++d0){s16x4 lo[4],hi[4];
    #pragma unroll
    for(int ks=0;ks<4;++ks){
      asm volatile("ds_read_b64_tr_b16 %0,%1 offset:%c2":"=&v"(lo[ks]):"v"(vb),"i"(d0*4096+ks*1024):"memory");
      asm volatile("ds_read_b64_tr_b16 %0,%1 offset:%c2":"=&v"(hi[ks]):"v"(vb),"i"(d0*4096+ks*1024+512):"memory");}
    asm volatile("s_waitcnt lgkmcnt(0)":::"memory");SBAR();
    #define PK(k) (bf16x8){lo[k][0],lo[k][1],lo[k][2],lo[k][3],hi[k][0],hi[k][1],hi[k][2],hi[k][3]}
    o[d0]=__builtin_amdgcn_mfma_f32_32x32x16_bf16(pa0,PK(0),o[d0],0,0,0);
    o[d0]=__builtin_amdgcn_mfma_f32_32x32x16_bf16(pa1,PK(1),o[d0],0,0,0);
    o[d0]=__builtin_amdgcn_mfma_f32_32x32x16_bf16(pa2,PK(2),o[d0],0,0,0);
    o[d0]=__builtin_amdgcn_mfma_f32_32x32x16_bf16(pa3,PK(3),o[d0],0,0,0);
    #undef PK
  }
}

#ifndef ATTN_STORE16
#define ATTN_STORE16(p,v) (*(u32x4*)(p)=(v))
#endif
template<int THRL> __device__ __forceinline__ void attn_unit(int b,int hq,int hv,int qb,const bf16*Q,const bf16*__restrict__ K,const bf16*__restrict__ V,bf16*O,char*shm,lds_fptr tab,int wid_in){
  int lane; asm volatile("v_mbcnt_lo_u32_b32 %0, -1, 0\n\tv_mbcnt_hi_u32_b32 %0, -1, %0" : "=v"(lane)); const int r32=lane&31,hi=lane>>5; const int wid=wid_in;
  const long rowbase=(long)b*SEQ; const int q0=qb*QB;
  const bf16*Qw=Q+(rowbase+q0+wid*QBLK)*DM+hq*D;
  const bf16*Kh=K+rowbase*DM+hq*D,*Vh=V+rowbase*DM+hv*D;
  const unsigned lds0=(unsigned)(uintptr_t)shm;
  float*wsf=(float*)(shm+LDS_WS)+wid*64;
  const bf16*ksrc=Kh+(long)lane*DM+wid*8;
  const bf16*vsrc=Vh+(long)(16*(wid&3)+(lane>>2))*DM+(wid>>2)*32+(lane&3)*8;
  const unsigned kdst=lds0+LDS_K+wid*1024, vdst=lds0+LDS_V+wid*1024;
  #define DMA_K(t,slot) glds16(ksrc+(long)(t)*KVBLK*DM,(unsigned)__builtin_amdgcn_readfirstlane(kdst+(slot)))
  #define DMA_V(t,slot) glds16(vsrc+(long)(t)*KVBLK*DM,(unsigned)__builtin_amdgcn_readfirstlane(vdst+(slot)))
  const int vb0=(int)(lds0+LDS_V)+((lane>>4)&1)*32+(lane&3)*8+(4*hi+((lane&15)>>2))*64;
  const char*Kbase=shm+LDS_K; bf16x8 kf[8];
  const lds_cptr shm3=(lds_cptr)shm; const lds_cptr kp0=shm3+LDS_K+hi*1024+r32*16; const lds_cptr vp0=shm3+LDS_V+((lane>>4)&1)*32+(lane&3)*8+(4*hi+((lane&15)>>2))*64;
  const int NT=(q0+QB)/KVBLK;
  DMA_K(0,0);DMA_V(0,0);DMA_K(1,SLOTB);
  bf16x8 qr[4];
  #pragma unroll
  for(int d0=0;d0<4;++d0)qr[d0]=*reinterpret_cast<const bf16x8*>(&Qw[(long)r32*DM+d0*16+hi*8]);
  float mhat=0.f,l_reg=0.f;f32x16 o[2],negm; { float z_; asm volatile("v_mov_b32 %0, 0":"=v"(z_)); _Pragma("unroll") for(int r=0;r<16;++r){o[0][r]=z_;o[1][r]=z_;negm[r]=z_;} } asm volatile("":"+v"(negm));
  const int qrel=wid*QBLK+r32;
  #define CMASK(P0,P1,t) do{int jb_=(t)-(NT-4); if(jb_>=-2)bmask(P0,P1,jb_,qrel,hi,tab);}while(0)
  bool resc=false;
  #define START(P0,P1) do{ const float rm=rowmax(P0,P1); resc=false; \
    { const float dl=rm; mhat=fadd_s(mhat,dl); \
      _Pragma("unroll") for(int r=0;r<16;++r){P0[r]=fsub_s(P0[r],dl);P1[r]=fsub_s(P1[r],dl);} \
      _Pragma("unroll") for(int r=0;r<16;++r)negm[r]=-mhat; asm volatile("":"+v"(negm)); } \
    _Pragma("unroll") for(int r=0;r<16;++r)P0[r]=__builtin_amdgcn_exp2f(P0[r]); }while(0)
  #define RESC() do{ if(resc){ asm volatile("s_waitcnt lgkmcnt(0)":::"memory"); \
      _Pragma("unroll") for(int d_=0;d_<2;++d_) _Pragma("unroll") for(int r=0;r<16;++r)o[d_][r]*=wsf[crow(r,hi)]; } }while(0)
  f32x16 pA0,pA1,pB0,pB1;
  int sl_prev=0,sl_cur=0,sl_next=SLOTB;
  #define ROT() do{sl_prev=sl_cur;sl_cur=sl_next;sl_next=(sl_next==(NSLOT-1)*SLOTB)?0:sl_next+SLOTB;}while(0)
  DMA_K(2,2*SLOTB);
  WAIT_BAR(3);
  qkt(pA0,pA1,Kbase,qr,negm,r32,hi);asm volatile("s_nop 15\n\ts_nop 7":"+v"(pA0),"+v"(pA1));CMASK(pA0,pA1,0);
  START(pA0,pA1);
  _Pragma("unroll") for(int r=0;r<16;++r)pA1[r]=__builtin_amdgcn_exp2f(pA1[r]);
  WAIT_BAR(0);
  DMA_K(3,0);DMA_V(1,SLOTB);
  ROT();
  kload8(kf,kp0+sl_cur);
  WAIT_BAR(2);
  s16x4 vlo[8],vhi[8]; u32x4 pw0,pw1,pw2,pw3;
  #define PKW(P,B) cvtpk_s(P[B],P[B+1])
  #define PAF(k) __builtin_bit_cast(bf16x8,pw##k)
  #define VFR(i) (bf16x8){vlo[i][0],vlo[i][1],vlo[i][2],vlo[i][3],vhi[i][0],vhi[i][1],vhi[i][2],vhi[i][3]}
  #define PIN(x) asm volatile("":"+v"(x))
  #define MX3(a,b,c) __builtin_fmaxf(__builtin_fmaxf((a),(b)),(c))
  #define GAPA(MF,A0,A1,A2,A3,W0,W1,PW) do{ MF; sacc+=A0; sacc+=A1; sacc+=A2; sacc+=A3; PIN(sacc); W0; W1; PIN(PW); SBAR(); }while(0)
  #define EX(v) __builtin_amdgcn_exp2f(v)
  #define GAPB(MF,X,B) do{ MF; X[B]=EX(X[B]); X[B+1]=EX(X[B+1]); X[B+2]=EX(X[B+2]); X[B+3]=EX(X[B+3]); PIN(X); SBAR(); }while(0)
  #define VRD(i) do{ vlo[i]=vtr(vp_+(((i)>>2)*4096+((i)&3)*1024)); vhi[i]=vtr(vp_+(((i)>>2)*4096+((i)&3)*1024+512)); }while(0)
  #define KRD(G,j) do{ if(G){ kload2(kf,kp0+sl_next,j); SBAR(); } }while(0)
  #define STEP(C0,C1,P0,P1,t,GK,GV,GL) do{ SBAR(); \
    const lds_cptr vp_=vp0+sl_prev; \
    VRD(0); SBAR(); float sacc=(P0[0]+P0[1]); \
    GAPA(C0=__builtin_amdgcn_mfma_f32_32x32x16_bf16(kf[0],qr[0],negm,0,0,0), P0[2],P0[3],P0[4],P0[5],     pw0[0]=PKW(P0,0), pw0[1]=PKW(P0,2), pw0); \
    VRD(4); SBAR(); GAPA(C1=__builtin_amdgcn_mfma_f32_32x32x16_bf16(kf[1],qr[0],negm,0,0,0), P0[6],P0[7],P0[8],P0[9],     pw0[2]=PKW(P0,4), pw0[3]=PKW(P0,6), pw0); \
    VRD(1); SBAR(); GAPA(C0=__builtin_amdgcn_mfma_f32_32x32x16_bf16(kf[2],qr[1],C0,0,0,0),   P0[10],P0[11],P0[12],P0[13], pw1[0]=PKW(P0,8), pw1[1]=PKW(P0,10), pw1); \
    VRD(5); SBAR(); GAPA(C1=__builtin_amdgcn_mfma_f32_32x32x16_bf16(kf[3],qr[1],C1,0,0,0),   P0[14],P0[15],P1[0],P1[1],   pw1[2]=PKW(P0,12),pw1[3]=PKW(P0,14), pw1); \
    VRD(2); SBAR(); GAPA(C0=__builtin_amdgcn_mfma_f32_32x32x16_bf16(kf[4],qr[2],C0,0,0,0),   P1[2],P1[3],P1[4],P1[5],     pw2[0]=PKW(P1,0), pw2[1]=PKW(P1,2), pw2); \
    VRD(6); SBAR(); GAPA(C1=__builtin_amdgcn_mfma_f32_32x32x16_bf16(kf[5],qr[2],C1,0,0,0),   P1[6],P1[7],P1[8],P1[9],     pw2[2]=PKW(P1,4), pw2[3]=PKW(P1,6), pw2); \
    VRD(3); SBAR(); GAPA(C0=__builtin_amdgcn_mfma_f32_32x32x16_bf16(kf[6],qr[3],C0,0,0,0),   P1[10],P1[11],P1[12],P1[13], pw3[0]=PKW(P1,8), pw3[1]=PKW(P1,10), pw3); \
    VRD(7); SBAR(); GAPA(C1=__builtin_amdgcn_mfma_f32_32x32x16_bf16(kf[7],qr[3],C1,0,0,0),   P1[14],P1[15],0.f,0.f,       pw3[2]=PKW(P1,12),pw3[3]=PKW(P1,14), pw3); \
    l_reg+=sacc; \
    if(GK){DMA_K((t)+3,sl_cur);} if(GV){DMA_V((t)+1,sl_next);} \
    CMASK(C0,C1,t); \
    { float a=MX3(C0[0],C0[1],C1[0]),b=MX3(C0[2],C0[3],C1[1]); a=MX3(a,C1[2],C1[3]); \
      _Pragma("unroll") for(int r=4;r<16;r+=4){a=MX3(a,C0[r],C0[r+1]);b=MX3(b,C0[r+2],C0[r+3]);a=MX3(a,C1[r],C1[r+1]);b=MX3(b,C1[r+2],C1[r+3]);} \
      float rm=__builtin_fmaxf(a,b); { auto rr=__builtin_amdgcn_permlane32_swap(__float_as_uint(rm),__float_as_uint(rm),false,false); rm=__builtin_fmaxf(__uint_as_float(rr[0]),__uint_as_float(rr[1])); } \
      resc=false; \
      if(__builtin_expect(__any(rm>(float)THRL),0)){ const float dl=__builtin_fmaxf(rm,0.f); mhat+=dl; \
        _Pragma("unroll") for(int r=0;r<16;++r){C0[r]-=dl;C1[r]-=dl;} \
        _Pragma("unroll") for(int r=0;r<16;++r)negm[r]=-mhat; asm volatile("":"+v"(negm)); \
        const float f=__builtin_amdgcn_exp2f(-dl); l_reg*=f; if(hi==0)wsf[r32]=f; resc=true; } } \
    SBAR(); \
    GAPB(o[0]=__builtin_amdgcn_mfma_f32_32x32x16_bf16(PAF(0),VFR(0),o[0],0,0,0), C0,0); \
    GAPB(o[1]=__builtin_amdgcn_mfma_f32_32x32x16_bf16(PAF(0),VFR(4),o[1],0,0,0), C0,4); \
    KRD(GL,0); GAPB(o[0]=__builtin_amdgcn_mfma_f32_32x32x16_bf16(PAF(1),VFR(1),o[0],0,0,0), C0,8); \
    KRD(GL,1); GAPB(o[1]=__builtin_amdgcn_mfma_f32_32x32x16_bf16(PAF(1),VFR(5),o[1],0,0,0), C0,12); \
    KRD(GL,2); GAPB(o[0]=__builtin_amdgcn_mfma_f32_32x32x16_bf16(PAF(2),VFR(2),o[0],0,0,0), C1,0); \
    KRD(GL,3); GAPB(o[1]=__builtin_amdgcn_mfma_f32_32x32x16_bf16(PAF(2),VFR(6),o[1],0,0,0), C1,4); \
    GAPB(o[0]=__builtin_amdgcn_mfma_f32_32x32x16_bf16(PAF(3),VFR(3),o[0],0,0,0), C1,8); \
    GAPB(o[1]=__builtin_amdgcn_mfma_f32_32x32x16_bf16(PAF(3),VFR(7),o[1],0,0,0), C1,12); \
    }while(0)
  int t=1;
  #undef CMASK
  #define CMASK(P0,P1,t) do{}while(0)
  for(;t+7<NT;t+=2){
    STEP(pB0,pB1,pA0,pA1,t,true,true,true);     WAIT_BAR(2); RESC(); ROT();
    STEP(pA0,pA1,pB0,pB1,t+1,true,true,true);   WAIT_BAR(2); RESC(); ROT();
  }
  #undef CMASK
  #define CMASK(P0,P1,t) do{int jb_=(t)-(NT-4); if(jb_>=-2)bmask(P0,P1,jb_,qrel,hi,tab);}while(0)
  #define ENDW(tt) do{ if((tt)+3<NT){WAIT_BAR(2);} else if((tt)+2<NT){WAIT_BAR(1);} else {WAIT_BAR(0);} }while(0)
  for(;t+1<NT;t+=2){
    STEP(pB0,pB1,pA0,pA1,t,(t+3<NT),(t+1<NT),(t+1<NT));       ENDW(t);   RESC(); ROT();
    STEP(pA0,pA1,pB0,pB1,t+1,(t+4<NT),(t+2<NT),(t+2<NT));     ENDW(t+1); RESC(); ROT();
  }
  STEP(pB0,pB1,pA0,pA1,NT-1,false,false,false); RESC();
  { float sacc=pB0[0]+pB0[1]; _Pragma("unroll") for(int r=2;r<16;++r)sacc+=pB0[r]; _Pragma("unroll") for(int r=0;r<16;++r)sacc+=pB1[r]; l_reg+=sacc;
    pw0=(u32x4){PKW(pB0,0),PKW(pB0,2),PKW(pB0,4),PKW(pB0,6)};pw1=(u32x4){PKW(pB0,8),PKW(pB0,10),PKW(pB0,12),PKW(pB0,14)};pw2=(u32x4){PKW(pB1,0),PKW(pB1,2),PKW(pB1,4),PKW(pB1,6)};pw3=(u32x4){PKW(pB1,8),PKW(pB1,10),PKW(pB1,12),PKW(pB1,14)};
    SBAR(); pv(o,vb0+sl_cur,PAF(0),PAF(1),PAF(2),PAF(3)); }
  #undef PKW
  #undef PAF
  #undef VFR
  #undef PIN
  #undef MX3
  #undef GAPA
  #undef GAPB
  #undef EX
  #undef VRD
  #undef KRD
  #undef STEP
  #undef ENDW
  {auto rr=__builtin_amdgcn_permlane32_swap(__float_as_uint(l_reg),__float_as_uint(l_reg),false,false);l_reg=__uint_as_float(rr[0])+__uint_as_float(rr[1]);}
  if(hi==0)wsf[32+r32]=l_reg;asm volatile("s_waitcnt lgkmcnt(0)":::"memory");
  float rli[16];
  #pragma unroll
  for(int r=0;r<16;++r)rli[r]=__builtin_amdgcn_rcpf(wsf[32+crow(r,hi)]);
  bf16*Ow=O+(rowbase+q0+wid*QBLK)*DM+hv*D;
  { bf16*stg=(bf16*)(shm+LDS_OST)+wid*2048;
    #pragma unroll
    for(int r=0;r<16;++r){const int orow=crow(r,hi);
      #pragma unroll
      for(int d0=0;d0<2;++d0)stg[orow*64+d0*32+r32]=__float2bfloat16(o[d0][r]*rli[r]);}
    asm volatile("s_waitcnt lgkmcnt(0)":::"memory");
    #pragma unroll
    for(int i=0;i<4;++i){const int row=i*8+(lane>>3),ch=lane&7; const u32x4 v=*(const u32x4*)(stg+row*64+ch*8); ATTN_STORE16(Ow+(long)row*DM+ch*8,v);} }
  asm volatile("s_waitcnt lgkmcnt(0)\n\ts_barrier":::"memory");
  #undef DMA_K
  #undef DMA_V
  #undef CMASK
  #undef START
  #undef RESC
  #undef ROT
}
constexpr int ATTN_LDS_BYTES=LDS_BYTES;
#undef SBAR
#undef WAIT_BAR
}


namespace attn_body {
#define SBAR() __builtin_amdgcn_sched_barrier(0)
#define WAIT_BAR(N) asm volatile("s_waitcnt vmcnt(" #N ") lgkmcnt(0)\n\ts_barrier":::"memory")
constexpr int SLOTK=8192, SLOTV=16384, L2_K=0, L2_V=NSLOT*SLOTK, L2_WS=L2_V+NSLOT*SLOTV, L2_OST=L2_WS+NW*64*4, L2_FLAG=L2_OST+NW*4096, L2_BYTES=L2_FLAG+64;
__device__ __forceinline__ void pv4(f32x16*o,int vb,bf16x8 pa0,bf16x8 pa1,bf16x8 pa2,bf16x8 pa3){
  #pragma unroll
  for(int d0=0;d0<4;++d0){s16x4 lo[4],hi[4];
    #pragma unroll
    for(int ks=0;ks<4;++ks){
      asm volatile("ds_read_b64_tr_b16 %0,%1 offset:%c2":"=&v"(lo[ks]):"v"(vb),"i"(d0*4096+ks*1024):"memory");
      asm volatile("ds_read_b64_tr_b16 %0,%1 offset:%c2":"=&v"(hi[ks]):"v"(vb),"i"(d0*4096+ks*1024+512):"memory");}
    asm volatile("s_waitcnt lgkmcnt(0)":::"memory");SBAR();
    #define PK(k) (bf16x8){lo[k][0],lo[k][1],lo[k][2],lo[k][3],hi[k][0],hi[k][1],hi[k][2],hi[k][3]}
    o[d0]=__builtin_amdgcn_mfma_f32_32x32x16_bf16(pa0,PK(0),o[d0],0,0,0);
    o[d0]=__builtin_amdgcn_mfma_f32_32x32x16_bf16(pa1,PK(1),o[d0],0,0,0);
    o[d0]=__builtin_amdgcn_mfma_f32_32x32x16_bf16(pa2,PK(2),o[d0],0,0,0);
    o[d0]=__builtin_amdgcn_mfma_f32_32x32x16_bf16(pa3,PK(3),o[d0],0,0,0);
    #undef PK
  }
}
#define ZERO16 (f32x16){0.f,0.f,0.f,0.f,0.f,0.f,0.f,0.f,0.f,0.f,0.f,0.f,0.f,0.f,0.f,0.f}
#define MFMA32(a,b,c) __builtin_amdgcn_mfma_f32_32x32x16_bf16(a,b,c,0,0,0)
template<int THRL,bool FAST,bool COMB> __device__ __forceinline__ bool attn_unit2(int b,int hq,int hvb,int qb,const bf16*Q,const bf16*__restrict__ K,const bf16*__restrict__ V,bf16*O,char*shm,lds_fptr tab,int wid_in,bf16*YG,const float*subw,float lam){
  int lane; asm volatile("v_mbcnt_lo_u32_b32 %0, -1, 0\n\tv_mbcnt_hi_u32_b32 %0, -1, %0" : "=v"(lane)); const int r32=lane&31,hi=lane>>5; const int wid=wid_in;
  const long rowbase=(long)b*SEQ; const int q0=qb*QB;
  const bf16*Qw=Q+(rowbase+q0+wid*QBLK)*DM+hq*D;
  const bf16*Kh=K+rowbase*DM+hq*D,*Vh=V+rowbase*DM+hvb*D;
  const unsigned lds0=(unsigned)(uintptr_t)shm;
  float*wsf=(float*)(shm+L2_WS)+wid*64;
  const bf16*ksrc=Kh+(long)lane*DM+wid*8;
  const bf16*vsrc=Vh+(long)(16*(wid&3)+(lane>>2))*DM+(wid>>2)*32+(lane&3)*8;
  const unsigned kdst=lds0+L2_K+wid*1024, vdst=lds0+L2_V+wid*1024;
  #define DMA_K(t,slot) glds16(ksrc+(long)(t)*KVBLK*DM,(unsigned)__builtin_amdgcn_readfirstlane(kdst+(slot)))
  #define DMA_V(t,slot) do{ glds16(vsrc+(long)(t)*KVBLK*DM,(unsigned)__builtin_amdgcn_readfirstlane(vdst+2*(slot))); glds16(vsrc+(long)(t)*KVBLK*DM+64,(unsigned)__builtin_amdgcn_readfirstlane(vdst+2*(slot)+8192)); }while(0)
  const int vb0=(int)(lds0+L2_V)+((lane>>4)&1)*32+(lane&3)*8+(4*hi+((lane&15)>>2))*64;
  const char*Kbase=shm+L2_K; bf16x8 kf[8];
  const lds_cptr shm3=(lds_cptr)shm; const lds_cptr kp0=shm3+L2_K+hi*1024+r32*16; const lds_cptr vp0=shm3+L2_V+((lane>>4)&1)*32+(lane&3)*8+(4*hi+((lane&15)>>2))*64;
  const int NT=(q0+QB)/KVBLK;
  DMA_K(0,0);DMA_V(0,0);DMA_K(1,SLOTK);
  bf16x8 qr[4];
  #pragma unroll
  for(int d0=0;d0<4;++d0)qr[d0]=*reinterpret_cast<const bf16x8*>(&Qw[(long)r32*DM+d0*16+hi*8]);
  float mh=0.f,l_reg=0.f,ovf=0.f; bool bad=false; f32x16 o[4]; { float z_; asm volatile("v_mov_b32 %0, 0":"=v"(z_)); _Pragma("unroll") for(int r=0;r<16;++r){o[0][r]=z_;o[1][r]=z_;o[2][r]=z_;o[3][r]=z_;} }
  const int qrel=wid*QBLK+r32;
  #define CMASK(P0,P1,t) do{int jb_=(t)-(NT-4); if(jb_>=-2)bmask(P0,P1,jb_,qrel,hi,tab);}while(0)
  bool resc=false;
  #define RESC() do{ if(!FAST&&resc){ asm volatile("s_waitcnt lgkmcnt(0)":::"memory"); \
      _Pragma("unroll") for(int d_=0;d_<4;++d_) _Pragma("unroll") for(int r=0;r<16;++r)o[d_][r]*=wsf[crow(r,hi)]; } }while(0)
  f32x16 pA0,pA1,pB0,pB1;
  int sl_prev=0,sl_cur=0,sl_next=SLOTK;
  #define ROT() do{sl_prev=sl_cur;sl_cur=sl_next;sl_next=(sl_next==(NSLOT-1)*SLOTK)?0:sl_next+SLOTK;}while(0)
  DMA_K(2,2*SLOTK);
  WAIT_BAR(4);
  { const char*kb=Kbase+hi*1024+r32*16;
    #pragma unroll
    for(int d0=0;d0<4;++d0){ const bf16x8 b0=*reinterpret_cast<const bf16x8*>(kb+d0*2048); const bf16x8 b1=*reinterpret_cast<const bf16x8*>(kb+d0*2048+512);
      if(d0==0){pA0=MFMA32(b0,qr[0],ZERO16);pA1=MFMA32(b1,qr[0],ZERO16);} else{pA0=MFMA32(b0,qr[d0],pA0);pA1=MFMA32(b1,qr[d0],pA1);} } }
  CMASK(pA0,pA1,0);
  { float a=__builtin_fmaxf(__builtin_fmaxf(pA0[0],pA0[1]),pA1[0]),b_=__builtin_fmaxf(__builtin_fmaxf(pA0[2],pA0[3]),pA1[1]); a=__builtin_fmaxf(__builtin_fmaxf(a,pA1[2]),pA1[3]);
    _Pragma("unroll") for(int r=4;r<16;r+=4){a=__builtin_fmaxf(__builtin_fmaxf(a,pA0[r]),pA0[r+1]);b_=__builtin_fmaxf(__builtin_fmaxf(b_,pA0[r+2]),pA0[r+3]);a=__builtin_fmaxf(__builtin_fmaxf(a,pA1[r]),pA1[r+1]);b_=__builtin_fmaxf(__builtin_fmaxf(b_,pA1[r+2]),pA1[r+3]);}
    float rm=__builtin_fmaxf(a,b_); { auto rr=__builtin_amdgcn_permlane32_swap(__float_as_uint(rm),__float_as_uint(rm),false,false); rm=__builtin_fmaxf(__uint_as_float(rr[0]),__uint_as_float(rr[1])); }
    if(FAST){ bad=__any(!(rm>-48.f&&rm<48.f))!=0; } else mh=rm;
    _Pragma("unroll") for(int r=0;r<16;++r){pA0[r]=FAST?__builtin_amdgcn_exp2f(pA0[r]):__builtin_amdgcn_exp2f(pA0[r]-mh);pA1[r]=FAST?__builtin_amdgcn_exp2f(pA1[r]):__builtin_amdgcn_exp2f(pA1[r]-mh);} }
  WAIT_BAR(0);
  DMA_K(3,0);DMA_V(1,SLOTK);
  ROT();
  kload8(kf,kp0+sl_cur);
  WAIT_BAR(3);
  s16x4 vlo[8],vhi[8]; u32x4 pw0,pw1,pw2,pw3;
  #define PKW(P,B) cvtpk_s(P[B],P[B+1])
  #define PAF(k) __builtin_bit_cast(bf16x8,pw##k)
  #define VFR(i) (bf16x8){vlo[i][0],vlo[i][1],vlo[i][2],vlo[i][3],vhi[i][0],vhi[i][1],vhi[i][2],vhi[i][3]}
  #define PIN(x) asm volatile("":"+v"(x))
  #define MX3(a,b,c) __builtin_fmaxf(__builtin_fmaxf((a),(b)),(c))
  #define GAPA(MF,A0,A1,A2,A3,W0,W1,PW) do{ MF; sacc+=A0; sacc+=A1; sacc+=A2; sacc+=A3; PIN(sacc); W0; W1; PIN(PW); SBAR(); }while(0)
  #define EX(v) (FAST?__builtin_amdgcn_exp2f(v):__builtin_amdgcn_exp2f((v)-mh))
  #define GAPB(MF,X,B) do{ MF; X[B]=EX(X[B]); X[B+1]=EX(X[B+1]); PIN(X); SBAR(); }while(0)
  #define VRDX(i,j) do{ vlo[i]=vtr(vp_+(((j)>>2)*4096+((j)&3)*1024)); vhi[i]=vtr(vp_+(((j)>>2)*4096+((j)&3)*1024+512)); }while(0)
  #define KRD(G,j) do{ if(G){ kload2(kf,kp0+sl_next,j); SBAR(); } }while(0)
  #define STEP(C0,C1,P0,P1,t,GK,GV,GL) do{ SBAR(); \
    const lds_cptr vp_=vp0+2*sl_prev; \
    VRDX(0,0); SBAR(); float sacc=(P0[0]+P0[1]); \
    GAPA(C0=MFMA32(kf[0],qr[0],ZERO16), P0[2],P0[3],P0[4],P0[5],     pw0[0]=PKW(P0,0), pw0[1]=PKW(P0,2), pw0); \
    VRDX(4,4); SBAR(); GAPA(C1=MFMA32(kf[1],qr[0],ZERO16), P0[6],P0[7],P0[8],P0[9],     pw0[2]=PKW(P0,4), pw0[3]=PKW(P0,6), pw0); \
    VRDX(1,1); SBAR(); GAPA(C0=MFMA32(kf[2],qr[1],C0),   P0[10],P0[11],P0[12],P0[13], pw1[0]=PKW(P0,8), pw1[1]=PKW(P0,10), pw1); \
    VRDX(5,5); SBAR(); GAPA(C1=MFMA32(kf[3],qr[1],C1),   P0[14],P0[15],P1[0],P1[1],   pw1[2]=PKW(P0,12),pw1[3]=PKW(P0,14), pw1); \
    VRDX(2,2); SBAR(); GAPA(C0=MFMA32(kf[4],qr[2],C0),   P1[2],P1[3],P1[4],P1[5],     pw2[0]=PKW(P1,0), pw2[1]=PKW(P1,2), pw2); \
    VRDX(6,6); SBAR(); GAPA(C1=MFMA32(kf[5],qr[2],C1),   P1[6],P1[7],P1[8],P1[9],     pw2[2]=PKW(P1,4), pw2[3]=PKW(P1,6), pw2); \
    VRDX(3,3); SBAR(); GAPA(C0=MFMA32(kf[6],qr[3],C0),   P1[10],P1[11],P1[12],P1[13], pw3[0]=PKW(P1,8), pw3[1]=PKW(P1,10), pw3); \
    VRDX(7,7); SBAR(); GAPA(C1=MFMA32(kf[7],qr[3],C1),   P1[14],P1[15],0.f,0.f,       pw3[2]=PKW(P1,12),pw3[3]=PKW(P1,14), pw3); \
    l_reg+=sacc; if(FAST)ovf=__builtin_fmaxf(ovf,sacc); \
    if(GK){DMA_K((t)+3,sl_cur);} if(GV){DMA_V((t)+1,sl_next);} \
    CMASK(C0,C1,t); \
    if(!FAST){ float a=MX3(C0[0],C0[1],C1[0]),b_=MX3(C0[2],C0[3],C1[1]); a=MX3(a,C1[2],C1[3]); \
      _Pragma("unroll") for(int r=4;r<16;r+=4){a=MX3(a,C0[r],C0[r+1]);b_=MX3(b_,C0[r+2],C0[r+3]);a=MX3(a,C1[r],C1[r+1]);b_=MX3(b_,C1[r+2],C1[r+3]);} \
      float rm=__builtin_fmaxf(a,b_); { auto rr=__builtin_amdgcn_permlane32_swap(__float_as_uint(rm),__float_as_uint(rm),false,false); rm=__builtin_fmaxf(__uint_as_float(rr[0]),__uint_as_float(rr[1])); } \
      resc=false; \
      if(__builtin_expect(__any(rm-mh>(float)THRL),0)){ const float dl=__builtin_fmaxf(rm-mh,0.f); mh+=dl; \
        const float f=__builtin_amdgcn_exp2f(-dl); l_reg*=f; if(hi==0)wsf[r32]=f; resc=true; } } \
    SBAR(); \
    GAPB(o[0]=MFMA32(PAF(0),VFR(0),o[0]), C0,0);  VRDX(0,8);  SBAR(); \
    GAPB(o[1]=MFMA32(PAF(0),VFR(4),o[1]), C0,2);  VRDX(4,12); SBAR(); \
    GAPB(o[0]=MFMA32(PAF(1),VFR(1),o[0]), C0,4);  VRDX(1,9);  SBAR(); \
    GAPB(o[1]=MFMA32(PAF(1),VFR(5),o[1]), C0,6);  VRDX(5,13); SBAR(); \
    GAPB(o[0]=MFMA32(PAF(2),VFR(2),o[0]), C0,8);  VRDX(2,10); SBAR(); \
    GAPB(o[1]=MFMA32(PAF(2),VFR(6),o[1]), C0,10); VRDX(6,14); SBAR(); \
    GAPB(o[0]=MFMA32(PAF(3),VFR(3),o[0]), C0,12); VRDX(3,11); SBAR(); \
    GAPB(o[1]=MFMA32(PAF(3),VFR(7),o[1]), C0,14); VRDX(7,15); SBAR(); \
    GAPB(o[2]=MFMA32(PAF(0),VFR(0),o[2]), C1,0); \
    GAPB(o[3]=MFMA32(PAF(0),VFR(4),o[3]), C1,2); \
    KRD(GL,0); GAPB(o[2]=MFMA32(PAF(1),VFR(1),o[2]), C1,4); \
    KRD(GL,1); GAPB(o[3]=MFMA32(PAF(1),VFR(5),o[3]), C1,6); \
    KRD(GL,2); GAPB(o[2]=MFMA32(PAF(2),VFR(2),o[2]), C1,8); \
    KRD(GL,3); GAPB(o[3]=MFMA32(PAF(2),VFR(6),o[3]), C1,10); \
    GAPB(o[2]=MFMA32(PAF(3),VFR(3),o[2]), C1,12); \
    GAPB(o[3]=MFMA32(PAF(3),VFR(7),o[3]), C1,14); \
    }while(0)
  int t=1;
  #undef CMASK
  #define CMASK(P0,P1,t) do{}while(0)
  for(;t+7<NT;t+=2){
    STEP(pB0,pB1,pA0,pA1,t,true,true,true);     WAIT_BAR(3); RESC(); ROT();
    STEP(pA0,pA1,pB0,pB1,t+1,true,true,true);   WAIT_BAR(3); RESC(); ROT();
  }
  #undef CMASK
  #define CMASK(P0,P1,t) do{int jb_=(t)-(NT-4); if(jb_>=-2)bmask(P0,P1,jb_,qrel,hi,tab);}while(0)
  #define ENDW(tt) do{ if((tt)+3<NT){WAIT_BAR(3);} else if((tt)+2<NT){WAIT_BAR(2);} else {WAIT_BAR(0);} }while(0)
  for(;t+1<NT;t+=2){
    STEP(pB0,pB1,pA0,pA1,t,(t+3<NT),(t+1<NT),(t+1<NT));       ENDW(t);   RESC(); ROT();
    STEP(pA0,pA1,pB0,pB1,t+1,(t+4<NT),(t+2<NT),(t+2<NT));     ENDW(t+1); RESC(); ROT();
  }
  STEP(pB0,pB1,pA0,pA1,NT-1,false,false,false); RESC();
  { float sacc=pB0[0]+pB0[1]; _Pragma("unroll") for(int r=2;r<16;++r)sacc+=pB0[r]; _Pragma("unroll") for(int r=0;r<16;++r)sacc+=pB1[r]; l_reg+=sacc; if(FAST)ovf=__builtin_fmaxf(ovf,sacc);
    pw0=(u32x4){PKW(pB0,0),PKW(pB0,2),PKW(pB0,4),PKW(pB0,6)};pw1=(u32x4){PKW(pB0,8),PKW(pB0,10),PKW(pB0,12),PKW(pB0,14)};pw2=(u32x4){PKW(pB1,0),PKW(pB1,2),PKW(pB1,4),PKW(pB1,6)};pw3=(u32x4){PKW(pB1,8),PKW(pB1,10),PKW(pB1,12),PKW(pB1,14)};
    SBAR(); pv4(o,vb0+2*sl_cur,PAF(0),PAF(1),PAF(2),PAF(3)); }
  bool redo=false;
  if(FAST){
    volatile __attribute__((address_space(3))) unsigned* flg=(volatile __attribute__((address_space(3))) unsigned*)((lds_cptr)shm+L2_FLAG);
    bad=bad||(__any(!(ovf<1.0e18f))!=0);
    if(bad&&lane==0)flg[0]=1u;
    asm volatile("s_waitcnt lgkmcnt(0)\n\ts_barrier":::"memory");
    redo=flg[0]!=0u;
    asm volatile("s_waitcnt lgkmcnt(0)\n\ts_barrier":::"memory");
    if(wid==0&&lane==0)flg[0]=0u;
  }
  if(!redo){
  {auto rr=__builtin_amdgcn_permlane32_swap(__float_as_uint(l_reg),__float_as_uint(l_reg),false,false);l_reg=__uint_as_float(rr[0])+__uint_as_float(rr[1]);}
  if(hi==0)wsf[32+r32]=l_reg;asm volatile("s_waitcnt lgkmcnt(0)":::"memory");
  float rli[16];
  #pragma unroll
  for(int r=0;r<16;++r)rli[r]=__builtin_amdgcn_rcpf(wsf[32+crow(r,hi)]);
  bf16*Ow=O+(rowbase+q0+wid*QBLK)*DM+hvb*D;
  bf16*stg=(bf16*)(shm+L2_OST)+wid*2048;
  if(!COMB){
    #pragma unroll
    for(int hf=0;hf<2;++hf){
      #pragma unroll
      for(int r=0;r<16;++r){const int orow=crow(r,hi);
        #pragma unroll
        for(int d0=0;d0<2;++d0)stg[orow*64+d0*32+r32]=__float2bfloat16(o[2*hf+d0][r]*rli[r]);}
      asm volatile("s_waitcnt lgkmcnt(0)":::"memory");
      #pragma unroll
      for(int i=0;i<4;++i){const int row=i*8+(lane>>3),ch=lane&7; const u32x4 v=*(const u32x4*)(stg+row*64+ch*8); ATTN_STORE16(Ow+(long)row*DM+hf*64+ch*8,v);}
      asm volatile("s_waitcnt lgkmcnt(0)":::"memory");
    }
  } else {
    bf16*Yw=YG+(rowbase+q0+wid*QBLK)*2048+1024+hvb*D;
    float dv[2][4][8]; float ss[4]={0.f,0.f,0.f,0.f};
    #pragma unroll
    for(int hf=0;hf<2;++hf){
      #pragma unroll
      for(int r=0;r<16;++r){const int orow=crow(r,hi);
        #pragma unroll
        for(int d0=0;d0<2;++d0)stg[orow*64+d0*32+r32]=__float2bfloat16(o[2*hf+d0][r]*rli[r]);}
      asm volatile("s_waitcnt lgkmcnt(0)":::"memory");
      #pragma unroll
      for(int i=0;i<4;++i){const int row=i*8+(lane>>3),ch=lane&7; const u32x4 v1=*(const u32x4*)(stg+row*64+ch*8); const u32x4 v0=*(const u32x4*)(Ow+(long)row*DM+hf*64+ch*8);
        const unsigned w1[4]={v1.x,v1.y,v1.z,v1.w}, w0[4]={v0.x,v0.y,v0.z,v0.w};
        #pragma unroll
        for(int e=0;e<4;++e){ const float a0=__uint_as_float(w0[e]<<16)-lam*__uint_as_float(w1[e]<<16), a1=__uint_as_float(w0[e]&0xffff0000u)-lam*__uint_as_float(w1[e]&0xffff0000u);
          dv[hf][i][2*e]=a0; dv[hf][i][2*e+1]=a1; ss[i]+=a0*a0+a1*a1; } }
      asm volatile("s_waitcnt lgkmcnt(0)":::"memory");
    }
    #pragma unroll
    for(int i=0;i<4;++i){ float s=ss[i]; s+=__shfl_xor(s,1); s+=__shfl_xor(s,2); s+=__shfl_xor(s,4); ss[i]=rsqrtf(s*(1.f/128.f)+1e-5f)*0.8f; }
    #pragma unroll
    for(int hf=0;hf<2;++hf){ float sw[8];
      #pragma unroll
      for(int e=0;e<8;++e)sw[e]=subw[hf*64+(lane&7)*8+e];
      #pragma unroll
      for(int i=0;i<4;++i){const int row=i*8+(lane>>3),ch=lane&7; bf16*yp=Yw+(long)row*2048+hf*64+ch*8; const u32x4 g=*(const u32x4*)yp; const unsigned gw[4]={g.x,g.y,g.z,g.w};
        u32x4 ov; unsigned ow[4];
        #pragma unroll
        for(int e=0;e<4;++e) ow[e]=cvtpk_s(dv[hf][i][2*e]*ss[i]*sw[2*e]*__uint_as_float(gw[e]<<16), dv[hf][i][2*e+1]*ss[i]*sw[2*e+1]*__uint_as_float(gw[e]&0xffff0000u));
        ov.x=ow[0];ov.y=ow[1];ov.z=ow[2];ov.w=ow[3]; *(u32x4*)yp=ov; } }
  }
  }
  asm volatile("s_waitcnt lgkmcnt(0)\n\ts_barrier":::"memory");
  #undef DMA_K
  #undef DMA_V
  #undef CMASK
  #undef RESC
  #undef ROT
  #undef PKW
  #undef PAF
  #undef VFR
  #undef PIN
  #undef MX3
  #undef GAPA
  #undef GAPB
  #undef EX
  #undef VRDX
  #undef KRD
  #undef STEP
  #undef ENDW
  return redo;
}
constexpr int ATTN2_LDS_BYTES=L2_BYTES;
#undef ZERO16
#undef MFMA32
#undef SBAR
#undef WAIT_BAR
}

#define GAS __attribute__((address_space(1)))
#define LAS __attribute__((address_space(3)))
typedef unsigned short bf16;
typedef unsigned v4u __attribute__((ext_vector_type(4)));
typedef float f32x4 __attribute__((ext_vector_type(4)));
typedef short bf16x8 __attribute__((ext_vector_type(8)));
typedef GAS unsigned gu32;
typedef GAS unsigned long long gu64;
#define RLX_AGENT __ATOMIC_RELAXED, __HIP_MEMORY_SCOPE_AGENT
#define LDS_WAIT() asm volatile("s_waitcnt lgkmcnt(0)" ::: "memory")
#define VM_WAIT() asm volatile("s_waitcnt vmcnt(0)" ::: "memory")
__device__ __forceinline__ unsigned long long rt() { return __builtin_amdgcn_s_memrealtime(); }
__device__ __forceinline__ unsigned f2bf(float f) { unsigned u = __builtin_bit_cast(unsigned, f); return (u + 0x7fffu + ((u >> 16) & 1u)) >> 16; }
__device__ __forceinline__ unsigned pk2(float lo, float hi) { return f2bf(lo) | (f2bf(hi) << 16); }

#define XB_TMO      128
#define XB_XCNT(j)  (256  + 64 * (j))
#define XB_XSUB(j)  (1280 + 64 * (j))
#define XB_XGEN(j)  (2304 + 64 * (j))
#define XB_TOP      3328
#define XB_TOPGEN   3392
#define XCD_BAR_WORDS 3456
#define XB_SPIN_CAP (1u << 18)

__device__ __forceinline__ unsigned xb_ld(unsigned* p)              { return __hip_atomic_load(p, __ATOMIC_RELAXED, __HIP_MEMORY_SCOPE_AGENT); }
__device__ __forceinline__ unsigned xb_add(unsigned* p, unsigned v) { return __hip_atomic_fetch_add(p, v, __ATOMIC_RELAXED, __HIP_MEMORY_SCOPE_AGENT); }
__device__ __forceinline__ unsigned xb_xcc_id() { return (unsigned)__builtin_amdgcn_s_getreg((3 << 11) | 20) & 0xFu; }
#define XB_SPIN(cond, bar) do { unsigned _sp = 0; while (cond) { __builtin_amdgcn_s_sleep(1); \
    if ((++_sp & 255u) == 0u) { if (xb_ld(&(bar)[XB_TMO])) break; if (_sp > XB_SPIN_CAP) { atomicAdd(&(bar)[XB_TMO], 1u); break; } } } } while (0)

struct XcdBarrier {
    unsigned* bar; unsigned x;
    volatile LAS unsigned* st;
};

__device__ __forceinline__ XcdBarrier xcd_barrier_post(unsigned* bar, volatile LAS unsigned* st) {
    XcdBarrier b; b.bar = bar; b.x = xb_xcc_id(); b.st = st;
    if (threadIdx.x == 0) (void)xb_add(&bar[XB_XCNT(b.x)], 1u);
    return b;
}
__device__ __forceinline__ void xcd_barrier_complete(unsigned* bar, unsigned x, unsigned& nloc, unsigned& nx) {
    const unsigned G = gridDim.x * gridDim.y * gridDim.z;
    unsigned sum, cnt, mine, sp = 0u;
    for (;;) {
        sum = 0u; cnt = 0u; mine = 0u;
#pragma unroll
        for (unsigned j = 0; j < 16; ++j) { const unsigned c = xb_ld(&bar[XB_XCNT(j)]); sum += c; cnt += (c > 0u) ? 1u : 0u; mine = (j == x) ? c : mine; }
        if (sum == G) break;
        __builtin_amdgcn_s_sleep(1);
        if ((++sp & 255u) == 0u) { if (xb_ld(&bar[XB_TMO])) break; if (sp > XB_SPIN_CAP) { atomicAdd(&bar[XB_TMO], 1u); break; } }
    }
    nloc = mine > 0u ? mine : 1u; nx = cnt > 0u ? cnt : 1u;
}

__device__ __forceinline__ void xcd_barrier(const XcdBarrier& b, const bool leader) {
    asm volatile("s_waitcnt vmcnt(0)" ::: "memory");
    __syncthreads();
    if (leader) {
        unsigned* bar = b.bar;
        __builtin_amdgcn_s_waitcnt(0);
        unsigned nloc = b.st[0], nx = b.st[1];
        if (nloc == 0u) { xcd_barrier_complete(bar, b.x, nloc, nx); b.st[0] = nloc; b.st[1] = nx; }
        const unsigned old = xb_add(&bar[XB_XSUB(b.x)], 1u);
        const unsigned gen = old / nloc;
        if (old + 1u == (gen + 1u) * nloc) {
            __builtin_amdgcn_fence(__ATOMIC_RELEASE, "agent");
            asm volatile("s_waitcnt vmcnt(0)" ::: "memory");
            const unsigned og = xb_add(&bar[XB_TOP], 1u);
            const unsigned tg = og / nx;
            if (og + 1u == (tg + 1u) * nx) xb_add(&bar[XB_TOPGEN], 1u);
            else XB_SPIN(xb_ld(&bar[XB_TOPGEN]) == tg, bar);
            __builtin_amdgcn_fence(__ATOMIC_ACQUIRE, "agent");
            xb_add(&bar[XB_XGEN(b.x)], 1u);
            asm volatile("s_waitcnt vmcnt(0)" ::: "memory");
        } else {
            XB_SPIN(xb_ld(&bar[XB_XGEN(b.x)]) == gen, bar);
            __builtin_amdgcn_fence(__ATOMIC_ACQUIRE, "agent");
            asm volatile("s_waitcnt vmcnt(0)" ::: "memory");
        }
    }
    __syncthreads();
}


constexpr int NWAVES = 8;
constexpr int RING_OFF = 0, RING_BYTES = 131072;
constexpr int LDS_BYTES = 163840;
constexpr int LDSCTL_OFF = LDS_BYTES - 1024, MISC_OFF = LDSCTL_OFF + 320;
constexpr int ATT_TAB_OFF = 110592;
static_assert(attn_body::ATTN_LDS_BYTES <= ATT_TAB_OFF && attn_body::ATTN2_LDS_BYTES <= ATT_TAB_OFF && ATT_TAB_OFF + 8 * 384 * 4 <= RING_BYTES, "attention LDS map");
constexpr int CW_TMO = 0, CW_CODE = 1, CW_BAR = 4096;
static_assert((CW_BAR + XCD_BAR_WORDS) * 4 <= (int)CTL_ZERO_BYTES, "control words inside the memset region");
constexpr int N_PHASES = 9;
static_assert(RING_BYTES <= LDSCTL_OFF, "LDS map");
#ifndef MK_DUP23
#define MK_DUP23 0
#endif
#ifndef MK_DUP_ATTN
#define MK_DUP_ATTN 1
#endif
#ifndef MK_ATTN2
#define MK_ATTN2 1
#endif
#ifndef MK_ALIGN
#define MK_ALIGN true
#endif
#ifndef MK_SP2
#define MK_SP2 true
#endif

__device__ __forceinline__ float wave_sum(float v) {
#pragma unroll
    for (int o = 1; o < 64; o <<= 1) v += __shfl_xor(v, o);
    return v;
}
__device__ __forceinline__ float sigm(float x) { return __builtin_amdgcn_rcpf(1.0f + __builtin_amdgcn_exp2f(-1.4426950408889634f * x)); }

__device__ __forceinline__ void p0_transpose_item(const float* W, int N, bf16* WT, int ldt, int koff, LAS float* scr, int item, int lane, int rot = 0) {
    const int nblk = N / 32, kb = item / nblk, nb = item % nblk, k0 = 64 * kb, n0 = 32 * nb;
#pragma unroll 8
    for (int i = 0; i < 32; ++i) { const int kk = 2 * i + (lane >> 5); scr[kk * 33 + (lane & 31)] = W[(size_t)(k0 + kk) * N + n0 + (lane & 31)]; }
    LDS_WAIT(); asm volatile("" ::: "memory");
    const int c = lane & 7;
#pragma unroll
    for (int j = 0; j < 4; ++j) { const int n = (lane >> 3) + 8 * j; const LAS float* s = scr + (8 * c) * 33 + n;
        v4u o; o.x = pk2(s[0 * 33], s[1 * 33]); o.y = pk2(s[2 * 33], s[3 * 33]); o.z = pk2(s[4 * 33], s[5 * 33]); o.w = pk2(s[6 * 33], s[7 * 33]);
        *(GAS v4u*)(WT + (size_t)((n0 + n + rot) & (N - 1)) * ldt + koff + k0 + 8 * c) = o; }
    LDS_WAIT(); asm volatile("" ::: "memory");
}

constexpr int RNN_ROWS = 520, RNN_BUF = RNN_ROWS * 128, RNN_RG = 2 * RNN_BUF, RNN_TOT = RNN_RG + 8 * 2048, RNN_LDS = RNN_TOT + 2048;
__device__ __forceinline__ void rnn_phase(LAS unsigned char* lds, int vcu, int lane, int wave, const bf16* RX, bf16* YA, const float* conv_w, const float* conv_b,
                                          const float* w_a, const float* b_a, const float* w_x, const float* b_x, const float* lam, const bf16* zrow) {
    const int b = vcu >> 6, hb = (vcu >> 2) & 15, qd = vcu & 3, fr = lane & 15, fq = lane >> 4;
    const int cin0 = hb * 64, jo = qd * 16 + fr, co = hb * 64 + jo;
    bf16x8 Ba[4][2], Bx[4][2], Bs[4][2];
    float bav = b_a[co], bxv = b_x[co];
#pragma unroll
    for (int ks = 0; ks < 2; ++ks)
#pragma unroll
        for (int j = 0; j < 8; ++j) { const int i = 32 * ks + 8 * fq + j; const float wa = w_a[(size_t)hb * 4096 + i * 64 + jo], wx = w_x[(size_t)hb * 4096 + i * 64 + jo];
#pragma unroll
            for (int tp = 0; tp < 4; ++tp) { const float cwv = conv_w[tp * 1024 + cin0 + i];
                Ba[tp][ks][j] = (short)f2bf(cwv * wa); Bx[tp][ks][j] = (short)f2bf(cwv * wx); Bs[tp][ks][j] = (i == jo) ? (short)f2bf(cwv) : (short)0; } }
    for (int i = 0; i < 64; ++i) { const float cbi = conv_b[cin0 + i]; bav += cbi * w_a[(size_t)hb * 4096 + i * 64 + jo]; bxv += cbi * w_x[(size_t)hb * 4096 + i * 64 + jo]; }
    const float cbv = conv_b[co];
    const float logu = -8.0f * log1pf(expf(-lam[co])); const float logu2 = logu * 1.4426950408889634f, logu_2 = 2.0f * logu;
    float hsc = 0.f;
    const unsigned lds0 = (unsigned)(uintptr_t)lds;
    LAS float* tot = (LAS float*)(lds + RNN_TOT);
    const bf16* RXd = RX + (size_t)b * SEQ * 1024 + cin0 + (((lane & 7) - (lane >> 3)) & 7) * 8;
    const bf16* RGd = YA + (size_t)b * SEQ * 2048 + hb * 64 + qd * 16 + (lane & 1) * 8;
    const unsigned rgreg = lds0 + RNN_RG + wave * 2048;
#define RNN_DMA_RX(s_) do { const int T0_ = (s_) * 512; const unsigned bufb_ = lds0 + ((s_) & 1) * RNN_BUF; \
        for (int p_ = wave; p_ < RNN_ROWS / 8; p_ += 8) { const int tok_ = T0_ - 8 + 8 * p_ + (lane >> 3); \
            const bf16* src_ = (tok_ >= 0) ? RXd + (size_t)tok_ * 1024 : zrow; \
            attn_body::glds16(src_, (unsigned)__builtin_amdgcn_readfirstlane(bufb_ + p_ * 1024)); } } while (0)
#define RNN_DMA_RG(s_) do { const int t0_ = (s_) * 512 + wave * 64; \
        attn_body::glds16(RGd + (size_t)(t0_ + (lane >> 1)) * 2048, (unsigned)__builtin_amdgcn_readfirstlane(rgreg)); \
        attn_body::glds16(RGd + (size_t)(t0_ + 32 + (lane >> 1)) * 2048, (unsigned)__builtin_amdgcn_readfirstlane(rgreg + 1024)); } while (0)
    unsigned la[8];
#pragma unroll
    for (int j = 0; j < 8; ++j) la[j] = (unsigned)(fr * 128 + (((fq + fr + 5 + j) & 7) * 16));
    bf16* YAb = YA + (size_t)b * SEQ * 2048 + co;
    RNN_DMA_RX(0);
    asm volatile("s_waitcnt vmcnt(0) lgkmcnt(0)\n\ts_barrier" ::: "memory");
    for (int sc = 0; sc < SEQ / 512; ++sc) {
        const int t0 = sc * 512 + wave * 64;
        if (sc + 1 < SEQ / 512) RNN_DMA_RX(sc + 1);
        RNN_DMA_RG(sc);
        const LAS unsigned char* bufp = lds + (sc & 1) * RNN_BUF + (wave * 64 + 5) * 128;
        float hl[4][4], ac[4][4]; float Ach = 1.f, Hch = 0.f;
#pragma unroll
        for (int m = 0; m < 4; ++m) {
            f32x4 Dr = (f32x4){0.f, 0.f, 0.f, 0.f}, Di = Dr, Dx = Dr;
#pragma unroll
            for (int tp = 0; tp < 4; ++tp) {
                const bf16x8 a0 = *(const LAS bf16x8*)(bufp + (16 * m + tp) * 128 + la[tp & 7]);
                const bf16x8 a1 = *(const LAS bf16x8*)(bufp + (16 * m + tp) * 128 + la[(4 + tp) & 7]);
                Dr = __builtin_amdgcn_mfma_f32_16x16x32_bf16(a0, Ba[tp][0], Dr, 0, 0, 0); Di = __builtin_amdgcn_mfma_f32_16x16x32_bf16(a0, Bx[tp][0], Di, 0, 0, 0); Dx = __builtin_amdgcn_mfma_f32_16x16x32_bf16(a0, Bs[tp][0], Dx, 0, 0, 0);
                Dr = __builtin_amdgcn_mfma_f32_16x16x32_bf16(a1, Ba[tp][1], Dr, 0, 0, 0); Di = __builtin_amdgcn_mfma_f32_16x16x32_bf16(a1, Bx[tp][1], Di, 0, 0, 0); Dx = __builtin_amdgcn_mfma_f32_16x16x32_bf16(a1, Bs[tp][1], Dx, 0, 0, 0); }
            float al[4], hh[4];
#pragma unroll
            for (int r = 0; r < 4; ++r) { const float rr = sigm(Dr[r] + bav), ii = sigm(Di[r] + bxv); const float a = __builtin_amdgcn_exp2f(rr * logu2);
                const float e = rr * logu_2;
                const float pl = -e * (1.0f + e * 0.5f * (1.0f + e * (1.0f / 3.0f) * (1.0f + e * 0.25f * (1.0f + e * 0.2f))));
                const float om = (e > -0.3f) ? pl : (1.0f - a * a);
                const float bin = __builtin_amdgcn_sqrtf(om) * (ii * (Dx[r] + cbv));
                if (r == 0) { al[0] = a; hh[0] = bin; } else { al[r] = a * al[r - 1]; hh[r] = a * hh[r - 1] + bin; } }
            float Ai = al[3], Hi = hh[3];
            { const float Ap = __shfl_up(Ai, 16), Hp = __shfl_up(Hi, 16); if (fq >= 1) { Hi = Ai * Hp + Hi; Ai = Ai * Ap; } }
            { const float Ap = __shfl_up(Ai, 32), Hp = __shfl_up(Hi, 32); if (fq >= 2) { Hi = Ai * Hp + Hi; Ai = Ai * Ap; } }
            float Ae = __shfl_up(Ai, 16), He = __shfl_up(Hi, 16); if (fq == 0) { Ae = 1.f; He = 0.f; }
            const float hin = Ae * Hch + He, Ain = Ae * Ach;
#pragma unroll
            for (int r = 0; r < 4; ++r) { hl[m][r] = hh[r] + al[r] * hin; ac[m][r] = al[r] * Ain; }
            const float Am = __shfl(Ai, 48 + fr), Hm = __shfl(Hi, 48 + fr);
            Hch = Am * Hch + Hm; Ach = Am * Ach;
        }
        LAS float* tw = tot + ((sc & 1) * 8 + wave) * 32;
        if (fq == 0) { tw[fr * 2] = Ach; tw[fr * 2 + 1] = Hch; }
        asm volatile("s_waitcnt vmcnt(0) lgkmcnt(0)\n\ts_barrier" ::: "memory");
        float cin = 0.f, c = hsc;
#pragma unroll
        for (int w2 = 0; w2 < 8; ++w2) { const LAS float* tr = tot + ((sc & 1) * 8 + w2) * 32 + fr * 2; const float A = tr[0], H = tr[1]; if (w2 == wave) cin = c; c = A * c + H; }
        hsc = c;
        const LAS unsigned short* rgp = (const LAS unsigned short*)(lds + RNN_RG + wave * 2048) + fr;
#pragma unroll
        for (int m = 0; m < 4; ++m)
#pragma unroll
            for (int r = 0; r < 4; ++r) { const float h = hl[m][r] + ac[m][r] * cin; const unsigned short g = rgp[(16 * m + 4 * fq + r) * 16];
                YAb[(size_t)(t0 + 16 * m + 4 * fq + r) * 2048] = (bf16)f2bf(h * __uint_as_float(((unsigned)g) << 16)); }
        asm volatile("s_waitcnt lgkmcnt(0)" ::: "memory");
    }
#undef RNN_DMA_RX
#undef RNN_DMA_RG
    asm volatile("s_waitcnt vmcnt(0) lgkmcnt(0)\n\ts_barrier" ::: "memory");
}

static_assert(RNN_LDS <= LDSCTL_OFF, "rnn LDS map");
__device__ __forceinline__ void attn_phase_diff(unsigned char* lds_generic, LAS unsigned char* lds, int vcu, int tid, int wave, const bf16* Q, const bf16* K, const bf16* V, bf16* O0, bf16* YA, const float* rel_bias,
                                                const float* lq1, const float* lk1, const float* lq2, const float* lk2, const float* subw) {
    LAS float* tab = (LAS float*)(lds + ATT_TAB_OFF);
    for (int e = tid; e < 8 * 384; e += NWAVES * 64) { const int h = e / 384, n = e % 384 - 256; float val = -INFINITY;
        if (n >= 0) { int bk; if (n < 16) bk = n; else { bk = 16 + (int)(logf((float)n / 16.0f) / 2.0794415416798357f * 16.0f); bk = bk < 31 ? bk : 31; }
            val = (rel_bias[bk * 8 + h] - rel_bias[31 * 8 + h]) * 1.4426950408889634f; }
        tab[e] = val; }
    if (tid == 0) *(LAS unsigned*)(lds + attn_body::L2_FLAG) = 0u;
    const int lane = tid & 63;
    float s1 = lq1[lane] * lk1[lane], s2 = lq2[lane] * lk2[lane]; s1 = wave_sum(s1); s2 = wave_sum(s2);
    const float lamv = __expf(s1) - __expf(s2) + 0.2f;
    asm volatile("s_waitcnt lgkmcnt(0)\n\ts_barrier" ::: "memory");
    const int g = vcu >> 3, s = vcu & 7, b = g >> 3, h = g & 7;
    const attn_body::lds_fptr tabh = (attn_body::lds_fptr)(tab + h * 384);
    for (int j = 0; j < 4; ++j) {
        const int qb = (j == 0) ? s : (j == 1) ? 15 - s : (j == 2) ? 16 + s : 31 - s;
#define MK_ATT_ARGS(c_) b, h * 2 + (c_), h * 2, qb, (const attn_body::bf16*)Q, (const attn_body::bf16*)K, (const attn_body::bf16*)V, (attn_body::bf16*)O0, (char*)lds_generic, tabh, wave, (attn_body::bf16*)YA, subw, lamv
        if (attn_body::attn_unit2<8, true, false>(MK_ATT_ARGS(0))) (void)attn_body::attn_unit2<8, false, false>(MK_ATT_ARGS(0));
        if (attn_body::attn_unit2<8, true, true>(MK_ATT_ARGS(1))) (void)attn_body::attn_unit2<8, false, true>(MK_ATT_ARGS(1));
#undef MK_ATT_ARGS
    }
}

struct Args { const float* in[23]; float* out; unsigned char* ws; int ph_lo, ph_hi; };
typedef const __attribute__((address_space(4))) Args* KArgs;
__device__ __forceinline__ KArgs kargs() { auto p = __builtin_amdgcn_kernarg_segment_ptr(); asm volatile("" : "+s"(p)); return (KArgs)p; }
__device__ __forceinline__ int lane_id() { int l; asm volatile("v_mbcnt_lo_u32_b32 %0, -1, 0\n\tv_mbcnt_hi_u32_b32 %0, -1, %0" : "=v"(l)); return l; }
__global__ void __launch_bounds__(NWAVES * 64, 2) mk_fwd(Args args) {
    extern __shared__ __attribute__((aligned(16))) unsigned char lds_[];
    LAS unsigned char* lds = (LAS unsigned char*)lds_;
    volatile LAS unsigned* MISC = (volatile LAS unsigned*)(lds + MISC_OFF);
    const int wave = __builtin_amdgcn_readfirstlane((int)threadIdx.x >> 6);
    const int G = gridDim.x; const int vcu = (G % 8 == 0) ? ((int)blockIdx.x % 8) * (G / 8) + (int)blockIdx.x / 8 : (int)blockIdx.x;
    const int gw = vcu * NWAVES + wave, NGW = G * NWAVES;
    gu32* ctl = (gu32*)(args.ws + WS_CTL);
    for (int u = threadIdx.x; u < (LDS_BYTES - LDSCTL_OFF) / 4; u += NWAVES * 64) ((LAS unsigned*)(lds + LDSCTL_OFF))[u] = 0u;
    __syncthreads();
    const int lo = args.ph_lo, hi = args.ph_hi;
    const bool use_bar = (hi - lo) > 1;
    XcdBarrier bar; bar.bar = (unsigned*)(ctl + CW_BAR); bar.x = 0; bar.st = nullptr;
    if (use_bar) bar = xcd_barrier_post((unsigned*)(ctl + CW_BAR), MISC + 8);
#define IN(k) (lo <= (k) && (k) < hi)
#define SEAM(k) do { if (IN(k) && IN((k) + 1 + ((k) == 4))) xcd_barrier(bar, wave == 0 && lane_id() == 0); } while (0)

    if (IN(0)) {
        KArgs A = kargs(); const int lane = lane_id(), tid = wave * 64 + lane; (void)tid;
        const float* cvec = A->in[1];
        const float* w_ada = A->in[2];
        const float* b_ada = A->in[3];
        const float* w_in = A->in[4];
        const float* w_rnn_out = A->in[18];
        const float* w_attn_out = A->in[19];
        const float* w_out = A->in[20];
        float* modf = (float*)(A->ws + WS_MODF);
        bf16* win_t = (bf16*)(A->ws + WS_WIN);
        bf16* wcat_t = (bf16*)(A->ws + WS_WCAT);
        bf16* wout_t = (bf16*)(A->ws + WS_WOUT);

        if (vcu < 192) {
            LAS float* scv = (LAS float*)lds;
            LAS float* red = (LAS float*)(lds + 16384);
#pragma unroll
            for (int i = 0; i < 8; ++i) { const int e = tid * 8 + i; const float cv = cvec[e]; scv[e] = cv * sigm(cv); }
            __syncthreads();
            const int e0 = vcu * 16, col = lane & 15, kg = lane >> 4;
            float a0 = 0.f, a1 = 0.f, a2 = 0.f, a3 = 0.f;
#pragma unroll 8
            for (int i = 0; i < 32; ++i) { const int k = wave * 128 + kg * 32 + i; const float w = w_ada[(size_t)k * 3072 + e0 + col];
                a0 += scv[k] * w; a1 += scv[1024 + k] * w; a2 += scv[2048 + k] * w; a3 += scv[3072 + k] * w; }
            a0 += __shfl_xor(a0, 16); a0 += __shfl_xor(a0, 32); a1 += __shfl_xor(a1, 16); a1 += __shfl_xor(a1, 32);
            a2 += __shfl_xor(a2, 16); a2 += __shfl_xor(a2, 32); a3 += __shfl_xor(a3, 16); a3 += __shfl_xor(a3, 32);
            if (kg == 0) { red[(wave * 4 + 0) * 16 + col] = a0; red[(wave * 4 + 1) * 16 + col] = a1; red[(wave * 4 + 2) * 16 + col] = a2; red[(wave * 4 + 3) * 16 + col] = a3; }
            __syncthreads();
            if (tid < 64) { const int bb = tid >> 4, cc = tid & 15; float sacc = b_ada[e0 + cc];
#pragma unroll
                for (int w2 = 0; w2 < 8; ++w2) sacc += red[(w2 * 4 + bb) * 16 + cc];
                modf[bb * 3072 + e0 + cc] = sacc; }
            __syncthreads();
        }
        LAS float* scr = (LAS float*)(lds + RING_OFF + wave * 16384);
        constexpr int I_IN = (DM / 64) * (NIN / 32), I_SQ = (DM / 64) * (DM / 32), NITEMS = I_IN + 3 * I_SQ;
        for (int it = gw; it < NITEMS; it += NGW) {
            int r = it;
            if (r < I_IN) { p0_transpose_item(w_in, NIN, win_t, DM, 0, scr, r, lane); continue; } r -= I_IN;
            if (r < I_SQ) { p0_transpose_item(w_rnn_out, DM, wcat_t, 2048, 0, scr, r, lane); continue; } r -= I_SQ;
            if (r < I_SQ) { p0_transpose_item(w_attn_out, DM, wcat_t, 2048, 1024, scr, r, lane); continue; } r -= I_SQ;
            p0_transpose_item(w_out, DM, wout_t, DM, 0, scr, r, lane);
        }
    }
    SEAM(0);
    if (IN(1)) {
        KArgs A = kargs(); const int lane = lane_id(), tid = wave * 64 + lane; (void)tid;
        const float* x = A->in[0];
        float* modf = (float*)(A->ws + WS_MODF);
        bf16* ubuf = (bf16*)((unsigned char*)A->out + DO_U);

        for (int blk = gw; blk < MTOK / 16; blk += NGW) {
            const int bb = (blk * 16) / SEQ; f32x4 sc4[4], sh4[4];
#pragma unroll
            for (int j = 0; j < 4; ++j) { sh4[j] = *(const GAS f32x4*)(modf + bb * 3072 + 256 * j + 4 * lane); sc4[j] = *(const GAS f32x4*)(modf + bb * 3072 + 1024 + 256 * j + 4 * lane) + 1.0f; }
            for (int rr = 0; rr < 16; ++rr) { const size_t row = (size_t)blk * 16 + rr;
                const GAS f32x4* xr = (const GAS f32x4*)(x + row * DM) + lane; GAS unsigned long long* o8 = (GAS unsigned long long*)(ubuf + row * DM) + lane;
#pragma unroll
                for (int j = 0; j < 4; ++j) { const f32x4 v = xr[64 * j] * sc4[j] + sh4[j]; o8[64 * j] = (unsigned long long)pk2(v.x, v.y) | ((unsigned long long)pk2(v.z, v.w) << 32); } }
        }
    }
    SEAM(1);
#if MK_DUP23
    for (int rep_ = 0; rep_ < 2; ++rep_) {
#endif
    if (IN(2)) {
        KArgs A = kargs(); const int lane = lane_id(), tid = wave * 64 + lane; (void)tid;
        bf16* ubuf = (bf16*)((unsigned char*)A->out + DO_U);
        bf16* win_t = (bf16*)(A->ws + WS_WIN);
        bf16* rxb = (bf16*)((unsigned char*)A->out + DO_RX);
        bf16* ya = (bf16*)(A->ws + WS_YA);
        bf16* qbuf = (bf16*)(A->ws + WS_Q);
        bf16* kbuf = (bf16*)(A->ws + WS_K);
        bf16* vbuf = (bf16*)(A->ws + WS_V);
        bf16* mgb = (bf16*)(A->ws + WS_MG);

        pg8::Gemm g{ubuf, win_t, MTOK, NIN, DM}; pg8::StaticOrder S; S.init(MTOK, NIN, G, (int)blockIdx.x);
        pg8::EpiProjV E{A->ws, (unsigned char*)A->out};
        pg8::gemm_phase<pg8::EpiProjV, pg8::StaticOrder, MK_ALIGN, MK_SP2>(lds + RING_OFF, g, S, E, tid);
    }
#if MK_DUP23 == 2
    }
#endif
    SEAM(2);
    if (IN(3)) {
        KArgs A = kargs(); const int lane = lane_id(), tid = wave * 64 + lane; (void)tid;
        bf16* rxb = (bf16*)((unsigned char*)A->out + DO_RX);
        bf16* ya = (bf16*)(A->ws + WS_YA);
        const float* conv_w = A->in[5];
        const float* conv_b = A->in[6];
        const float* w_rg_a = A->in[7];
        const float* b_rg_a = A->in[8];
        const float* w_rg_x = A->in[9];
        const float* b_rg_x = A->in[10];
        const float* lru_lambda = A->in[11];
 if (G == 256) rnn_phase(lds, vcu, lane, wave, rxb, ya, conv_w, conv_b, w_rg_a, b_rg_a, w_rg_x, b_rg_x, lru_lambda, (const bf16*)(A->ws + WS_ZERO)); }
#if MK_DUP23 == 1
    if (rep_ == 0) xcd_barrier(bar, wave == 0 && lane_id() == 0);
    }
#endif
    if (IN(4)) {
        KArgs A = kargs(); const int lane = lane_id(), tid = wave * 64 + lane; (void)tid;
        bf16* qbuf = (bf16*)(A->ws + WS_Q); bf16* kbuf = (bf16*)(A->ws + WS_K); bf16* vbuf = (bf16*)(A->ws + WS_V); bf16* ya = (bf16*)(A->ws + WS_YA);
        bf16* o0 = (bf16*)((unsigned char*)A->out + DO_O0);
        if (G == 256) attn_phase_diff(lds_, lds, vcu, tid, wave, qbuf, kbuf, vbuf, o0, ya, A->in[17], A->in[12], A->in[13], A->in[14], A->in[15], A->in[16]);
    }
    SEAM(4);
    if (IN(6)) {
        KArgs A = kargs(); const int lane = lane_id(), tid = wave * 64 + lane; (void)tid;
        bf16* ya = (bf16*)(A->ws + WS_YA);
        bf16* wcat_t = (bf16*)(A->ws + WS_WCAT);
        bf16* mgb = (bf16*)(A->ws + WS_MG);
        bf16* merged = (bf16*)(A->ws + WS_Q);

        pg8::Gemm g{ya, wcat_t, MTOK, DM, 2048}; pg8::StaticOrder S; S.init(MTOK, DM, G, (int)blockIdx.x);
        pg8::EpiMergeV E{mgb, merged};
        pg8::gemm_phase<pg8::EpiMergeV, pg8::StaticOrder, MK_ALIGN, MK_SP2>(lds + RING_OFF, g, S, E, tid);
    }
    SEAM(6);
    if (IN(7)) {
        KArgs A = kargs(); const int lane = lane_id(), tid = wave * 64 + lane; (void)tid;
        bf16* merged = (bf16*)(A->ws + WS_Q);
        bf16* wout_t = (bf16*)(A->ws + WS_WOUT);
        const float* x = A->in[0];
        float* modf = (float*)(A->ws + WS_MODF);
        float* outp = A->out;

        pg8::Gemm g{merged, wout_t, MTOK, DM, DM}; pg8::StaticOrder S; S.init(MTOK, DM, G, (int)blockIdx.x);
        pg8::EpiOutV E{x, modf, outp};
        pg8::gemm_phase<pg8::EpiOutV, pg8::StaticOrder, MK_ALIGN, MK_SP2>(lds + RING_OFF, g, S, E, tid);
    }
    SEAM(7);
    if (IN(8)) {
        KArgs A = kargs(); const int lane = lane_id(), tid = wave * 64 + lane; (void)tid;
        const float* ln_g = A->in[21];
        const float* ln_b = A->in[22];
        float* outp = A->out;

        f32x4 gg[4], bb[4];
#pragma unroll
        for (int j = 0; j < 4; ++j) { gg[j] = *(const GAS f32x4*)(ln_g + 256 * j + 4 * lane); bb[j] = *(const GAS f32x4*)(ln_b + 256 * j + 4 * lane); }
        for (int row = gw; row < MTOK; row += NGW) {
            GAS f32x4* p = (GAS f32x4*)(outp + (size_t)row * DM) + lane; f32x4 v[4]; float s = 0.f;
#pragma unroll
            for (int j = 0; j < 4; ++j) { v[j] = p[64 * j]; s += (v[j].x + v[j].y) + (v[j].z + v[j].w); }
            const float mean = wave_sum(s) * (1.f / DM); float s2 = 0.f;
#pragma unroll
            for (int j = 0; j < 4; ++j) { v[j] = v[j] - mean; s2 += (v[j].x * v[j].x + v[j].y * v[j].y) + (v[j].z * v[j].z + v[j].w * v[j].w); }
            const float rstd = rsqrtf(wave_sum(s2) * (1.f / DM) + LN_EPS);
#pragma unroll
            for (int j = 0; j < 4; ++j) p[64 * j] = v[j] * rstd * gg[j] + bb[j];
        }
    }
#undef IN
#undef SEAM
}

#ifndef MK_STEP
#define MK_STEP 4
#define MK_C0 6144
#define MK_C1 7168
#endif
extern "C" void kernel_launch(void* const* d_in, const int* in_sizes, int n_in, void* d_out, int out_size, void* d_ws, size_t ws_size, hipStream_t stream) {
    static int grid = 0;
    if (grid == 0) {
        if (n_in != 23 || out_size != MTOK * DM || ws_size < WS_END) { fprintf(stderr, "kernel_launch: unexpected shapes (n_in %d out %d ws %zu)\n", n_in, out_size, ws_size); grid = -1; return; }
        int dev = 0, cus = 0;
        if (hipGetDevice(&dev) != hipSuccess || hipDeviceGetAttribute(&cus, hipDeviceAttributeMultiprocessorCount, dev) != hipSuccess) { grid = -1; return; }
        if (hipFuncSetAttribute((const void*)mk_fwd, hipFuncAttributeMaxDynamicSharedMemorySize, LDS_BYTES) != hipSuccess) { fprintf(stderr, "kernel_launch: hipFuncSetAttribute failed\n"); grid = -1; return; }
        (void)hipGetLastError();
        grid = cus;
        if (grid != 256) { fprintf(stderr, "kernel_launch: built for 256 CUs, found %d\n", grid); }
    }
    if (grid < 0) return;
    (void)hipMemsetAsync((char*)d_ws + WS_CTL, 0, CTL_ZERO_BYTES, stream);
    Args a{};
    for (int i = 0; i < 23; ++i) a.in[i] = (const float*)d_in[i];
    a.out = (float*)d_out; a.ws = (unsigned char*)d_ws;
#define MK_RUN(lo_, hi_) do { a.ph_lo = (lo_); a.ph_hi = (hi_); hipLaunchKernelGGL(mk_fwd, dim3(grid), dim3(NWAVES * 64), LDS_BYTES, stream, a); } while (0)
    unsigned char* ws = (unsigned char*)d_ws; unsigned char* dob = (unsigned char*)d_out;
    bf16_t* ya = (bf16_t*)(ws + WS_YA); bf16_t* qb = (bf16_t*)(ws + WS_Q); bf16_t* kb = (bf16_t*)(ws + WS_K); bf16_t* vb = (bf16_t*)(ws + WS_V);
    bf16_t* rx = (bf16_t*)(dob + DO_RX); bf16_t* o0 = (bf16_t*)(dob + DO_O0); bf16_t* o1 = (bf16_t*)(dob + DO_O1);
    const float* conv_w = (const float*)d_in[5]; const float* conv_b = (const float*)d_in[6];
    const float* w_rg_a = (const float*)d_in[7]; const float* b_rg_a = (const float*)d_in[8]; const float* w_rg_x = (const float*)d_in[9]; const float* b_rg_x = (const float*)d_in[10];
    const float* lru_lambda = (const float*)d_in[11]; const float* lq1 = (const float*)d_in[12]; const float* lk1 = (const float*)d_in[13]; const float* lq2 = (const float*)d_in[14]; const float* lk2 = (const float*)d_in[15];
    const float* subln_w = (const float*)d_in[16]; const float* rel_bias = (const float*)d_in[17]; const float* ln_g = (const float*)d_in[21]; const float* ln_b = (const float*)d_in[22];
#if MK_STEP == 1
    MK_RUN(0, 1); MK_RUN(1, 2); MK_RUN(2, 3);
    k_rnn_simple<<<NB * 16, 64, 0, stream>>>(rx, ya, conv_w, conv_b, w_rg_a, b_rg_a, w_rg_x, b_rg_x, lru_lambda);
    k_attn_simple<<<NB * 8 * 2 * 32, 256, 0, stream>>>(qb, kb, vb, o0, o1, rel_bias);
    k_combine<<<MTOK / 4, 256, 0, stream>>>(o0, o1, ya, lq1, lk1, lq2, lk2, subln_w);
    MK_RUN(6, 7); MK_RUN(7, 8);
    k_ln<<<MTOK / 4, 256, 0, stream>>>((float*)d_out, ln_g, ln_b);
#elif MK_STEP == 11
    MK_RUN(0, 1); MK_RUN(1, 2); MK_RUN(2, 3);
    k_rnn_simple<<<NB * 16, 64, 0, stream>>>(rx, ya, conv_w, conv_b, w_rg_a, b_rg_a, w_rg_x, b_rg_x, lru_lambda);
    k_attn_simple<<<NB * 8 * 2 * 32, 256, 0, stream>>>(qb, kb, vb, o0, o1, rel_bias);
    k_combine<<<MTOK / 4, 256, 0, stream>>>(o0, o1, ya, lq1, lk1, lq2, lk2, subln_w);
    { EpiMerge e{(bf16_t*)(ws + WS_MG), qb}; k_gemm_simple<EpiMerge, true><<<dim3(DM / 64, MTOK / 64), 256, 0, stream>>>(ya, (bf16_t*)(ws + WS_WCAT), MTOK, DM, 2048, e); }
    { EpiOut e{(const float*)d_in[0], (const float*)(ws + WS_MODF), (float*)d_out}; k_gemm_simple<EpiOut, false><<<dim3(DM / 64, MTOK / 64), 256, 0, stream>>>(qb, (bf16_t*)(ws + WS_WOUT), MTOK, DM, DM, e); }
    k_ln<<<MTOK / 4, 256, 0, stream>>>((float*)d_out, ln_g, ln_b);
#elif MK_STEP == 12 || MK_STEP == 13
    MK_RUN(0, 1);
#if MK_STEP == 13
    MK_RUN(1, 2);
#else
    k_u<<<(unsigned)(((size_t)MTOK * DM + 255) / 256), 256, 0, stream>>>((const float*)d_in[0], (const float*)(ws + WS_MODF), (bf16_t*)(dob + DO_U));
#endif
    { EpiProj e{rx, ya, qb, kb, vb, (bf16_t*)(ws + WS_MG)}; k_gemm_simple<EpiProj, false><<<dim3(NIN / 64, MTOK / 64), 256, 0, stream>>>((bf16_t*)(dob + DO_U), (bf16_t*)(ws + WS_WIN), MTOK, NIN, DM, e); }
    k_rnn_simple<<<NB * 16, 64, 0, stream>>>(rx, ya, conv_w, conv_b, w_rg_a, b_rg_a, w_rg_x, b_rg_x, lru_lambda);
    k_attn_simple<<<NB * 8 * 2 * 32, 256, 0, stream>>>(qb, kb, vb, o0, o1, rel_bias);
    k_combine<<<MTOK / 4, 256, 0, stream>>>(o0, o1, ya, lq1, lk1, lq2, lk2, subln_w);
    { EpiMerge e{(bf16_t*)(ws + WS_MG), qb}; k_gemm_simple<EpiMerge, true><<<dim3(DM / 64, MTOK / 64), 256, 0, stream>>>(ya, (bf16_t*)(ws + WS_WCAT), MTOK, DM, 2048, e); }
    { EpiOut e{(const float*)d_in[0], (const float*)(ws + WS_MODF), (float*)d_out}; k_gemm_simple<EpiOut, false><<<dim3(DM / 64, MTOK / 64), 256, 0, stream>>>(qb, (bf16_t*)(ws + WS_WOUT), MTOK, DM, DM, e); }
    k_ln<<<MTOK / 4, 256, 0, stream>>>((float*)d_out, ln_g, ln_b);
#elif MK_STEP == 14
    MK_RUN(0, 1); MK_RUN(1, 2);
    { EpiProj e{rx, ya, qb, kb, vb, (bf16_t*)(ws + WS_MG)}; k_gemm_simple<EpiProj, false><<<dim3(NIN / 64, MTOK / 64), 256, 0, stream>>>((bf16_t*)(dob + DO_U), (bf16_t*)(ws + WS_WIN), MTOK, NIN, DM, e); }
    k_rnn_simple<<<NB * 16, 64, 0, stream>>>(rx, ya, conv_w, conv_b, w_rg_a, b_rg_a, w_rg_x, b_rg_x, lru_lambda);
    k_attn_simple<<<NB * 8 * 2 * 32, 256, 0, stream>>>(qb, kb, vb, o0, o1, rel_bias);
    k_combine<<<MTOK / 4, 256, 0, stream>>>(o0, o1, ya, lq1, lk1, lq2, lk2, subln_w);
    MK_RUN(6, 7); MK_RUN(7, 8);
    k_ln<<<MTOK / 4, 256, 0, stream>>>((float*)d_out, ln_g, ln_b);
#elif MK_STEP == 15
    MK_RUN(0, 1); MK_RUN(1, 2); MK_RUN(2, 3);
    { EpiProj e{rx, ya, qb, kb, vb, (bf16_t*)(ws + WS_MG)}; k_gemm_simple<EpiProj, false><<<dim3((MK_C1 - MK_C0) / 64, MTOK / 64), 256, 0, stream>>>((bf16_t*)(dob + DO_U), (bf16_t*)(ws + WS_WIN), MTOK, NIN, DM, e, MK_C0 / 64); }
    k_rnn_simple<<<NB * 16, 64, 0, stream>>>(rx, ya, conv_w, conv_b, w_rg_a, b_rg_a, w_rg_x, b_rg_x, lru_lambda);
    k_attn_simple<<<NB * 8 * 2 * 32, 256, 0, stream>>>(qb, kb, vb, o0, o1, rel_bias);
    k_combine<<<MTOK / 4, 256, 0, stream>>>(o0, o1, ya, lq1, lk1, lq2, lk2, subln_w);
    MK_RUN(6, 7); MK_RUN(7, 8);
    k_ln<<<MTOK / 4, 256, 0, stream>>>((float*)d_out, ln_g, ln_b);
#elif MK_STEP == 2
    MK_RUN(0, 1); MK_RUN(1, 2); MK_RUN(2, 3);
    k_rnn_simple<<<NB * 16, 64, 0, stream>>>(rx, ya, conv_w, conv_b, w_rg_a, b_rg_a, w_rg_x, b_rg_x, lru_lambda);
    MK_RUN(4, 5); MK_RUN(5, 6); MK_RUN(6, 7); MK_RUN(7, 8); MK_RUN(8, 9);
#elif MK_STEP == 3
    for (int p = 0; p < N_PHASES; ++p) MK_RUN(p, p + 1);
#else
    MK_RUN(0, N_PHASES);
#endif
}
```
